# Optimizing an MI355X kernel written in HIP

```python
import math
import jax, jax.numpy as jnp
from jax import lax
import numpy as np

D_MODEL = 1024
BATCH = 8
SEQ = 2048
DEPTH = 2
DEC_BATCH = 16
DEC_SEQ = 32
PAST_LEN = 4096

CHUNK = 64
Q_BLOCK = 128
MLA_HEADS = 8
MLA_NOPE = 64
MLA_ROPE = 32
MLA_V = 64
MLA_Q_RANK = 256
MLA_KV_RANK = 128
ROPE_BASE = 10000.0
SB_HEADS = 8
SB_DIM = 64
DIFF_HEADS = 4
DIFF_DIM = 64
BRANCH_W = 512
N_BRANCH = 3
D_FF = 2816
CONV_W = 3
EPS = 1e-6

MLA_SCALE = (MLA_NOPE + MLA_ROPE) ** -0.5
SB_SCALE = SB_DIM ** -0.5
DIFF_SCALE = DIFF_DIM ** -0.5
SPLITS = (MLA_Q_RANK, MLA_KV_RANK, MLA_ROPE,
          SB_HEADS * SB_DIM, SB_HEADS * SB_DIM, SB_HEADS * SB_DIM,
          2 * DIFF_HEADS * DIFF_DIM, 2 * DIFF_HEADS * DIFF_DIM, 2 * DIFF_HEADS * DIFF_DIM,
          N_BRANCH * D_MODEL)
N_IN = sum(SPLITS)
SPLIT_IDX = tuple(int(i) for i in np.cumsum(SPLITS)[:-1])

kernel_name = 'hybrid_mla_stickbreak_diffattn_convffn_stream_step'


def rmsnorm(x, g):
    xf = x.astype(jnp.float32)
    y = xf * lax.rsqrt(jnp.mean(xf * xf, axis=-1, keepdims=True) + EPS)
    return (y * g.astype(jnp.float32)).astype(x.dtype)


def rope(x, pos):
    half = x.shape[-1] // 2
    inv = ROPE_BASE ** (-jnp.arange(half, dtype=jnp.float32) / half)
    ang = pos.astype(jnp.float32)[:, None] * inv[None, :]
    cos = jnp.cos(ang)[:, None, :]
    sin = jnp.sin(ang)[:, None, :]
    xf = x.astype(jnp.float32)
    x1, x2 = xf[..., :half], xf[..., half:]
    return jnp.concatenate([x1 * cos - x2 * sin, x1 * sin + x2 * cos], axis=-1).astype(x.dtype)


def chunk_mask(q_pos, k_pos):
    return (k_pos[None, :] // CHUNK) <= (q_pos[:, None] // CHUNK)


def alibi_slopes():
    return 2.0 ** (-8.0 * jnp.arange(1, DIFF_HEADS + 1, dtype=jnp.float32) / DIFF_HEADS)


def sweep(fn, q_args, q_pos):
    S = q_pos.shape[0]
    if S <= Q_BLOCK or S % Q_BLOCK != 0:
        return fn(*q_args, q_pos)
    nb = S // Q_BLOCK
    blocks = tuple(jnp.moveaxis(a.reshape((a.shape[0], nb, Q_BLOCK) + a.shape[2:]), 1, 0) for a in q_args)
    pos_blocks = q_pos.reshape(nb, Q_BLOCK)
    out = lax.map(lambda t: fn(*t[0], t[1]), (blocks, pos_blocks))
    o = jnp.moveaxis(out, 0, 1)
    return o.reshape((o.shape[0], nb * Q_BLOCK) + o.shape[3:])


def mla_block(qn, qr, q_pos, kn, kr, v, k_pos):
    s = (jnp.einsum('bqhd,bkhd->bhqk', qn, kn) + jnp.einsum('bqhr,bkr->bhqk', qr, kr)).astype(jnp.float32) * MLA_SCALE
    s = jnp.where(chunk_mask(q_pos, k_pos), s, -jnp.inf)
    p = jax.nn.softmax(s, axis=-1).astype(v.dtype)
    return jnp.einsum('bhqk,bkhd->bqhd', p, v)


def sb_block(q, q_pos, k, v, k_pos):
    z = jnp.einsum('bqhd,bkhd->bhqk', q, k).astype(jnp.float32) * SB_SCALE
    valid = k_pos[None, :] < q_pos[:, None]
    log_1mb = jnp.where(valid, jax.nn.log_sigmoid(-z), 0.0)
    suffix = lax.cumsum(log_1mb, axis=3, reverse=True) - log_1mb
    a = jnp.where(valid, jnp.exp(jax.nn.log_sigmoid(z) + suffix), 0.0).astype(v.dtype)
    return jnp.einsum('bhqk,bkhd->bqhd', a, v)


def diff_block(q, q_pos, k, v, k_pos, lam):
    s = jnp.einsum('bqhmd,bkhmd->bhmqk', q, k).astype(jnp.float32) * DIFF_SCALE
    dist = jnp.abs(q_pos[:, None] - k_pos[None, :]).astype(jnp.float32)
    s = s - alibi_slopes()[:, None, None, None] * dist
    s = jnp.where(chunk_mask(q_pos, k_pos), s, -jnp.inf)
    p = jax.nn.softmax(s, axis=-1)
    pd = (p[:, :, 0] - lam * p[:, :, 1]).astype(v.dtype)
    return jnp.einsum('bhqk,bkhe->bqhe', pd, v)


def mixer_layer(x, q_pos, past, w, layer_idx):
    B, S, _ = x.shape
    h = rmsnorm(x, w['mix_norm_g'])
    z = h @ w['w_in']
    z_cq, z_ckv, z_kr, z_sq, z_sk, z_sv, z_dq, z_dk, z_dv, z_g = jnp.split(z, SPLIT_IDX, axis=-1)
    cq = rmsnorm(z_cq, w['mla_q_norm_g'])
    q = (cq @ w['mla_w_uq']).reshape(B, S, MLA_HEADS, MLA_NOPE + MLA_ROPE)
    qn = rmsnorm(q[..., :MLA_NOPE], w['mla_qn_g'])
    qr = rope(rmsnorm(q[..., MLA_NOPE:], w['mla_qr_g']), q_pos)
    ckv_new = rmsnorm(z_ckv, w['mla_kv_norm_g'])
    kr_new = rope(rmsnorm(z_kr, w['mla_kr_g'])[:, :, None, :], q_pos)[:, :, 0, :]
    sbq = z_sq.reshape(B, S, SB_HEADS, SB_DIM)
    sbk_new = z_sk.reshape(B, S, SB_HEADS, SB_DIM)
    sbv_new = z_sv.reshape(B, S, SB_HEADS, SB_DIM)
    dq = rmsnorm(z_dq.reshape(B, S, DIFF_HEADS, 2, DIFF_DIM), w['diff_qn_g'])
    dk_new = rmsnorm(z_dk.reshape(B, S, DIFF_HEADS, 2, DIFF_DIM), w['diff_kn_g'])
    dv_new = z_dv.reshape(B, S, DIFF_HEADS, 2 * DIFF_DIM)
    new_rows = (ckv_new, kr_new, sbk_new, sbv_new, dk_new, dv_new)
    if past is None:
        full = new_rows
    else:
        full = tuple(jnp.concatenate([c, n], axis=1) for c, n in zip(past, new_rows))
    ckv, kr, sbk, sbv, dk, dv = full
    K = ckv.shape[1]
    k_pos = jnp.arange(K, dtype=jnp.int32)
    kn = rmsnorm((ckv @ w['mla_w_uk']).reshape(B, K, MLA_HEADS, MLA_NOPE), w['mla_kn_g'])
    mv = (ckv @ w['mla_w_uv']).reshape(B, K, MLA_HEADS, MLA_V)
    o_mla = sweep(lambda a, b, qp: mla_block(a, b, qp, kn, kr, mv, k_pos), (qn, qr), q_pos)
    o_sb = sweep(lambda a, qp: sb_block(a, qp, sbk, sbv, k_pos), (sbq,), q_pos)
    lam_init = 0.8 - 0.6 * math.exp(-0.3 * layer_idx)
    lv = w['diff_lambda'].astype(jnp.float32)
    lam = jnp.exp(jnp.sum(lv[0] * lv[1])) - jnp.exp(jnp.sum(lv[2] * lv[3])) + lam_init
    o_diff = sweep(lambda a, qp: diff_block(a, qp, dk, dv, k_pos, lam), (dq,), q_pos)
    o_diff = rmsnorm(o_diff, w['diff_subln_g']) * (1.0 - lam_init)
    g_mla, g_sb, g_diff = jnp.split(jax.nn.sigmoid(z_g), N_BRANCH, axis=-1)
    merged = (g_mla * (o_mla.reshape(B, S, BRANCH_W) @ w['w_br_mla'])
              + g_sb * (o_sb.reshape(B, S, BRANCH_W) @ w['w_br_sb'])
              + g_diff * (o_diff.reshape(B, S, BRANCH_W) @ w['w_br_diff']))
    return merged @ w['w_out'], new_rows


def ffn_layer(x, conv_past, w):
    h = rmsnorm(x, w['ffn_norm_g'])
    a, u = jnp.split(h @ w['ffn_w_up'], 2, axis=-1)
    B, S, _ = a.shape
    pad = jnp.zeros((B, CONV_W - 1, D_FF), a.dtype) if conv_past is None else conv_past
    ap = jnp.concatenate([pad, a], axis=1)
    cw = w['ffn_conv_w']
    c = ap[:, 0:S] * cw[0]
    for k in range(1, CONV_W):
        c = c + ap[:, k:k + S] * cw[k]
    c = c + w['ffn_conv_b']
    out = (jax.nn.silu(c) * u) @ w['ffn_w_down']
    return out, ap[:, -(CONV_W - 1):]


def setup_inputs(seed: int = 0) -> dict:
    key = jax.random.key(seed)
    ks = iter(jax.random.split(key, 48))

    def nrm(shape, scale=1.0):
        return jax.random.normal(next(ks), shape, jnp.float32) * scale

    def gain(shape):
        return 1.0 + 0.02 * nrm(shape)

    L = DEPTH
    return {
        'x_prompt': nrm((BATCH, SEQ, D_MODEL)),
        'x_sample': nrm((DEC_BATCH, DEC_SEQ, D_MODEL)),
        'cache_mla_ckv': nrm((L, DEC_BATCH, PAST_LEN, MLA_KV_RANK)),
        'cache_mla_krope': nrm((L, DEC_BATCH, PAST_LEN, MLA_ROPE)),
        'cache_sb_k': nrm((L, DEC_BATCH, PAST_LEN, SB_HEADS, SB_DIM)),
        'cache_sb_v': nrm((L, DEC_BATCH, PAST_LEN, SB_HEADS, SB_DIM)),
        'cache_diff_k': nrm((L, DEC_BATCH, PAST_LEN, DIFF_HEADS, 2, DIFF_DIM)),
        'cache_diff_v': nrm((L, DEC_BATCH, PAST_LEN, DIFF_HEADS, 2 * DIFF_DIM)),
        'state_ffn_conv': nrm((L, DEC_BATCH, CONV_W - 1, D_FF)),
        'mix_norm_g': gain((L, D_MODEL)),
        'w_in': nrm((L, D_MODEL, N_IN), D_MODEL ** -0.5),
        'mla_q_norm_g': gain((L, MLA_Q_RANK)),
        'mla_w_uq': nrm((L, MLA_Q_RANK, MLA_HEADS * (MLA_NOPE + MLA_ROPE)), MLA_Q_RANK ** -0.5),
        'mla_kv_norm_g': gain((L, MLA_KV_RANK)),
        'mla_w_uk': nrm((L, MLA_KV_RANK, MLA_HEADS * MLA_NOPE), MLA_KV_RANK ** -0.5),
        'mla_w_uv': nrm((L, MLA_KV_RANK, MLA_HEADS * MLA_V), MLA_KV_RANK ** -0.5),
        'mla_qn_g': gain((L, MLA_NOPE)),
        'mla_kn_g': gain((L, MLA_NOPE)),
        'mla_qr_g': gain((L, MLA_ROPE)),
        'mla_kr_g': gain((L, MLA_ROPE)),
        'diff_qn_g': gain((L, DIFF_DIM)),
        'diff_kn_g': gain((L, DIFF_DIM)),
        'diff_lambda': nrm((L, 4, DIFF_DIM), 0.1),
        'diff_subln_g': gain((L, 2 * DIFF_DIM)),
        'w_br_mla': nrm((L, BRANCH_W, D_MODEL), BRANCH_W ** -0.5),
        'w_br_sb': nrm((L, BRANCH_W, D_MODEL), BRANCH_W ** -0.5),
        'w_br_diff': nrm((L, BRANCH_W, D_MODEL), BRANCH_W ** -0.5),
        'w_out': nrm((L, D_MODEL, D_MODEL), D_MODEL ** -0.5),
        'ffn_norm_g': gain((L, D_MODEL)),
        'ffn_w_up': nrm((L, D_MODEL, 2 * D_FF), D_MODEL ** -0.5),
        'ffn_conv_w': nrm((L, CONV_W, D_FF), CONV_W ** -0.5),
        'ffn_conv_b': nrm((L, D_FF), 0.01),
        'ffn_w_down': nrm((L, D_FF, D_MODEL), D_FF ** -0.5),
    }


def reference(x_prompt, x_sample, cache_mla_ckv, cache_mla_krope, cache_sb_k, cache_sb_v,
              cache_diff_k, cache_diff_v, state_ffn_conv,
              mix_norm_g, w_in, mla_q_norm_g, mla_w_uq, mla_kv_norm_g, mla_w_uk, mla_w_uv,
              mla_qn_g, mla_kn_g, mla_qr_g, mla_kr_g, diff_qn_g, diff_kn_g, diff_lambda,
              diff_subln_g, w_br_mla, w_br_sb, w_br_diff, w_out, ffn_norm_g, ffn_w_up,
              ffn_conv_w, ffn_conv_b, ffn_w_down):
    weights = dict(mix_norm_g=mix_norm_g, w_in=w_in, mla_q_norm_g=mla_q_norm_g, mla_w_uq=mla_w_uq,
                   mla_kv_norm_g=mla_kv_norm_g, mla_w_uk=mla_w_uk, mla_w_uv=mla_w_uv,
                   mla_qn_g=mla_qn_g, mla_kn_g=mla_kn_g, mla_qr_g=mla_qr_g, mla_kr_g=mla_kr_g,
                   diff_qn_g=diff_qn_g, diff_kn_g=diff_kn_g, diff_lambda=diff_lambda,
                   diff_subln_g=diff_subln_g, w_br_mla=w_br_mla, w_br_sb=w_br_sb,
                   w_br_diff=w_br_diff, w_out=w_out, ffn_norm_g=ffn_norm_g, ffn_w_up=ffn_w_up,
                   ffn_conv_w=ffn_conv_w, ffn_conv_b=ffn_conv_b, ffn_w_down=ffn_w_down)
    past_len = cache_mla_ckv.shape[2]
    pos_p = jnp.arange(x_prompt.shape[1], dtype=jnp.int32)
    pos_s = past_len + jnp.arange(x_sample.shape[1], dtype=jnp.int32)
    xp, xs = x_prompt, x_sample
    rows_p, rows_s, conv_p, conv_s = [], [], [], []
    for l in range(DEPTH):
        w = {name: arr[l] for name, arr in weights.items()}
        yp, rp = mixer_layer(xp, pos_p, None, w, l)
        xp = xp + yp
        fp, cp = ffn_layer(xp, None, w)
        xp = xp + fp
        past = (cache_mla_ckv[l], cache_mla_krope[l], cache_sb_k[l], cache_sb_v[l],
                cache_diff_k[l], cache_diff_v[l])
        ys, rs = mixer_layer(xs, pos_s, past, w, l)
        xs = xs + ys
        fs, cs = ffn_layer(xs, state_ffn_conv[l], w)
        xs = xs + fs
        rows_p.append(rp)
        rows_s.append(rs)
        conv_p.append(cp)
        conv_s.append(cs)
    p_ckv = jnp.stack([r[0] for r in rows_p])
    p_krope = jnp.stack([r[1] for r in rows_p])
    p_sbk = jnp.stack([r[2] for r in rows_p])
    p_sbv = jnp.stack([r[3] for r in rows_p])
    p_dk = jnp.stack([r[4] for r in rows_p])
    p_dv = jnp.stack([r[5] for r in rows_p])
    p_conv = jnp.stack(conv_p)
    s_ckv = jnp.stack([r[0] for r in rows_s])
    s_krope = jnp.stack([r[1] for r in rows_s])
    s_sbk = jnp.stack([r[2] for r in rows_s])
    s_sbv = jnp.stack([r[3] for r in rows_s])
    s_dk = jnp.stack([r[4] for r in rows_s])
    s_dv = jnp.stack([r[5] for r in rows_s])
    s_conv = jnp.stack(conv_s)
    return (xp, xs, p_ckv, p_krope, p_sbk, p_sbv, p_dk, p_dv, p_conv,
            s_ckv, s_krope, s_sbk, s_sbv, s_dk, s_dv, s_conv)
```

```cpp
#include <hip/hip_runtime.h>
#include <math.h>
#include <cstdio>
#include <cstdint>
__device__ __forceinline__ int hw_lane() { int l; asm volatile("v_mbcnt_lo_u32_b32 %0, -1, 0\n\tv_mbcnt_hi_u32_b32 %0, -1, %0" : "=v"(l)); return l; }
template <int M> __device__ __forceinline__ float sw_xor(float v) { return __builtin_bit_cast(float, __builtin_amdgcn_ds_swizzle(__builtin_bit_cast(int, v), 0x1f | (M << 10))); }
__device__ __forceinline__ float half_sum(float v) { const unsigned u = __builtin_bit_cast(unsigned, v); auto rr = __builtin_amdgcn_permlane32_swap(u, u, false, false); return __builtin_bit_cast(float, (unsigned)rr[0]) + __builtin_bit_cast(float, (unsigned)rr[1]); }
__device__ __forceinline__ float half_max(float v) { const unsigned u = __builtin_bit_cast(unsigned, v); auto rr = __builtin_amdgcn_permlane32_swap(u, u, false, false); return fmaxf(__builtin_bit_cast(float, (unsigned)rr[0]), __builtin_bit_cast(float, (unsigned)rr[1])); }
__device__ __forceinline__ float half_other(float v, int hi) { const unsigned u = __builtin_bit_cast(unsigned, v); auto rr = __builtin_amdgcn_permlane32_swap(u, u, false, false); return __builtin_bit_cast(float, (unsigned)(hi ? rr[0] : rr[1])); }
namespace pg8 {
#define PG8_LAS __attribute__((address_space(3)))
typedef unsigned short bf16_t;
typedef short bf16x8 __attribute__((ext_vector_type(8)));
typedef float f32x4 __attribute__((ext_vector_type(4)));
typedef unsigned u32x4 __attribute__((ext_vector_type(4)));
constexpr int BM = 256, BK = 64, HALF = 128, HTB = HALF * BK * 2  , STAGE_BYTES = 8 * HTB, NXCD = 8, WGM = 8;

__host__ __device__ __forceinline__ int lds_byte(int r, int c) { const int st = (r >> 4) * 2 + (c >> 5), rr = r & 15, cc = c & 31, ob = rr * 64 + cc * 2; return st * 1024 + (ob ^ (((ob >> 9) & 1) << 5)); }
__host__ __device__ __forceinline__ void stage_rc(int b, int& R, int& C) { const int st = b / 1024, sb = b % 1024, swz = sb ^ (((sb >> 9) & 1) << 5); R = (st >> 1) * 16 + swz / 64; C = (st & 1) * 32 + (swz % 64) / 2; }
__host__ __device__ __forceinline__ int perm32(int rho) { const int n = rho >> 4, i = rho & 15; return 8 * (i >> 2) + 4 * n + (i & 3); }

struct Unit { int pm, pn; };
struct Gemm { const bf16_t* A; const bf16_t* Bt; int M, N, K, lda; int prows = 256; };

struct StaticOrder {
    int nM, nN, nwg, G, c;
    __host__ __device__ void init(int M, int N, int G_, int c_) { nM = M / BM; nN = N / BM; nwg = nM * nN; G = G_; c = c_; }
    __host__ __device__ bool next(int i, Unit& u) const {
        const long L = (long)i * G + c; if (L >= nwg) return false;
        int wgid = (int)L; { const int q = nwg / NXCD, r = nwg % NXCD, xcd = wgid % NXCD, off = wgid / NXCD; wgid = (xcd < r ? xcd * (q + 1) : r * (q + 1) + (xcd - r) * q) + off; }
        const int nig = WGM * nN, gid = wgid / nig, fm = gid * WGM, gsz = (nM - fm) < WGM ? (nM - fm) : WGM;
        u.pm = fm + ((wgid % nig) % gsz); u.pn = (wgid % nig) / gsz; return true;
    }
    __device__ __forceinline__ void a_ready(const Unit&) const {}
    __device__ __forceinline__ void done(const Unit&) const {}
};

struct BranchOrder {
    StaticOrder S;
    __host__ __device__ void init(int M, int G_, int c_) { S.init(M, 1024, G_, c_); }
    __host__ __device__ bool next(int i, Unit& u) const { Unit t; const int j = i % 3; if (!S.next(i / 3, t)) return false; u.pm = 66 * j + t.pm; u.pn = 4 * j + t.pn; return true; }
    __device__ __forceinline__ void a_ready(const Unit&) const {}
    __device__ __forceinline__ void done(const Unit&) const {}
};
template <int NN  , int NWG  , int FIRST  , int E> struct TailOrder {
    int G, c, rem, e;
    __host__ __device__ void init(int G_, int c_) { G = G_; c = c_; rem = FIRST % G_; e = rem ? E : 0; }
    __host__ __device__ bool next(int i, Unit& u) const {
        const int extra = (G - rem) * e; int L;
        if (c >= rem) L = i < e ? (c - rem) * e + i : extra + (i - e) * G + c; else L = extra + i * G + c;
        if (L >= NWG) return false; u.pm = L / NN; u.pn = L % NN; return true; }
    __device__ __forceinline__ void a_ready(const Unit&) const {}
    __device__ __forceinline__ void done(const Unit&) const {}
};
struct SubOrder {
    StaticOrder S; int pn0;
    __host__ __device__ void init(int M, int ntn, int pn0_, int G_, int c_) { S.init(M, ntn * BM, G_, c_); pn0 = pn0_; }
    __host__ __device__ bool next(int i, Unit& u) const { const bool ok = S.next(i, u); u.pn += pn0; return ok; }
    __device__ __forceinline__ void a_ready(const Unit&) const {}
    __device__ __forceinline__ void done(const Unit&) const {}
};

__device__ __forceinline__ unsigned cvt_pk_bf16(float lo, float hi) { unsigned r; asm volatile("v_cvt_pk_bf16_f32 %0, %1, %2" : "=v"(r) : "v"(lo), "v"(hi)); return r; }
constexpr int kR = 16896, kRP = 16384, kRS = 512, kZW = 6656;
constexpr int ZC_CQ = 0, ZC_CKV = 256, ZC_KR = 384, ZC_SQ = 512, ZC_SK = 1024, ZC_SV = 1536, ZC_DQ = 2048, ZC_DK = 2560, ZC_DV = 3072, ZC_G = 3584;
constexpr float kEPS = 1e-6f;
typedef float f32x2 __attribute__((ext_vector_type(2)));
__device__ __forceinline__ float bf_lo(unsigned w) { return __uint_as_float(w << 16); }
__device__ __forceinline__ float bf_hi(unsigned w) { return __uint_as_float(w & 0xffff0000u); }
__device__ __forceinline__ float fast_sigmoid(float x) { return __builtin_amdgcn_rcpf(1.0f + __expf(-x)); }

#ifndef EPI_SC1
#define EPI_SC1 0
#endif
template <class T> __device__ __forceinline__ void st16(const void __attribute__((address_space(1)))* p, T v) {
#if EPI_SC1
    asm volatile("global_store_dwordx4 %0, %1, off sc1" :: "v"(p), "v"(v));
#else
    *(T __attribute__((address_space(1)))*)p = v;
#endif
}
template <class T> __device__ __forceinline__ void st16(const void* p, T v) { st16((const void __attribute__((address_space(1)))*)p, v); }
__device__ __forceinline__ void epi_bar() { asm volatile("s_waitcnt lgkmcnt(0)" ::: "memory"); __builtin_amdgcn_s_barrier(); asm volatile("" ::: "memory"); }
__device__ __forceinline__ float sq8(const f32x4& a, const f32x4& b) { return (a[0] * a[0] + a[1] * a[1]) + (a[2] * a[2] + a[3] * a[3]) + (b[0] * b[0] + b[1] * b[1]) + (b[2] * b[2] + b[3] * b[3]); }
__device__ __forceinline__ u32x4 pack8f(const f32x4& a, const f32x4& b) { u32x4 w; w.x = cvt_pk_bf16(a[0], a[1]); w.y = cvt_pk_bf16(a[2], a[3]); w.z = cvt_pk_bf16(b[0], b[1]); w.w = cvt_pk_bf16(b[2], b[3]); return w; }
constexpr float kQS64 = 0.125f * 1.4426950408889634f, kQSMLA = 0.10206207261596577f * 1.4426950408889634f;

__device__ __forceinline__ void rope_cs4(int pos, int j0, f32x4& c, f32x4& s) {
#pragma unroll
    for (int i = 0; i < 4; ++i) { const float invrev = __builtin_amdgcn_exp2f(-(float)(j0 + i) * (13.287712379549449f / 16.0f)) * 0.15915494309189535f;
        const float ph = __builtin_amdgcn_fractf((float)pos * invrev); c[i] = __builtin_amdgcn_cosf(ph); s[i] = __builtin_amdgcn_sinf(ph); }
}
struct EpiIn {
    static constexpr bool PERM = true, AFTER_DRAIN = false;
    const void __attribute__((address_space(4)))* kargs; int layer; PG8_LAS float* xs;
    size_t ws_z, ws_ssq, ws_rope, ws_kmla;
    size_t off_p_ckv, off_s_ckv, off_p_kr, off_s_kr, off_p_sbk, off_s_sbk;
    int i_out, i_ws, i_qng, i_kvng, i_krg, i_dqg, i_dkg;
    __device__ __forceinline__ void operator()(const f32x4 (&acc)[2][2][4][2], const Unit& u, int wr, int wc, int fr_in, int fq_in) const {
        const int ln_ = hw_lane(); const int fr = ln_ & 15, fq = ln_ >> 4; (void)fr_in; (void)fq_in;
        const void __attribute__((address_space(4)))* ka = kargs; asm volatile("" : "+s"(ka));
        typedef const unsigned long long __attribute__((address_space(4)))* KP_;
#define EPI_G __attribute__((address_space(1)))
#define EPI_ARG(T, i) ((T EPI_G*)(((KP_)ka)[i]))
        unsigned char EPI_G* wsb = EPI_ARG(unsigned char, i_ws); float EPI_G* out = EPI_ARG(float, i_out);
        bf16_t EPI_G* Z = (bf16_t EPI_G*)(wsb + ws_z); const float EPI_G* ssq = (const float EPI_G*)(wsb + ws_ssq);
        const int pn = u.pn; const bool prompt = u.pm < 64;
        const int row0 = u.pm * BM + wr * 64 + fr, col0 = pn * BM + wc * 64 + 8 * fq;
        const size_t nrows = prompt ? (size_t)kRP : (size_t)kRS;
        float rs[2][4];
#pragma unroll
        for (int ai = 0; ai < 2; ++ai)
#pragma unroll
            for (int m = 0; m < 4; ++m) rs[ai][m] = __hip_atomic_load(ssq + row0 + ai * HALF + m * 16, __ATOMIC_RELAXED, __HIP_MEMORY_SCOPE_AGENT);
#pragma unroll
        for (int ai = 0; ai < 2; ++ai)
#pragma unroll
            for (int m = 0; m < 4; ++m) rs[ai][m] = rsqrtf(rs[ai][m] * (1.0f / 1024.0f) + kEPS);
        if (pn >= 14 || pn == 2 || pn == 3) {
            const float sc = pn < 14 ? kQS64 : 1.0f;
#pragma unroll
            for (int ai = 0; ai < 2; ++ai)
#pragma unroll
                for (int m = 0; m < 4; ++m) { const int row = row0 + ai * HALF + m * 16; const float r_ = rs[ai][m] * sc;
#pragma unroll
                    for (int bj = 0; bj < 2; ++bj) st16((Z + (size_t)row * kZW + col0 + 32 * bj), pack8f(acc[ai][bj][m][0] * r_, acc[ai][bj][m][1] * r_)); }
        } else if ((pn >= 4 && pn < 8) || pn == 12 || pn == 13) {
            const int sel = pn < 6 ? 0 : (pn < 8 ? 1 : 3);
            float EPI_G* fdst = out + (prompt ? off_p_sbk : off_s_sbk) + ((size_t)sel * 2 + layer) * nrows * 512 + (pn & 1) * 256 + wc * 64 + 8 * fq;
#pragma unroll
            for (int ai = 0; ai < 2; ++ai)
#pragma unroll
                for (int m = 0; m < 4; ++m) { const int row = row0 + ai * HALF + m * 16; const int orow = prompt ? row : row - kRP; const float r_ = rs[ai][m];
#pragma unroll
                    for (int bj = 0; bj < 2; ++bj) { const f32x4 v0 = acc[ai][bj][m][0] * r_, v1 = acc[ai][bj][m][1] * r_;
                        st16((Z + (size_t)row * kZW + col0 + 32 * bj), pack8f(v0, v1));
                        float EPI_G* fp = fdst + (size_t)orow * 512 + 32 * bj; st16(fp, v0); st16((fp + 4), v1); } }
        } else if (pn >= 8 && pn < 12) {
            const bool isq = pn < 10; const float EPI_G* g = (isq ? EPI_ARG(const float, i_dqg) + layer * 64 : EPI_ARG(const float, i_dkg) + layer * 64); const float sc = isq ? kQS64 : 1.0f;
            f32x4 g0[2][2];
#pragma unroll
            for (int bj = 0; bj < 2; ++bj) { g0[bj][0] = *(const f32x4 EPI_G*)(g + 32 * bj + 8 * fq); g0[bj][1] = *(const f32x4 EPI_G*)(g + 32 * bj + 8 * fq + 4); }
            float EPI_G* fdst = out + (prompt ? off_p_sbk : off_s_sbk) + ((size_t)2 * 2 + layer) * nrows * 512 + (pn & 1) * 256 + wc * 64 + 8 * fq;
#pragma unroll
            for (int ai = 0; ai < 2; ++ai)
#pragma unroll
                for (int m = 0; m < 4; ++m) { const int row = row0 + ai * HALF + m * 16; const int orow = prompt ? row : row - kRP; const float r_ = rs[ai][m];
                    f32x4 v[2][2]; float s = 0.f;
#pragma unroll
                    for (int bj = 0; bj < 2; ++bj) { v[bj][0] = acc[ai][bj][m][0] * r_; v[bj][1] = acc[ai][bj][m][1] * r_; s += sq8(v[bj][0], v[bj][1]); }
                    s += sw_xor<16>(s); s = half_sum(s);
                    const float rn = rsqrtf(s * (1.0f / 64.0f) + kEPS) * sc;
#pragma unroll
                    for (int bj = 0; bj < 2; ++bj) { const f32x4 w0 = v[bj][0] * rn * g0[bj][0], w1 = v[bj][1] * rn * g0[bj][1];
                        st16((Z + (size_t)row * kZW + col0 + 32 * bj), pack8f(w0, w1));
                        if (!isq) { float EPI_G* fp = fdst + (size_t)orow * 512 + 32 * bj; st16(fp, w0); st16((fp + 4), w1); } } }
        } else {
            PG8_LAS unsigned char* xsb = (PG8_LAS unsigned char*)xs + (wr * 64 + fr) * 16;
            float sown[2][4];
#pragma unroll
            for (int ai = 0; ai < 2; ++ai)
#pragma unroll
                for (int m = 0; m < 4; ++m) { const float r_ = rs[ai][m]; float s = 0.f;
#pragma unroll
                    for (int bj = 0; bj < 2; ++bj) s += sq8(acc[ai][bj][m][0] * r_, acc[ai][bj][m][1] * r_);
                    s += sw_xor<16>(s); s = half_sum(s); sown[ai][m] = s;
                    if (fq == 0) *(PG8_LAS float*)(xsb + (ai * HALF + m * 16) * 16 + wc * 4) = s; }
            epi_bar();
            if (pn == 0) {
                const float EPI_G* qng = EPI_ARG(const float, i_qng) + layer * 256;
                f32x4 g0[2][2];
#pragma unroll
                for (int bj = 0; bj < 2; ++bj) { g0[bj][0] = *(const f32x4 EPI_G*)(qng + wc * 64 + 32 * bj + 8 * fq); g0[bj][1] = *(const f32x4 EPI_G*)(qng + wc * 64 + 32 * bj + 8 * fq + 4); }
#pragma unroll
                for (int ai = 0; ai < 2; ++ai)
#pragma unroll
                    for (int m = 0; m < 4; ++m) { const int rl = ai * HALF + wr * 64 + m * 16 + fr; const int row = u.pm * BM + rl;
                        const f32x4 pp = *(const PG8_LAS f32x4*)(xsb + (ai * HALF + m * 16) * 16); const float rn = rsqrtf(((pp[0] + pp[1]) + (pp[2] + pp[3])) * (1.0f / 256.0f) + kEPS) * rs[ai][m];
#pragma unroll
                        for (int bj = 0; bj < 2; ++bj) st16((Z + (size_t)row * kZW + col0 + 32 * bj), pack8f(acc[ai][bj][m][0] * rn * g0[bj][0], acc[ai][bj][m][1] * rn * g0[bj][1])); }
            } else if (wc < 2) {
                const float EPI_G* kvng = EPI_ARG(const float, i_kvng) + layer * 128;
                f32x4 g0[2][2];
#pragma unroll
                for (int bj = 0; bj < 2; ++bj) { g0[bj][0] = *(const f32x4 EPI_G*)(kvng + wc * 64 + 32 * bj + 8 * fq); g0[bj][1] = *(const f32x4 EPI_G*)(kvng + wc * 64 + 32 * bj + 8 * fq + 4); }
                float EPI_G* fdst = out + (prompt ? off_p_ckv : off_s_ckv) + (size_t)layer * nrows * 128 + wc * 64 + 8 * fq;
#pragma unroll
                for (int ai = 0; ai < 2; ++ai)
#pragma unroll
                    for (int m = 0; m < 4; ++m) { const int rl = ai * HALF + wr * 64 + m * 16 + fr; const int row = u.pm * BM + rl; const int orow = prompt ? row : row - kRP;
                        const f32x2 pq = *(const PG8_LAS f32x2*)(xsb + (ai * HALF + m * 16) * 16); const float rn = rsqrtf((pq[0] + pq[1]) * (1.0f / 128.0f) + kEPS) * rs[ai][m];
#pragma unroll
                        for (int bj = 0; bj < 2; ++bj) { const f32x4 w0 = acc[ai][bj][m][0] * rn * g0[bj][0], w1 = acc[ai][bj][m][1] * rn * g0[bj][1];
                            st16((Z + (size_t)row * kZW + col0 + 32 * bj), pack8f(w0, w1));
                            float EPI_G* fp = fdst + (size_t)orow * 128 + 32 * bj; st16(fp, w0); st16((fp + 4), w1); } }
            } else if (wc == 2) {
                const float EPI_G* krg = EPI_ARG(const float, i_krg) + layer * 32; const float EPI_G* rope = (const float EPI_G*)(wsb + ws_rope); bf16_t EPI_G* Kmla = (bf16_t EPI_G*)(wsb + ws_kmla);
                const f32x4 g0 = *(const f32x4 EPI_G*)(krg + 8 * fq), g1 = *(const f32x4 EPI_G*)(krg + 8 * fq + 4);
                float EPI_G* fdst = out + (prompt ? off_p_kr : off_s_kr) + (size_t)layer * nrows * 32 + 8 * fq;
                const bool up = fq >= 2;
#pragma unroll
                for (int ai = 0; ai < 2; ++ai)
#pragma unroll
                    for (int m = 0; m < 4; ++m) { const int row = row0 + ai * HALF + m * 16; const int orow = prompt ? row : row - kRP; const float r_ = rs[ai][m];
                        float s = sq8(acc[ai][0][m][0], acc[ai][0][m][1]) * (r_ * r_); s += sw_xor<16>(s); s = half_sum(s);
                        const float rn = rsqrtf(s * (1.0f / 32.0f) + kEPS) * r_;
                        const int pos = prompt ? (row & 2047) : 4096 + ((row - kRP) & 31);
                        float EPI_G* fp = fdst + (size_t)orow * 32;
                        f32x4 oo[2];
#pragma unroll
                        for (int n = 0; n < 2; ++n) {
                            const f32x4 v = acc[ai][0][m][n] * rn * (n == 0 ? g0 : g1);
                            f32x4 cc, ss; rope_cs4(pos, 8 * (fq & 1) + 4 * n, cc, ss);
#pragma unroll
                            for (int i = 0; i < 4; ++i) { const float pp = half_other(v[i], up ? 1 : 0);
                                oo[n][i] = up ? (pp * ss[i] + v[i] * cc[i]) : (v[i] * cc[i] - pp * ss[i]); }
                            st16((fp + 4 * n), oo[n]);
                        }
                        const u32x4 w = pack8f(oo[0], oo[1]);
                        st16((Z + (size_t)row * kZW + ZC_KR + 8 * fq), w);
#pragma unroll
                        for (int h = 0; h < 8; ++h) st16((Kmla + (size_t)row * 768 + h * 96 + 64 + 8 * fq), w);
                        asm volatile("" ::: "memory"); }
            }
            epi_bar();
        }
#undef EPI_ARG
#undef EPI_G
    }
};

struct EpiQ {
    static constexpr bool PERM = true, AFTER_DRAIN = false;
    bf16_t* Q; const float *qng, *qrg; const float* rope;
    __device__ __forceinline__ void operator()(const f32x4 (&acc)[2][2][4][2], const Unit& u, int wr, int wc, int fr_in, int fq_in) const {
        const int ln_ = hw_lane(); const int fr = ln_ & 15, fq = ln_ >> 4; (void)fr_in; (void)fq_in;
        const int row0 = u.pm * BM + wr * 64 + fr;
        if (u.pn < 2) {
            const int head = 4 * u.pn + wc;
            f32x4 g0[2][2];
#pragma unroll
            for (int bj = 0; bj < 2; ++bj) { g0[bj][0] = *(const f32x4*)(qng + 32 * bj + 8 * fq); g0[bj][1] = *(const f32x4*)(qng + 32 * bj + 8 * fq + 4); }
#pragma unroll
            for (int ai = 0; ai < 2; ++ai)
#pragma unroll
                for (int m = 0; m < 4; ++m) { const int row = row0 + ai * HALF + m * 16;
                    float s = sq8(acc[ai][0][m][0], acc[ai][0][m][1]) + sq8(acc[ai][1][m][0], acc[ai][1][m][1]); s += sw_xor<16>(s); s = half_sum(s);
                    const float rn = rsqrtf(s * (1.0f / 64.0f) + kEPS) * kQSMLA;
#pragma unroll
                    for (int bj = 0; bj < 2; ++bj) st16((Q + (size_t)row * 768 + head * 96 + 32 * bj + 8 * fq), pack8f(acc[ai][bj][m][0] * rn * g0[bj][0], acc[ai][bj][m][1] * rn * g0[bj][1])); }
        } else {
            const f32x4 g0 = *(const f32x4*)(qrg + 8 * fq), g1 = *(const f32x4*)(qrg + 8 * fq + 4);
            const bool up = fq >= 2;
#pragma unroll
            for (int ai = 0; ai < 2; ++ai)
#pragma unroll
                for (int m = 0; m < 4; ++m) { const int row = row0 + ai * HALF + m * 16;
                    const int pos = row < kRP ? (row & 2047) : 4096 + ((row - kRP) & 31);
                    f32x4 c0, c1, s0, s1; rope_cs4(pos, 8 * (fq & 1), c0, s0); rope_cs4(pos, 8 * (fq & 1) + 4, c1, s1);
#pragma unroll
                    for (int bj = 0; bj < 2; ++bj) { const int head = 2 * wc + bj;
                        f32x4 v0 = acc[ai][bj][m][0], v1 = acc[ai][bj][m][1];
                        float s = sq8(v0, v1); s += sw_xor<16>(s); s = half_sum(s);
                        const float rn = rsqrtf(s * (1.0f / 32.0f) + kEPS); v0 = v0 * rn * g0; v1 = v1 * rn * g1;
                        f32x4 o0, o1;
#pragma unroll
                        for (int i = 0; i < 4; ++i) { const float p0 = half_other(v0[i], up ? 1 : 0), p1 = half_other(v1[i], up ? 1 : 0);
                            o0[i] = (up ? (p0 * s0[i] + v0[i] * c0[i]) : (v0[i] * c0[i] - p0 * s0[i])) * kQSMLA;
                            o1[i] = (up ? (p1 * s1[i] + v1[i] * c1[i]) : (v1[i] * c1[i] - p1 * s1[i])) * kQSMLA; }
                        st16((Q + (size_t)row * 768 + head * 96 + 64 + 8 * fq), pack8f(o0, o1)); } }
        }
    }
};

struct EpiKV {
    static constexpr bool PERM = true, AFTER_DRAIN = false;
    bf16_t* Kmla; bf16_t* V; const float* kng;
    __device__ __forceinline__ void operator()(const f32x4 (&acc)[2][2][4][2], const Unit& u, int wr, int wc, int fr_in, int fq_in) const {
        const int ln_ = hw_lane(); const int fr = ln_ & 15, fq = ln_ >> 4; (void)fr_in; (void)fq_in;
        const int row0 = u.pm * BM + wr * 64 + fr;
        if (u.pn < 2) {
            const int head = 4 * u.pn + wc;
            f32x4 g0[2][2];
#pragma unroll
            for (int bj = 0; bj < 2; ++bj) { g0[bj][0] = *(const f32x4*)(kng + 32 * bj + 8 * fq); g0[bj][1] = *(const f32x4*)(kng + 32 * bj + 8 * fq + 4); }
#pragma unroll
            for (int ai = 0; ai < 2; ++ai)
#pragma unroll
                for (int m = 0; m < 4; ++m) { const int row = row0 + ai * HALF + m * 16;
                    float s = sq8(acc[ai][0][m][0], acc[ai][0][m][1]) + sq8(acc[ai][1][m][0], acc[ai][1][m][1]); s += sw_xor<16>(s); s = half_sum(s);
                    const float rn = rsqrtf(s * (1.0f / 64.0f) + kEPS);
#pragma unroll
                    for (int bj = 0; bj < 2; ++bj) st16((Kmla + (size_t)row * 768 + head * 96 + 32 * bj + 8 * fq), pack8f(acc[ai][bj][m][0] * rn * g0[bj][0], acc[ai][bj][m][1] * rn * g0[bj][1])); }
        } else {
#pragma unroll
            for (int ai = 0; ai < 2; ++ai)
#pragma unroll
                for (int m = 0; m < 4; ++m) { const int row = row0 + ai * HALF + m * 16;
#pragma unroll
                    for (int bj = 0; bj < 2; ++bj) st16((V + (size_t)row * 1024 + u.pn * BM + wc * 64 + 32 * bj + 8 * fq), pack8f(acc[ai][bj][m][0], acc[ai][bj][m][1])); }
        }
    }
};

struct EpiPlain {
    static constexpr bool PERM = true, AFTER_DRAIN = false;
    bf16_t* O; int ldc; const float* ssq;
    __device__ __forceinline__ void operator()(const f32x4 (&acc)[2][2][4][2], const Unit& u, int wr, int wc, int fr_in, int fq_in) const {
        const int ln_ = hw_lane(); const int fr = ln_ & 15, fq = ln_ >> 4; (void)fr_in; (void)fq_in;
        const int row0 = u.pm * BM + wr * 64 + fr, col0 = u.pn * BM + wc * 32 + 8 * fq;
#pragma unroll
        for (int ai = 0; ai < 2; ++ai)
#pragma unroll
            for (int m = 0; m < 4; ++m) {
                const int row = row0 + ai * HALF + m * 16;
                const float rs = ssq ? rsqrtf(__hip_atomic_load(ssq + row, __ATOMIC_RELAXED, __HIP_MEMORY_SCOPE_AGENT) * (1.0f / 1024.0f) + kEPS) : 1.0f;
                bf16_t* op = O + (size_t)row * ldc + col0;
#pragma unroll
                for (int bj = 0; bj < 2; ++bj) {
                    const f32x4 v0 = acc[ai][bj][m][0] * rs, v1 = acc[ai][bj][m][1] * rs;
                    u32x4 w; w.x = cvt_pk_bf16(v0[0], v0[1]); w.y = cvt_pk_bf16(v0[2], v0[3]); w.z = cvt_pk_bf16(v1[0], v1[1]); w.w = cvt_pk_bf16(v1[2], v1[3]);
                    st16((op + bj * HALF), w);
                }
            }
    }
};

template <int J> struct EpiBranch {
    static constexpr bool PERM = true, AFTER_DRAIN = false;
    const bf16_t* Z; bf16_t* P; bf16_t* Mb;
    __device__ __forceinline__ void operator()(const f32x4 (&acc)[2][2][4][2], const Unit& u, int wr, int wc, int fr_in, int fq_in) const {
        const int ln_ = hw_lane(); const int fr = ln_ & 15, fq = ln_ >> 4; (void)fr_in; (void)fq_in;
        const int row0 = u.pm * BM + wr * 64 + fr, col0 = u.pn * BM + wc * 32 + 8 * fq;
        const bf16_t* zg = Z + (size_t)row0 * kZW + ZC_G + J * 1024 + col0; bf16_t* pp0 = P + (size_t)row0 * 1024 + col0; bf16_t* mb0 = Mb + (size_t)row0 * 1024 + col0;
        u32x4 gq[2][4], pq[2][4];
        auto load = [&](int slot, int b) {
            const int ai = b >> 1, mh = b & 1;
#pragma unroll
            for (int k = 0; k < 4; ++k) { const int m = 2 * mh + (k >> 1), bj = k & 1; const size_t ro = (size_t)(ai * HALF + m * 16);
                gq[slot][k] = *(const u32x4*)(zg + ro * kZW + bj * HALF);
                if (J >= 1) pq[slot][k] = *(const u32x4*)(pp0 + ro * 1024 + bj * HALF); }
        };
        load(0, 0);
#pragma unroll
        for (int b = 0; b < 4; ++b) {
            const int slot = b & 1, ai = b >> 1, mh = b & 1;
            if (b < 3) load(slot ^ 1, b + 1);
#pragma unroll
            for (int k = 0; k < 4; ++k) { const int m = 2 * mh + (k >> 1), bj = k & 1; const size_t ro = (size_t)(ai * HALF + m * 16);
                const u32x4 g = gq[slot][k];
                f32x4 v0 = acc[ai][bj][m][0], v1 = acc[ai][bj][m][1];
                v0[0] *= fast_sigmoid(bf_lo(g.x)); v0[1] *= fast_sigmoid(bf_hi(g.x)); v0[2] *= fast_sigmoid(bf_lo(g.y)); v0[3] *= fast_sigmoid(bf_hi(g.y));
                v1[0] *= fast_sigmoid(bf_lo(g.z)); v1[1] *= fast_sigmoid(bf_hi(g.z)); v1[2] *= fast_sigmoid(bf_lo(g.w)); v1[3] *= fast_sigmoid(bf_hi(g.w));
                if (J >= 1) { const u32x4 q = pq[slot][k];
                    v0[0] += bf_lo(q.x); v0[1] += bf_hi(q.x); v0[2] += bf_lo(q.y); v0[3] += bf_hi(q.y); v1[0] += bf_lo(q.z); v1[1] += bf_hi(q.z); v1[2] += bf_lo(q.w); v1[3] += bf_hi(q.w); }
                *(u32x4*)((J <= 1 ? pp0 : mb0) + ro * 1024 + bj * HALF) = pack8f(v0, v1); }
        }
    }
};


__device__ __forceinline__ float dpp_ror1(float v) { return __builtin_bit_cast(float, __builtin_amdgcn_update_dpp(0, __builtin_bit_cast(int, v), 0x121, 0xf, 0xf, false)); }
__device__ __forceinline__ float dpp_ror2(float v) { return __builtin_bit_cast(float, __builtin_amdgcn_update_dpp(0, __builtin_bit_cast(int, v), 0x122, 0xf, 0xf, false)); }
struct EpiUpConv {
    static constexpr bool PERM = true, AFTER_DRAIN = false;
    bf16_t* ACT; const float* ssq; const float* cw; const float* cb; const float* cpast; float* out; size_t off_p_conv, off_s_conv; PG8_LAS float* hx;
    __device__ __forceinline__ void operator()(const f32x4 (&acc)[2][2][4][2], const Unit& u, int wr, int wc, int fr_in, int fq_in) const {
        const int ln_ = hw_lane(); const int fr = ln_ & 15, fq = ln_ >> 4; (void)fr_in; (void)fq_in;
        const int cj = wc * 32 + 8 * fq;
        const int gc = u.pn * 128 + cj;
        const int tok0 = 254 * u.pm - 2 + wr * 64 + fr;
        f32x4 w0[2], w1[2], w2[2], bb[2];
#pragma unroll
        for (int n = 0; n < 2; ++n) { w0[n] = *(const f32x4*)(cw + gc + 4 * n); w1[n] = *(const f32x4*)(cw + 2816 + gc + 4 * n); w2[n] = *(const f32x4*)(cw + 2 * 2816 + gc + 4 * n); bb[n] = *(const f32x4*)(cb + gc + 4 * n); }
        float rs[2][4];
#pragma unroll
        for (int ai = 0; ai < 2; ++ai)
#pragma unroll
            for (int m = 0; m < 4; ++m) { const int tok = tok0 + ai * HALF + m * 16;
                rs[ai][m] = (tok >= 0 && tok < kR) ? __hip_atomic_load(ssq + tok, __ATOMIC_RELAXED, __HIP_MEMORY_SCOPE_AGENT) : -1.0f; }
#pragma unroll
        for (int ai = 0; ai < 2; ++ai)
#pragma unroll
            for (int m = 0; m < 4; ++m) rs[ai][m] = rs[ai][m] >= 0.f ? rsqrtf(rs[ai][m] * (1.0f / 1024.0f) + kEPS) : 0.f;
        if (fr >= 14) {
#pragma unroll
            for (int ai = 0; ai < 2; ++ai)
#pragma unroll
                for (int n = 0; n < 2; ++n) *(PG8_LAS f32x4*)(hx + (((2 * ai + wr) * 2 + (fr - 14)) * 128 + cj + 4 * n)) = acc[ai][0][3][n] * rs[ai][3];
        }
        epi_bar();
#pragma unroll
        for (int ai = 0; ai < 2; ++ai) {
            const int slab = 2 * ai + wr;
            f32x4 H1[2], H2[2];
#pragma unroll
            for (int n = 0; n < 2; ++n) { H1[n] = (f32x4){0.f, 0.f, 0.f, 0.f}; H2[n] = H1[n];
                if (slab > 0 && fr < 2) { H1[n] = *(const PG8_LAS f32x4*)(hx + (((slab - 1) * 2 + 1) * 128 + cj + 4 * n)); H2[n] = *(const PG8_LAS f32x4*)(hx + (((slab - 1) * 2 + 0) * 128 + cj + 4 * n)); } }
            f32x4 pr1[2], pr2[2];
#pragma unroll
            for (int m = 0; m < 4; ++m) {
                const int tok = tok0 + ai * HALF + m * 16;
                const bool owned = !(ai == 0 && wr == 0 && m == 0 && fr < 2) && tok < kR;
                const bool prompt = tok < kRP; const int t = prompt ? (tok & 2047) : ((tok - kRP) & 31); const int b = prompt ? (tok >> 11) : ((tok - kRP) >> 5); const int S = prompt ? 2048 : 32;
                unsigned pk[4];
#pragma unroll
                for (int n = 0; n < 2; ++n) {
                    const f32x4 cur = acc[ai][0][m][n] * rs[ai][m];
                    f32x4 r1, r2;
#pragma unroll
                    for (int i = 0; i < 4; ++i) { r1[i] = dpp_ror1(cur[i]); r2[i] = dpp_ror2(cur[i]); }
                    f32x4 p1, p2;
                    if (m == 0) {
#pragma unroll
                        for (int i = 0; i < 4; ++i) { p1[i] = fr == 0 ? H1[n][i] : r1[i]; p2[i] = fr == 0 ? H2[n][i] : (fr == 1 ? H1[n][i] : r2[i]); }
                    } else {
#pragma unroll
                        for (int i = 0; i < 4; ++i) { p1[i] = fr == 0 ? pr1[n][i] : r1[i]; p2[i] = fr < 2 ? pr2[n][i] : r2[i]; }
                    }
                    pr1[n] = r1; pr2[n] = r2;
                    if (owned && t < 2) {
                        const f32x4 z4 = {0.f, 0.f, 0.f, 0.f};
                        const f32x4 q1 = prompt ? z4 : *(const f32x4*)(cpast + ((size_t)b * 2 + 1) * 2816 + gc + 4 * n);
                        const f32x4 q0 = prompt ? z4 : *(const f32x4*)(cpast + ((size_t)b * 2 + 0) * 2816 + gc + 4 * n);
                        if (t == 0) { p1 = q1; p2 = q0; } else p2 = q1;
                    }
                    const f32x4 uu = acc[ai][1][m][n] * rs[ai][m];
                    f32x4 o;
#pragma unroll
                    for (int i = 0; i < 4; ++i) { const float cv = p2[i] * w0[n][i] + p1[i] * w1[n][i] + cur[i] * w2[n][i] + bb[n][i];
                        o[i] = cv * __builtin_amdgcn_rcpf(1.0f + __expf(-cv)) * uu[i]; }
                    pk[2 * n] = cvt_pk_bf16(o[0], o[1]); pk[2 * n + 1] = cvt_pk_bf16(o[2], o[3]);
                    if (owned && t >= S - 2) { float* od = out + (prompt ? off_p_conv + (size_t)b * 2 * 2816 : off_s_conv + (size_t)b * 2 * 2816) + (size_t)(t - (S - 2)) * 2816 + gc + 4 * n; *(f32x4*)od = cur; }
                }
                if (owned) *(u32x4*)(ACT + (size_t)tok * 2816 + gc) = (u32x4){pk[0], pk[1], pk[2], pk[3]};
            }
        }
        epi_bar();
    }
};

struct EpiBranchAll {
    static constexpr bool PERM = true, AFTER_DRAIN = false;
    const bf16_t* Z; bf16_t* P; bf16_t* Mb;
    __device__ __forceinline__ void operator()(const f32x4 (&acc)[2][2][4][2], const Unit& u, int wr, int wc, int fr, int fq) const {
        const int j = u.pn >> 2; Unit t; t.pm = u.pm - 66 * j; t.pn = u.pn - 4 * j;
        if (j == 0) EpiBranch<0>{Z, P, Mb}(acc, t, wr, wc, fr, fq); else if (j == 1) EpiBranch<1>{Z, P, Mb}(acc, t, wr, wc, fr, fq); else EpiBranch<2>{Z, P, Mb}(acc, t, wr, wc, fr, fq);
    }
};

struct EpiRes {
    static constexpr bool PERM = true, AFTER_DRAIN = false;
    float* X; bf16_t* Xb; float* ssq_next;
    __device__ __forceinline__ void operator()(const f32x4 (&acc)[2][2][4][2], const Unit& u, int wr, int wc, int fr_in, int fq_in) const {
        const int ln_ = hw_lane(); const int fr = ln_ & 15, fq = ln_ >> 4; (void)fr_in; (void)fq_in;
        const int row0 = u.pm * BM + wr * 64 + fr, col0 = u.pn * BM + wc * 32 + 8 * fq;
        float* x0 = X + (size_t)row0 * 1024 + col0; bf16_t* xb0 = Xb ? Xb + (size_t)row0 * 1024 + col0 : nullptr;
        f32x4 xq[2][4][2];
        auto load = [&](int slot, int b) {
            const int ai = b >> 1, mh = b & 1;
#pragma unroll
            for (int k = 0; k < 4; ++k) { const int m = 2 * mh + (k >> 1), bj = k & 1; const float* xp = x0 + (size_t)(ai * HALF + m * 16) * 1024 + bj * HALF;
                xq[slot][k][0] = *(const f32x4*)xp; xq[slot][k][1] = *(const f32x4*)(xp + 4); }
        };
        load(0, 0);
#pragma unroll
        for (int b = 0; b < 4; ++b) {
            const int slot = b & 1, ai = b >> 1, mh = b & 1;
            if (b < 3) load(slot ^ 1, b + 1);
#pragma unroll
            for (int mm = 0; mm < 2; ++mm) { const int m = 2 * mh + mm; const size_t ro = (size_t)(ai * HALF + m * 16);
                float s = 0.f;
#pragma unroll
                for (int bj = 0; bj < 2; ++bj) { const int k = 2 * mm + bj;
                    const f32x4 v0 = acc[ai][bj][m][0] + xq[slot][k][0], v1 = acc[ai][bj][m][1] + xq[slot][k][1];
                    float* xp = x0 + ro * 1024 + bj * HALF; st16(xp, v0); st16((xp + 4), v1);
                    s += sq8(v0, v1);
                    if (Xb) st16((xb0 + ro * 1024 + bj * HALF), pack8f(v0, v1)); }
                if (ssq_next) { s += sw_xor<16>(s); s = half_sum(s);
                    if (fq == 0) __hip_atomic_fetch_add(ssq_next + row0 + ai * HALF + m * 16, s, __ATOMIC_RELAXED, __HIP_MEMORY_SCOPE_AGENT); } }
        }
    }
};

template <class Epi, class Sched, bool ALIGN_EPI = false, bool SP2 = false>
__device__ __forceinline__ void gemm_phase(PG8_LAS unsigned char* lds, const Gemm g, const Sched& S, const Epi& E, int tid_in  ) {
    int tid_ = tid_in; asm volatile("" : "+v"(tid_));
    const int tid = tid_, wid = __builtin_amdgcn_readfirstlane(tid >> 6), lane = tid & 63, wr = wid >> 2, wc = wid & 3, fr = lane & 15, fq = lane >> 4;
    const int K = g.K, nt = K / BK;
    unsigned voffA[2], voffB[2];
#pragma unroll
    for (int i = 0; i < 2; ++i) { int R, C; stage_rc(tid * 16 + i * 8192, R, C); const int Rb = Epi::PERM ? ((R & ~31) + perm32(R & 31)) : R;
        voffA[i] = (unsigned)(R * g.lda + C) * 2u; voffB[i] = (unsigned)(Rb * K + C) * 2u; }
    const size_t kstep = (size_t)(BK * 2);
    const size_t hstep = (size_t)HALF * K * 2;
    const size_t tstep = 2 * hstep; const size_t hstepA = (size_t)HALF * g.lda * 2, tstepA = (size_t)g.prows * g.lda * 2;
    const unsigned ldsw = (unsigned)wid * 1024u;
    const int aoff = lds_byte(wr * 64 + fr, fq * 8), boff = lds_byte(wc * 32 + fr, fq * 8);
#define PG8_SA(b, h) (((b) * 2 + (h)) * HTB)
#define PG8_SB(b, h) ((4 + (b) * 2 + (h)) * HTB)
#define PG8_STAGE(bufoff, gbase, voff) do { _Pragma("unroll") for (int _i = 0; _i < 2; ++_i) \
        __builtin_amdgcn_global_load_lds((const unsigned*)((const char*)(gbase) + (voff)[_i]), (PG8_LAS unsigned*)(lds + (bufoff) + ldsw + _i * 8192), 16, 0, 0); } while (0)
#define PG8_LDA(dst, b, h) do { _Pragma("unroll") for (int m = 0; m < 4; ++m) _Pragma("unroll") for (int k = 0; k < 2; ++k) dst[m][k] = *(const PG8_LAS bf16x8*)(lds + PG8_SA(b, h) + aoff + m * 2048 + k * 1024); } while (0)
#define PG8_LDB(dst, b, h) do { _Pragma("unroll") for (int n = 0; n < 2; ++n) _Pragma("unroll") for (int k = 0; k < 2; ++k) dst[n][k] = *(const PG8_LAS bf16x8*)(lds + PG8_SB(b, h) + boff + n * 2048 + k * 1024); } while (0)
#define PG8_MMA(ai, bj, At, Bt) do { __builtin_amdgcn_s_setprio(1); _Pragma("unroll") for (int m = 0; m < 4; ++m) _Pragma("unroll") for (int n = 0; n < 2; ++n) _Pragma("unroll") for (int k = 0; k < 2; ++k) \
        acc[ai][bj][m][n] = __builtin_amdgcn_mfma_f32_16x16x32_bf16(Bt[n][k], At[m][k], acc[ai][bj][m][n], 0, 0, 0); __builtin_amdgcn_s_setprio(0); } while (0)
#define PG8_WAIT_V(n) asm volatile("s_waitcnt vmcnt(" #n ")" ::: "memory")
#define PG8_WAIT_L(n) asm volatile("s_waitcnt lgkmcnt(" #n ")" ::: "memory")
#define PG8_BAR __builtin_amdgcn_s_barrier()
#define PG8_SCHED __builtin_amdgcn_sched_barrier(0)
    Unit cur, nxt; int ui = 0;
    if (!S.next(0, cur)) return;
    f32x4 acc[2][2][4][2];
#pragma unroll
    for (int a = 0; a < 2; ++a)
#pragma unroll
        for (int b = 0; b < 2; ++b)
#pragma unroll
            for (int m = 0; m < 4; ++m)
#pragma unroll
                for (int n = 0; n < 2; ++n) acc[a][b][m][n] = (f32x4){0.f, 0.f, 0.f, 0.f};
    bf16x8 At[4][2], B0[2][2], B1[2][2];
    const char* cA = (const char*)g.A + (size_t)cur.pm * tstepA; const char* cB = (const char*)g.Bt + (size_t)cur.pn * tstep;
    S.a_ready(cur);
    if constexpr (SP2) {
        PG8_STAGE(PG8_SB(0, 0), cB, voffB); PG8_STAGE(PG8_SB(0, 1), cB + hstep, voffB); PG8_STAGE(PG8_SA(0, 0), cA, voffA); PG8_STAGE(PG8_SA(0, 1), cA + hstepA, voffA);
        if (wr == 1) PG8_BAR;
        PG8_WAIT_V(2); PG8_BAR;
        PG8_STAGE(PG8_SB(1, 0), cB + kstep, voffB); PG8_STAGE(PG8_SA(1, 0), cA + kstep, voffA); PG8_STAGE(PG8_SB(1, 1), cB + hstep + kstep, voffB);
        PG8_WAIT_V(6); PG8_BAR;
    } else {
        PG8_STAGE(PG8_SB(0, 0), cB, voffB); PG8_STAGE(PG8_SA(0, 0), cA, voffA); PG8_STAGE(PG8_SB(0, 1), cB + hstep, voffB); PG8_STAGE(PG8_SA(0, 1), cA + hstepA, voffA);
        if (wr == 1) PG8_BAR;
        PG8_WAIT_V(4); PG8_BAR;
        PG8_STAGE(PG8_SB(1, 0), cB + kstep, voffB); PG8_STAGE(PG8_SA(1, 0), cA + kstep, voffA); PG8_STAGE(PG8_SB(1, 1), cB + hstep + kstep, voffB);
        PG8_WAIT_V(6); PG8_BAR;
    }
    for (;;) {
        const bool has_next = S.next(ui + 1, nxt);
        const char* nA = has_next ? (const char*)g.A + (size_t)nxt.pm * tstepA : cA; const char* nB = has_next ? (const char*)g.Bt + (size_t)nxt.pn * tstep : cB;
        for (int t = 0; t < nt; t += 2) {
            const bool last = (t == nt - 2);
            const char* a1 = cA + (size_t)(t + 1) * kstep;
            const char* a2 = last ? nA : cA + (size_t)(t + 2) * kstep; const char* b2 = last ? nB : cB + (size_t)(t + 2) * kstep;
            const char* a3 = a2 + kstep; const char* b3 = b2 + kstep;
            if (last && has_next) S.a_ready(nxt);
            if constexpr (SP2) {
            PG8_LDB(B0, 0, 0); PG8_LDB(B1, 0, 1); PG8_SCHED; PG8_LDA(At, 0, 0); PG8_STAGE(PG8_SA(1, 1), a1 + hstepA, voffA);
            PG8_WAIT_V(8); PG8_WAIT_L(0); PG8_BAR; PG8_MMA(0, 0, At, B0); PG8_MMA(0, 1, At, B1); PG8_BAR; PG8_SCHED;
            PG8_LDA(At, 0, 1); PG8_STAGE(PG8_SB(0, 0), b2, voffB); PG8_STAGE(PG8_SB(0, 1), b2 + hstep, voffB); PG8_STAGE(PG8_SA(0, 0), a2, voffA);
            PG8_WAIT_V(8); PG8_WAIT_L(0); PG8_BAR; PG8_MMA(1, 0, At, B0); PG8_MMA(1, 1, At, B1); PG8_BAR; PG8_SCHED;
            PG8_LDB(B0, 1, 0); PG8_LDB(B1, 1, 1); PG8_SCHED; PG8_LDA(At, 1, 0); PG8_STAGE(PG8_SA(0, 1), a2 + hstepA, voffA);
            PG8_WAIT_V(8); PG8_WAIT_L(0); PG8_BAR; PG8_MMA(0, 0, At, B0); PG8_MMA(0, 1, At, B1); PG8_BAR; PG8_SCHED;
            PG8_LDA(At, 1, 1); PG8_STAGE(PG8_SB(1, 0), b3, voffB); PG8_STAGE(PG8_SB(1, 1), b3 + hstep, voffB); PG8_STAGE(PG8_SA(1, 0), a3, voffA);
            PG8_WAIT_V(8); PG8_WAIT_L(0); PG8_BAR; PG8_MMA(1, 0, At, B0); PG8_MMA(1, 1, At, B1); PG8_BAR; PG8_SCHED;
            } else {
            PG8_LDB(B0, 0, 0); PG8_SCHED; PG8_LDA(At, 0, 0); PG8_STAGE(PG8_SA(1, 1), a1 + hstepA, voffA);
            PG8_WAIT_L(8); PG8_BAR; PG8_WAIT_L(0); PG8_MMA(0, 0, At, B0); PG8_BAR; PG8_SCHED;
            PG8_LDB(B1, 0, 1); PG8_STAGE(PG8_SB(0, 0), b2, voffB);
            PG8_BAR; PG8_WAIT_L(0); PG8_MMA(0, 1, At, B1); PG8_BAR;
            PG8_LDA(At, 0, 1); PG8_STAGE(PG8_SA(0, 0), a2, voffA);
            PG8_BAR; PG8_WAIT_L(0); PG8_MMA(1, 0, At, B0); PG8_BAR; PG8_SCHED;
            PG8_STAGE(PG8_SB(0, 1), b2 + hstep, voffB);
            PG8_WAIT_V(6); PG8_BAR; PG8_MMA(1, 1, At, B1); PG8_BAR;
            PG8_LDB(B0, 1, 0); PG8_SCHED; PG8_LDA(At, 1, 0); PG8_STAGE(PG8_SA(0, 1), a2 + hstepA, voffA);
            PG8_WAIT_L(8); PG8_BAR; PG8_WAIT_L(0); PG8_MMA(0, 0, At, B0); PG8_BAR; PG8_SCHED;
            PG8_LDB(B1, 1, 1); PG8_STAGE(PG8_SB(1, 0), b3, voffB);
            PG8_BAR; PG8_WAIT_L(0); PG8_MMA(0, 1, At, B1); PG8_BAR;
            PG8_LDA(At, 1, 1); PG8_STAGE(PG8_SA(1, 0), a3, voffA);
            PG8_BAR; PG8_WAIT_L(0); PG8_MMA(1, 0, At, B0); PG8_BAR; PG8_SCHED;
            PG8_STAGE(PG8_SB(1, 1), b3 + hstep, voffB);
            PG8_WAIT_V(6); PG8_BAR; PG8_MMA(1, 1, At, B1); PG8_BAR;
            }
        }
        if constexpr (ALIGN_EPI) { if (wr == 0) PG8_BAR; }
        if constexpr (!Epi::AFTER_DRAIN) { E(acc, cur, wr, wc, fr, fq); S.done(cur); }
        if (!has_next) break;
#pragma unroll
        for (int a = 0; a < 2; ++a)
#pragma unroll
            for (int b = 0; b < 2; ++b)
#pragma unroll
                for (int m = 0; m < 4; ++m)
#pragma unroll
                    for (int n = 0; n < 2; ++n) acc[a][b][m][n] = (f32x4){0.f, 0.f, 0.f, 0.f};
        cur = nxt; cA = nA; cB = nB; ++ui;
        if constexpr (ALIGN_EPI) { if (wr == 1) PG8_BAR; }
    }
    PG8_WAIT_V(0);
    if constexpr (!ALIGN_EPI) { if (wr == 0) PG8_BAR; }
    PG8_BAR;
    if constexpr (Epi::AFTER_DRAIN) { E.fused(acc, cur, wr, wc, fr, fq, lds, wid, lane); S.done(cur); }
#undef PG8_SA
#undef PG8_SB
#undef PG8_STAGE
#undef PG8_LDA
#undef PG8_LDB
#undef PG8_MMA
#undef PG8_WAIT_V
#undef PG8_WAIT_L
#undef PG8_BAR
#undef PG8_SCHED
}
}
using pg8::kR; using pg8::kRP; using pg8::kRS; using pg8::kZW; using pg8::kEPS;
using pg8::ZC_CQ; using pg8::ZC_CKV; using pg8::ZC_KR; using pg8::ZC_SQ; using pg8::ZC_SK; using pg8::ZC_SV; using pg8::ZC_DQ; using pg8::ZC_DK; using pg8::ZC_DV; using pg8::ZC_G;
constexpr int NWAVES = 8;
constexpr int NIN0 = 6560, DFF = 2816, PASTL = 4096, NCACHE = 16 * 4096;
constexpr float LOG2E = 1.4426950408889634f;
constexpr float QS_MLA = 0.10206207261596577f * LOG2E;
constexpr float QS_64 = 0.125f * LOG2E;

constexpr size_t OUT_YP = 0;
constexpr size_t OUT_YS = OUT_YP + (size_t)kRP * 1024;
constexpr size_t OUT_PCKV = OUT_YS + (size_t)kRS * 1024;
constexpr size_t OUT_PKR = OUT_PCKV + (size_t)2 * kRP * 128;
constexpr size_t OUT_PSBK = OUT_PKR + (size_t)2 * kRP * 32;
constexpr size_t OUT_PSBV = OUT_PSBK + (size_t)2 * kRP * 512;
constexpr size_t OUT_PDK = OUT_PSBV + (size_t)2 * kRP * 512;
constexpr size_t OUT_PDV = OUT_PDK + (size_t)2 * kRP * 512;
constexpr size_t OUT_PCONV = OUT_PDV + (size_t)2 * kRP * 512;
constexpr size_t OUT_SCKV = OUT_PCONV + (size_t)2 * 8 * 2 * DFF;
constexpr size_t OUT_SKR = OUT_SCKV + (size_t)2 * kRS * 128;
constexpr size_t OUT_SSBK = OUT_SKR + (size_t)2 * kRS * 32;
constexpr size_t OUT_SSBV = OUT_SSBK + (size_t)2 * kRS * 512;
constexpr size_t OUT_SDK = OUT_SSBV + (size_t)2 * kRS * 512;
constexpr size_t OUT_SDV = OUT_SDK + (size_t)2 * kRS * 512;
constexpr size_t OUT_SCONV = OUT_SDV + (size_t)2 * kRS * 512;

enum { IN_XP = 0, IN_XS, IN_CCKV, IN_CKR, IN_CSBK, IN_CSBV, IN_CDK, IN_CDV, IN_CONV, IN_MIXG, IN_WIN, IN_QNG, IN_WUQ, IN_KVNG, IN_WUK, IN_WUV, IN_QN_G, IN_KN_G, IN_QR_G, IN_KR_G,
       IN_DQN_G, IN_DKN_G, IN_LAMBDA, IN_SUBLN_G, IN_WBR_MLA, IN_WBR_SB, IN_WBR_DIFF, IN_WOUT, IN_FFNG, IN_WUP, IN_CONVW, IN_CONVB, IN_WDOWN, N_INPUTS };

constexpr size_t MiB = 1u << 20;
constexpr size_t WS_CTL = 0, CTL_ZERO_BYTES = 2 * MiB;
constexpr int CW_BAR = 1024;
constexpr int CW_WQ = 8192;
constexpr int CW_SSQ = 16384;
static_assert((CW_SSQ + 4 * kR) * 4 <= (int)CTL_ZERO_BYTES, "ctl region");
constexpr size_t WL_IN = 0, WL_UQ = WL_IN + (size_t)kZW * 1024 * 2, WL_UKV = WL_UQ + (size_t)768 * 256 * 2, WL_BR = WL_UKV + (size_t)1024 * 128 * 2,
                 WL_OUT = WL_BR + (size_t)3 * 1024 * 512 * 2, WL_UP = WL_OUT + (size_t)1024 * 1024 * 2, WL_DOWN = WL_UP + (size_t)5632 * 1024 * 2, WL_SIZE = WL_DOWN + (size_t)1024 * 2816 * 2;
constexpr size_t WS_W = 2 * MiB;
constexpr size_t WS_XB = WS_W + 2 * WL_SIZE;
#ifndef WS_TRANS_BASE
#define WS_TRANS_BASE (WS_XB + (size_t)kR * 1024 * 2)
#endif
constexpr size_t WS_Z = WS_TRANS_BASE;
constexpr size_t WS_Q = WS_Z + (size_t)kR * kZW * 2;
constexpr size_t WS_KNMV = WS_Q + (size_t)kR * 768 * 2;
constexpr size_t WS_KMLA = WS_KNMV + (size_t)kR * 1024 * 2;
constexpr size_t WS_CKVB = WS_KMLA + (size_t)kR * 768 * 2;
constexpr size_t WS_KNMVC = WS_CKVB + (size_t)2 * NCACHE * 128 * 2;
constexpr size_t WS_KMLAC = WS_KNMVC + (size_t)NCACHE * 1024 * 2;
constexpr size_t WS_ROPE = WS_KMLAC + (size_t)2 * NCACHE * 768 * 2;
constexpr size_t WS_O = WS_ROPE + (size_t)2080 * 32 * 4;
constexpr size_t WS_MP = WS_O + (size_t)3 * kR * 512 * 2;
constexpr size_t WS_MB = WS_MP + (size_t)kR * 1024 * 4;
constexpr size_t WS_ACT = WS_MB + (size_t)kR * 1024 * 2;
constexpr size_t WS_FAST_END = WS_ACT + (size_t)kR * DFF * 2;
constexpr size_t WS_AU = WS_Z;

constexpr int RING_BYTES = 131072;
constexpr int MISC_OFF = RING_BYTES + 8192;
constexpr int LDS_BYTES = 147456;

#define GAS __attribute__((address_space(1)))
#define LAS __attribute__((address_space(3)))
typedef unsigned short bf16;
typedef unsigned v4u __attribute__((ext_vector_type(4)));
typedef unsigned v2u __attribute__((ext_vector_type(2)));
typedef float f32x4 __attribute__((ext_vector_type(4)));
typedef float f32x2 __attribute__((ext_vector_type(2)));
__device__ __forceinline__ unsigned f2bf(float f) { unsigned u = __builtin_bit_cast(unsigned, f); return (u + 0x7fffu + ((u >> 16) & 1u)) >> 16; }
__device__ __forceinline__ unsigned pk2(float lo, float hi) { return f2bf(lo) | (f2bf(hi) << 16); }
__device__ __forceinline__ float bflo(unsigned w) { return __uint_as_float(w << 16); }
__device__ __forceinline__ float bfhi(unsigned w) { return __uint_as_float(w & 0xffff0000u); }
__device__ __forceinline__ float bf1(bf16 h) { return __uint_as_float((unsigned)h << 16); }
__device__ __forceinline__ float wave_sum(float v) {
    v += sw_xor<1>(v); v += sw_xor<2>(v); v += sw_xor<4>(v); v += sw_xor<8>(v); v += sw_xor<16>(v);
    return half_sum(v);
}
#define LDS_WAIT() asm volatile("s_waitcnt lgkmcnt(0)" ::: "memory")

struct Args { const float* in[N_INPUTS]; float* out; unsigned char* ws; int layer; int pad; };
typedef const Args __attribute__((address_space(4)))* CArgsP;

__device__ __forceinline__ int row_pos(int row) { return row < kRP ? (row & 2047) : PASTL + ((row - kRP) & 31); }
__device__ __forceinline__ float rope_inv16(int i) { return exp2f(-(float)i * (13.287712379549449f / 16.0f)); }

__device__ __forceinline__ void transpose_item(const float* W, int ldw, int k0, int scol, bf16* WT, int K, int n0, const float* gk, LAS float* scr, int lane) {
    float tv[32];
#pragma unroll
    for (int i = 0; i < 32; ++i) { const int kk = 2 * i + (lane >> 5); tv[i] = scol >= 0 ? __builtin_nontemporal_load(W + (size_t)(k0 + kk) * ldw + scol + (lane & 31)) : 0.f; }
    if (gk) {
#pragma unroll
        for (int i = 0; i < 32; ++i) tv[i] *= gk[k0 + 2 * i + (lane >> 5)]; }
#pragma unroll
    for (int i = 0; i < 32; ++i) scr[(2 * i + (lane >> 5)) * 33 + (lane & 31)] = tv[i];
    LDS_WAIT(); asm volatile("" ::: "memory");
    const int c = lane & 7;
#pragma unroll
    for (int j = 0; j < 4; ++j) { const int n = (lane >> 3) + 8 * j; const LAS float* s = scr + (8 * c) * 33 + n;
        v4u o; o.x = pk2(s[0 * 33], s[1 * 33]); o.y = pk2(s[2 * 33], s[3 * 33]); o.z = pk2(s[4 * 33], s[5 * 33]); o.w = pk2(s[6 * 33], s[7 * 33]);
        *(v4u*)(WT + (size_t)(n0 + n) * K + k0 + 8 * c) = o; }
    LDS_WAIT(); asm volatile("" ::: "memory");
}
struct TMat { const float* W; int ldw; int K; int Ndst; bf16* WT; const float* gk; int kind; int perm; };
__device__ __forceinline__ int tmat_items(const TMat& m) { return (m.K / 64) * (m.Ndst / 32); }
__device__ __forceinline__ void tmat_do(const TMat& m, int item, LAS float* scr, int lane) {
    const int ng = m.Ndst / 32, kb = item / ng, g = item % ng;
    int L = g * 32;
    if (m.perm) { const int tile = g >> 3, g32 = g & 7; L = tile * 256 + 64 * (g32 & 3) + 32 * (g32 >> 2); }
    int scol = L;
    if (m.kind == 1) scol = L < 416 ? L : (L < 512 ? -1 : L - 96);
    if (m.kind == 2) scol = L < 512 ? (L >> 6) * 96 + (L & 63) : ((L - 512) >> 5) * 96 + 64;
    if (m.kind == 3) { const int tile = g >> 3, g32 = g & 7; scol = g32 < 4 ? 128 * tile + 32 * g32 : 2816 + 128 * tile + 32 * (g32 - 4); }
    transpose_item(m.W, m.ldw, kb * 64, scol, m.WT, m.K, g * 32, m.gk, scr, lane);
}

namespace p0w {
constexpr int NI0 = (1024 / 64) * (kZW / 32), NI1 = (256 / 64) * (768 / 32), NI2 = (128 / 64) * (512 / 32), NI4 = (512 / 64) * (1024 / 32), NI7 = (1024 / 64) * (1024 / 32),
              NI8 = (1024 / 64) * (5632 / 32), NI9 = (DFF / 64) * (1024 / 32);
constexpr int C1 = NI0, C2 = C1 + NI1, C3 = C2 + NI2, C4 = C3 + NI2, C5 = C4 + NI4, C6 = C5 + NI4, C7 = C6 + NI4, C8 = C7 + NI7, C9 = C8 + NI8, CL = C9 + NI9;
constexpr int CHUNK = 64, NCHUNK = (CL + CHUNK - 1) / CHUNK;
}
__device__ __forceinline__ void p0_weight_item(CArgsP a, int it  , LAS float* scr, int lane) {
    using namespace p0w;
    unsigned char* ws = a->ws;
    const int l = it >= CL ? 1 : 0, r = it - l * CL;
    bf16* wl = (bf16*)(ws + WS_W + (size_t)l * WL_SIZE);
    if (r < C1)      tmat_do(TMat{a->in[IN_WIN] + (size_t)l * 1024 * NIN0, NIN0, 1024, kZW, (bf16*)((unsigned char*)wl + WL_IN), a->in[IN_MIXG] + l * 1024, 1, 1}, r, scr, lane);
    else if (r < C2) tmat_do(TMat{a->in[IN_WUQ] + (size_t)l * 256 * 768, 768, 256, 768, (bf16*)((unsigned char*)wl + WL_UQ), nullptr, 2, 1}, r - C1, scr, lane);
    else if (r < C3) tmat_do(TMat{a->in[IN_WUK] + (size_t)l * 128 * 512, 512, 128, 512, (bf16*)((unsigned char*)wl + WL_UKV), nullptr, 0, 1}, r - C2, scr, lane);
    else if (r < C4) tmat_do(TMat{a->in[IN_WUV] + (size_t)l * 128 * 512, 512, 128, 512, (bf16*)((unsigned char*)wl + WL_UKV) + (size_t)512 * 128, nullptr, 0, 1}, r - C3, scr, lane);
    else if (r < C5) tmat_do(TMat{a->in[IN_WBR_MLA] + (size_t)l * 512 * 1024, 1024, 512, 1024, (bf16*)((unsigned char*)wl + WL_BR), nullptr, 0, 0}, r - C4, scr, lane);
    else if (r < C6) tmat_do(TMat{a->in[IN_WBR_SB] + (size_t)l * 512 * 1024, 1024, 512, 1024, (bf16*)((unsigned char*)wl + WL_BR) + (size_t)1024 * 512, nullptr, 0, 0}, r - C5, scr, lane);
    else if (r < C7) tmat_do(TMat{a->in[IN_WBR_DIFF] + (size_t)l * 512 * 1024, 1024, 512, 1024, (bf16*)((unsigned char*)wl + WL_BR) + (size_t)2 * 1024 * 512, nullptr, 0, 0}, r - C6, scr, lane);
    else if (r < C8) tmat_do(TMat{a->in[IN_WOUT] + (size_t)l * 1024 * 1024, 1024, 1024, 1024, (bf16*)((unsigned char*)wl + WL_OUT), nullptr, 0, 0}, r - C7, scr, lane);
    else if (r < C9) tmat_do(TMat{a->in[IN_WUP] + (size_t)l * 1024 * 5632, 5632, 1024, 5632, (bf16*)((unsigned char*)wl + WL_UP), a->in[IN_FFNG] + l * 1024, 3, 0}, r - C8, scr, lane);
    else             tmat_do(TMat{a->in[IN_WDOWN] + (size_t)l * DFF * 1024, 1024, DFF, 1024, (bf16*)((unsigned char*)wl + WL_DOWN), nullptr, 0, 0}, r - C9, scr, lane);
}
__device__ __forceinline__ void p0_phase(CArgsP a, LAS unsigned char* lds, int gw, int NGW, int wave, int lane) {
    LAS float* scr = (LAS float*)(lds + wave * 16384);
    unsigned char* ws = a->ws;
    for (int it = gw; it < p0w::CL; it += NGW) p0_weight_item(a, it, scr, lane);
    float* ssq0 = (float*)(ws + WS_CTL) + CW_SSQ;
    bf16* xb = (bf16*)(ws + WS_XB);
    for (int row0 = gw; row0 < kR; row0 += 2 * NGW) {
        f32x4 v[2][4]; int rows[2]; bool ok[2];
#pragma unroll
        for (int k = 0; k < 2; ++k) { const int row = row0 + k * NGW; ok[k] = row < kR; rows[k] = ok[k] ? row : row0;
            const float* src = rows[k] < kRP ? a->in[IN_XP] + (size_t)rows[k] * 1024 : a->in[IN_XS] + (size_t)(rows[k] - kRP) * 1024;
#pragma unroll
            for (int j = 0; j < 4; ++j) v[k][j] = *((const f32x4*)src + lane + 64 * j); }
#pragma unroll
        for (int k = 0; k < 2; ++k) { if (!ok[k]) continue;
            float* dst = a->out + (size_t)rows[k] * 1024; float s = 0.f;
#pragma unroll
            for (int j = 0; j < 4; ++j) { const f32x4 x = v[k][j]; *((f32x4*)dst + lane + 64 * j) = x;
                s += (x.x * x.x + x.y * x.y) + (x.z * x.z + x.w * x.w);
                v2u w; w.x = pk2(x.x, x.y); w.y = pk2(x.z, x.w); *((v2u*)(xb + (size_t)rows[k] * 1024) + lane + 64 * j) = w; }
            s = wave_sum(s); if (lane == 0) ssq0[rows[k]] = s; }
    }
    { const float* src = a->in[IN_CKR]; bf16* dst = (bf16*)(ws + WS_KMLAC); const size_t n4 = (size_t)2 * NCACHE * 4;
      const size_t st = (size_t)NGW * 64;
      for (size_t i0 = (size_t)gw * 64 + lane; i0 < n4; i0 += 4 * st) { f32x4 v0[4], v1[4];
#pragma unroll
          for (int k = 0; k < 4; ++k) { const size_t i = i0 + k * st < n4 ? i0 + k * st : i0; const size_t row = i >> 2; const int c8 = (int)(i & 3) * 8;
              v0[k] = __builtin_nontemporal_load((const f32x4*)(src + row * 32 + c8)); v1[k] = __builtin_nontemporal_load((const f32x4*)(src + row * 32 + c8 + 4)); }
#pragma unroll
          for (int k = 0; k < 4; ++k) { const size_t i = i0 + k * st; if (i >= n4) continue; const size_t row = i >> 2; const int c8 = (int)(i & 3) * 8;
              v4u w; w.x = pk2(v0[k].x, v0[k].y); w.y = pk2(v0[k].z, v0[k].w); w.z = pk2(v1[k].x, v1[k].y); w.w = pk2(v1[k].z, v1[k].w);
#pragma unroll
              for (int h = 0; h < 8; ++h) *(v4u*)(dst + row * 768 + h * 96 + 64 + c8) = w; } } }
    { constexpr size_t n8 = (size_t)2 * NCACHE * 128 / 8; const float* src = a->in[IN_CCKV]; bf16* dst = (bf16*)(ws + WS_CKVB); const size_t st = (size_t)NGW * 64;
      for (size_t i0 = (size_t)gw * 64 + lane; i0 < n8; i0 += 4 * st) { f32x4 v0[4], v1[4];
#pragma unroll
          for (int k = 0; k < 4; ++k) { const size_t i = i0 + k * st < n8 ? i0 + k * st : i0; v0[k] = __builtin_nontemporal_load((const f32x4*)src + 2 * i); v1[k] = __builtin_nontemporal_load((const f32x4*)src + 2 * i + 1); }
#pragma unroll
          for (int k = 0; k < 4; ++k) { const size_t i = i0 + k * st; if (i < n8) { v4u w; w.x = pk2(v0[k].x, v0[k].y); w.y = pk2(v0[k].z, v0[k].w); w.z = pk2(v1[k].x, v1[k].y); w.w = pk2(v1[k].z, v1[k].w); *((v4u*)dst + i) = w; } } } }
}

__device__ __forceinline__ void post_in_phase(CArgsP a, int l, int gw, int NGW, int lane) {
    bf16* Z = (bf16*)(a->ws + WS_Z);
    const float* qng = a->in[IN_QNG] + l * 256; const float* kvng = a->in[IN_KVNG] + l * 128; const float* krg = a->in[IN_KR_G] + l * 32;
    const float* dqg = a->in[IN_DQN_G] + l * 64; const float* dkg = a->in[IN_DKN_G] + l * 64;
    for (int row = gw; row < kR; row += NGW) {
        bf16* z = Z + (size_t)row * kZW;
        const bool prompt = row < kRP; const size_t crow = prompt ? (size_t)l * kRP + row : (size_t)l * kRS + (row - kRP);
        const int pos = row_pos(row);
        { const v2u w = *(const v2u*)(z + ZC_CQ + 4 * lane); float f0 = bflo(w.x), f1 = bfhi(w.x), f2 = bflo(w.y), f3 = bfhi(w.y);
          const float rs = rsqrtf(wave_sum((f0 * f0 + f1 * f1) + (f2 * f2 + f3 * f3)) * (1.f / 256.f) + kEPS); const f32x4 g = *(const f32x4*)(qng + 4 * lane);
          v2u o; o.x = pk2(f0 * rs * g.x, f1 * rs * g.y); o.y = pk2(f2 * rs * g.z, f3 * rs * g.w); *(v2u*)(z + ZC_CQ + 4 * lane) = o; }
        { const unsigned w = *(const unsigned*)(z + ZC_CKV + 2 * lane); float f0 = bflo(w), f1 = bfhi(w);
          const float rs = rsqrtf(wave_sum(f0 * f0 + f1 * f1) * (1.f / 128.f) + kEPS); const f32x2 g = *(const f32x2*)(kvng + 2 * lane);
          f0 = f0 * rs * g.x; f1 = f1 * rs * g.y; *(unsigned*)(z + ZC_CKV + 2 * lane) = pk2(f0, f1);
          float* o = a->out + (prompt ? OUT_PCKV : OUT_SCKV) + crow * 128 + 2 * lane; *(f32x2*)o = (f32x2){f0, f1}; }
        { float f = lane < 32 ? bf1(z[ZC_KR + lane]) : 0.f; const float rs = rsqrtf(wave_sum(f * f) * (1.f / 32.f) + kEPS);
          const float fn = lane < 32 ? f * rs * krg[lane & 31] : 0.f; const float other = sw_xor<16>(fn);
          const int i = lane & 15; float sn, cs; sincosf((float)pos * rope_inv16(i), &sn, &cs);
          const float o = (lane & 16) ? (other * sn + fn * cs) : (fn * cs - other * sn);
          if (lane < 32) { a->out[(prompt ? OUT_PKR : OUT_SKR) + crow * 32 + lane] = o; z[ZC_KR + lane] = (bf16)f2bf(o); } }
        { v4u w = *(const v4u*)(z + ZC_SQ + 8 * lane);
          w.x = pk2(bflo(w.x) * QS_64, bfhi(w.x) * QS_64); w.y = pk2(bflo(w.y) * QS_64, bfhi(w.y) * QS_64); w.z = pk2(bflo(w.z) * QS_64, bfhi(w.z) * QS_64); w.w = pk2(bflo(w.w) * QS_64, bfhi(w.w) * QS_64);
          *(v4u*)(z + ZC_SQ + 8 * lane) = w; }
        { const v4u w = *(const v4u*)(z + ZC_DQ + 8 * lane); float f[8] = {bflo(w.x), bfhi(w.x), bflo(w.y), bfhi(w.y), bflo(w.z), bfhi(w.z), bflo(w.w), bfhi(w.w)};
          float s = 0.f;
#pragma unroll
          for (int i = 0; i < 8; ++i) s += f[i] * f[i];
          s += sw_xor<1>(s); s += sw_xor<2>(s); s += sw_xor<4>(s);
          const float rs = rsqrtf(s * (1.f / 64.f) + kEPS) * QS_64; const float* g = dqg + 8 * (lane & 7);
          v4u o; o.x = pk2(f[0] * rs * g[0], f[1] * rs * g[1]); o.y = pk2(f[2] * rs * g[2], f[3] * rs * g[3]); o.z = pk2(f[4] * rs * g[4], f[5] * rs * g[5]); o.w = pk2(f[6] * rs * g[6], f[7] * rs * g[7]);
          *(v4u*)(z + ZC_DQ + 8 * lane) = o; }
        { const v4u w = *(const v4u*)(z + ZC_DK + 8 * lane); float f[8] = {bflo(w.x), bfhi(w.x), bflo(w.y), bfhi(w.y), bflo(w.z), bfhi(w.z), bflo(w.w), bfhi(w.w)};
          float s = 0.f;
#pragma unroll
          for (int i = 0; i < 8; ++i) s += f[i] * f[i];
          s += sw_xor<1>(s); s += sw_xor<2>(s); s += sw_xor<4>(s);
          const float rs = rsqrtf(s * (1.f / 64.f) + kEPS); const float* g = dkg + 8 * (lane & 7);
#pragma unroll
          for (int i = 0; i < 8; ++i) f[i] = f[i] * rs * g[i];
          v4u o; o.x = pk2(f[0], f[1]); o.y = pk2(f[2], f[3]); o.z = pk2(f[4], f[5]); o.w = pk2(f[6], f[7]);
          *(v4u*)(z + ZC_DK + 8 * lane) = o;
          float* od = a->out + (prompt ? OUT_PDK : OUT_SDK) + crow * 512 + 8 * lane; *(f32x4*)od = (f32x4){f[0], f[1], f[2], f[3]}; *(f32x4*)(od + 4) = (f32x4){f[4], f[5], f[6], f[7]}; }
    }
}

__device__ __forceinline__ void post_qk_phase(CArgsP a, int l, int gw, int NGW, int lane) {
    bf16* Q = (bf16*)(a->ws + WS_Q); const bf16* KNMV = (const bf16*)(a->ws + WS_KNMV); bf16* KM = (bf16*)(a->ws + WS_KMLA); const bf16* Z = (const bf16*)(a->ws + WS_Z);
    const float* qng = a->in[IN_QN_G] + l * 64; const float* qrg = a->in[IN_QR_G] + l * 32; const float* kng = a->in[IN_KN_G] + l * 64;
    for (int row = gw; row < kR; row += NGW) {
        const int pos = row_pos(row);
        const int i = lane & 15; float sn, cs; sincosf((float)pos * rope_inv16(i), &sn, &cs);
        const bf16 krv = lane < 32 ? Z[(size_t)row * kZW + ZC_KR + lane] : (bf16)0;
        for (int h = 0; h < 8; ++h) {
            bf16* q = Q + (size_t)row * 768 + h * 96;
            const float v = bf1(q[lane]); const float rs = rsqrtf(wave_sum(v * v) * (1.f / 64.f) + kEPS);
            const float w = lane < 32 ? bf1(q[64 + lane]) : 0.f; const float rs2 = rsqrtf(wave_sum(w * w) * (1.f / 32.f) + kEPS);
            const float wn = lane < 32 ? w * rs2 * qrg[lane & 31] : 0.f; const float other = sw_xor<16>(wn);
            const float o = (lane & 16) ? (other * sn + wn * cs) : (wn * cs - other * sn);
            q[lane] = (bf16)f2bf(v * rs * qng[lane] * QS_MLA);
            if (lane < 32) q[64 + lane] = (bf16)f2bf(o * QS_MLA);
            const float kv = bf1(KNMV[(size_t)row * 1024 + h * 64 + lane]); const float rk = rsqrtf(wave_sum(kv * kv) * (1.f / 64.f) + kEPS);
            bf16* km = KM + (size_t)row * 768 + h * 96;
            km[lane] = (bf16)f2bf(kv * rk * kng[lane]);
            if (lane < 32) km[64 + lane] = krv;
        }
    }
}
__device__ __forceinline__ void post_kc_phase(CArgsP a, int l, int gw, int NGW, int lane) {
    const bf16* KNMVC = (const bf16*)(a->ws + WS_KNMVC); bf16* KMC = (bf16*)(a->ws + WS_KMLAC);
    const float* kng = a->in[IN_KN_G] + l * 64; const float* ckr = a->in[IN_CKR] + (size_t)l * NCACHE * 32;
    for (int row = gw; row < NCACHE; row += NGW) {
        const bf16 krv = lane < 32 ? (bf16)f2bf(ckr[(size_t)row * 32 + lane]) : (bf16)0;
        for (int h = 0; h < 8; ++h) {
            const float kv = bf1(KNMVC[(size_t)row * 1024 + h * 64 + lane]); const float rk = rsqrtf(wave_sum(kv * kv) * (1.f / 64.f) + kEPS);
            bf16* km = KMC + (size_t)row * 768 + h * 96;
            km[lane] = (bf16)f2bf(kv * rk * kng[lane]);
            if (lane < 32) km[64 + lane] = krv;
        }
    }
}

__device__ __forceinline__ void conv_phase(CArgsP a, int l, int gw, int NGW, int lane) {
    const bf16* __restrict__ AU = (const bf16*)(a->ws + WS_AU); bf16* __restrict__ ACT = (bf16*)(a->ws + WS_ACT);
    const float* __restrict__ cw = a->in[IN_CONVW] + (size_t)l * 3 * DFF; const float* __restrict__ cb = a->in[IN_CONVB] + (size_t)l * DFF; const float* __restrict__ cpast = a->in[IN_CONV] + (size_t)l * 16 * 2 * DFF;
    float* __restrict__ outp = a->out;
    constexpr int CG = DFF / 8;
    constexpr int NIT = kR * CG;
    constexpr int U = 4;
    const int stride = NGW * 64;
    for (int it0 = gw * 64 + lane; it0 < NIT; it0 += U * stride) {
        v4u wa[U], wu[U], w1[U], w2[U]; int row[U], c0[U]; bool ok[U];
#pragma unroll
        for (int k = 0; k < U; ++k) { const int it = it0 + k * stride; ok[k] = it < NIT; const int itc = ok[k] ? it : it0; row[k] = itc / CG; c0[k] = (itc % CG) * 8;
            const bool prompt = row[k] < kRP; const int t = prompt ? (row[k] & 2047) : ((row[k] - kRP) & 31);
            const bf16* ap = AU + (size_t)row[k] * 5632 + c0[k];
            wa[k] = *(const v4u*)ap; wu[k] = *(const v4u*)(ap + DFF);
            w1[k] = *(const v4u*)(ap - (t >= 1 ? 5632 : 0)); w2[k] = *(const v4u*)(ap - (t >= 2 ? 2 * 5632 : 0)); }
#pragma unroll
        for (int k = 0; k < U; ++k) { if (!ok[k]) continue;
            const bool prompt = row[k] < kRP; const int t = prompt ? (row[k] & 2047) : ((row[k] - kRP) & 31); const int b = prompt ? (row[k] >> 11) : ((row[k] - kRP) >> 5); const int S = prompt ? 2048 : 32;
            const int cc = c0[k];
            float a0[8] = {bflo(wa[k].x), bfhi(wa[k].x), bflo(wa[k].y), bfhi(wa[k].y), bflo(wa[k].z), bfhi(wa[k].z), bflo(wa[k].w), bfhi(wa[k].w)};
            float uu[8] = {bflo(wu[k].x), bfhi(wu[k].x), bflo(wu[k].y), bfhi(wu[k].y), bflo(wu[k].z), bfhi(wu[k].z), bflo(wu[k].w), bfhi(wu[k].w)};
            float a1[8] = {bflo(w1[k].x), bfhi(w1[k].x), bflo(w1[k].y), bfhi(w1[k].y), bflo(w1[k].z), bfhi(w1[k].z), bflo(w1[k].w), bfhi(w1[k].w)};
            float a2[8] = {bflo(w2[k].x), bfhi(w2[k].x), bflo(w2[k].y), bfhi(w2[k].y), bflo(w2[k].z), bfhi(w2[k].z), bflo(w2[k].w), bfhi(w2[k].w)};
            if (t < 1) {
#pragma unroll
                for (int i = 0; i < 8; ++i) a1[i] = prompt ? 0.f : cpast[((size_t)b * 2 + 1) * DFF + cc + i]; }
            if (t < 2) {
#pragma unroll
                for (int i = 0; i < 8; ++i) a2[i] = prompt ? 0.f : cpast[((size_t)b * 2 + t) * DFF + cc + i]; }
            const f32x4 c00 = *(const f32x4*)(cw + cc), c01 = *(const f32x4*)(cw + cc + 4), c10 = *(const f32x4*)(cw + DFF + cc), c11 = *(const f32x4*)(cw + DFF + cc + 4),
                        c20 = *(const f32x4*)(cw + 2 * DFF + cc), c21 = *(const f32x4*)(cw + 2 * DFF + cc + 4), b0 = *(const f32x4*)(cb + cc), b1 = *(const f32x4*)(cb + cc + 4);
            const float w0[8] = {c00.x, c00.y, c00.z, c00.w, c01.x, c01.y, c01.z, c01.w}, w1f[8] = {c10.x, c10.y, c10.z, c10.w, c11.x, c11.y, c11.z, c11.w},
                        w2f[8] = {c20.x, c20.y, c20.z, c20.w, c21.x, c21.y, c21.z, c21.w}, bb[8] = {b0.x, b0.y, b0.z, b0.w, b1.x, b1.y, b1.z, b1.w};
            float o[8];
#pragma unroll
            for (int i = 0; i < 8; ++i) { const float cv = a2[i] * w0[i] + a1[i] * w1f[i] + a0[i] * w2f[i] + bb[i];
                o[i] = cv * __builtin_amdgcn_rcpf(1.f + __expf(-cv)) * uu[i]; }
            v4u w; w.x = pk2(o[0], o[1]); w.y = pk2(o[2], o[3]); w.z = pk2(o[4], o[5]); w.w = pk2(o[6], o[7]);
            *(v4u*)(ACT + (size_t)row[k] * DFF + cc) = w;
            if (t >= S - 2) { float* od = outp + (prompt ? OUT_PCONV + ((size_t)l * 8 + b) * 2 * DFF : OUT_SCONV + ((size_t)l * 16 + b) * 2 * DFF) + (size_t)(t - (S - 2)) * DFF + cc;
                *(f32x4*)od = (f32x4){a0[0], a0[1], a0[2], a0[3]}; *(f32x4*)(od + 4) = (f32x4){a0[4], a0[5], a0[6], a0[7]}; }
        }
    }
}
#define XB_TMO      128
#define XB_XCNT(j)  (256  + 64 * (j))
#define XB_XSUB(j)  (1280 + 64 * (j))
#define XB_XGEN(j)  (2304 + 64 * (j))
#define XB_TOP      3328
#define XB_TOPGEN   3392
#define XCD_BAR_WORDS 3456
#define XB_SPIN_CAP (1u << 18)

__device__ __forceinline__ unsigned xb_ld(unsigned* p)              { return __hip_atomic_load(p, __ATOMIC_RELAXED, __HIP_MEMORY_SCOPE_AGENT); }
__device__ __forceinline__ unsigned xb_add(unsigned* p, unsigned v) { return __hip_atomic_fetch_add(p, v, __ATOMIC_RELAXED, __HIP_MEMORY_SCOPE_AGENT); }
__device__ __forceinline__ unsigned xb_xcc_id() { return (unsigned)__builtin_amdgcn_s_getreg((3 << 11) | 20) & 0xFu; }
#define XB_SPIN(cond, bar) do { unsigned _sp = 0; while (cond) { __builtin_amdgcn_s_sleep(1); \
    if ((++_sp & 255u) == 0u) { if (xb_ld(&(bar)[XB_TMO])) break; if (_sp > XB_SPIN_CAP) { atomicAdd(&(bar)[XB_TMO], 1u); break; } } } } while (0)

struct XcdBarrier {
    unsigned* bar; unsigned x;
    volatile LAS unsigned* st;
};

__device__ __forceinline__ XcdBarrier xcd_barrier_post(unsigned* bar, volatile LAS unsigned* st, bool t0  ) {
    XcdBarrier b; b.bar = bar; b.x = xb_xcc_id(); b.st = st;
    if (t0) (void)xb_add(&bar[XB_XCNT(b.x)], 1u);
    return b;
}
__device__ __forceinline__ void xcd_barrier_complete(unsigned* bar, unsigned x, unsigned& nloc, unsigned& nx) {
    const unsigned G = gridDim.x * gridDim.y * gridDim.z;
    unsigned sum, cnt, mine, sp = 0u;
    for (;;) {
        sum = 0u; cnt = 0u; mine = 0u;
#pragma unroll
        for (unsigned j = 0; j < 16; ++j) { const unsigned c = xb_ld(&bar[XB_XCNT(j)]); sum += c; cnt += (c > 0u) ? 1u : 0u; mine = (j == x) ? c : mine; }
        if (sum == G) break;
        __builtin_amdgcn_s_sleep(1);
        if ((++sp & 255u) == 0u) { if (xb_ld(&bar[XB_TMO])) break; if (sp > XB_SPIN_CAP) { atomicAdd(&bar[XB_TMO], 1u); break; } }
    }
    nloc = mine > 0u ? mine : 1u; nx = cnt > 0u ? cnt : 1u;
}

__device__ __forceinline__ void xcd_barrier(const XcdBarrier& b, bool t0  ) {
    asm volatile("s_waitcnt vmcnt(0)" ::: "memory");
    __syncthreads();
    if (t0) {
        unsigned* bar = b.bar;
        __builtin_amdgcn_s_waitcnt(0);
        unsigned nloc = b.st[0], nx = b.st[1];
        if (nloc == 0u) { xcd_barrier_complete(bar, b.x, nloc, nx); b.st[0] = nloc; b.st[1] = nx; }
        const unsigned old = xb_add(&bar[XB_XSUB(b.x)], 1u);
        const unsigned gen = old / nloc;
        if (old + 1u == (gen + 1u) * nloc) {
            __builtin_amdgcn_fence(__ATOMIC_RELEASE, "agent");
            asm volatile("s_waitcnt vmcnt(0)" ::: "memory");
            const unsigned og = xb_add(&bar[XB_TOP], 1u);
            const unsigned tg = og / nx;
            if (og + 1u == (tg + 1u) * nx) xb_add(&bar[XB_TOPGEN], 1u);
            else XB_SPIN(xb_ld(&bar[XB_TOPGEN]) == tg, bar);
            __builtin_amdgcn_fence(__ATOMIC_ACQUIRE, "agent");
            xb_add(&bar[XB_XGEN(b.x)], 1u);
            asm volatile("s_waitcnt vmcnt(0)" ::: "memory");
        } else {
            XB_SPIN(xb_ld(&bar[XB_XGEN(b.x)]) == gen, bar);
            __builtin_amdgcn_fence(__ATOMIC_ACQUIRE, "agent");
            asm volatile("s_waitcnt vmcnt(0)" ::: "memory");
        }
    }
    __syncthreads();
}
namespace att {
typedef short bf16x8 __attribute__((ext_vector_type(8)));
typedef short s16x4 __attribute__((ext_vector_type(4)));
typedef float f32x16 __attribute__((ext_vector_type(16)));
enum { MLA = 0, SBK = 1, DIFF = 2 };
template <int N> struct IC { static constexpr int value = N; };
template <int MODE> struct Cfg {
    static constexpr int DQK = MODE == MLA ? 96 : 64;
    static constexpr int NMAP = MODE == DIFF ? 2 : 1;
    static constexpr int KW = MODE == MLA ? 96 : (MODE == DIFF ? 128 : 64);
    static constexpr int DV = MODE == DIFF ? 128 : 64;
    static constexpr int KP = KW * 2 + 16;
    static constexpr int VP = MODE == DIFF ? 320 : 192;
    static constexpr int KS = DQK / 16, DT = DV / 32;
    static constexpr int KWS = MODE == MLA ? 96 : 64;
    static constexpr int KPS = KWS * 2 + 16;
};
__device__ __forceinline__ unsigned cvtpk(float lo, float hi) { typedef float f2 __attribute__((ext_vector_type(2))); typedef __bf16 b2 __attribute__((ext_vector_type(2)));
    f2 v = {lo, hi}; b2 b = __builtin_convertvector(v, b2); return __builtin_bit_cast(unsigned, b); }
__device__ __forceinline__ bf16x8 pack8(const f32x16& p, int s8) {
    v4u w; w.x = cvtpk(p[s8 + 0], p[s8 + 1]); w.y = cvtpk(p[s8 + 2], p[s8 + 3]); w.z = cvtpk(p[s8 + 4], p[s8 + 5]); w.w = cvtpk(p[s8 + 6], p[s8 + 7]); return __builtin_bit_cast(bf16x8, w); }
__device__ __forceinline__ s16x4 vtr(LAS const unsigned char* p) { typedef short v4i16_t __attribute__((ext_vector_type(4)));
    return __builtin_bit_cast(s16x4, __builtin_amdgcn_ds_read_tr16_b64_v4i16((LAS v4i16_t*)p)); }
__device__ __forceinline__ float ex2(float x) { return __builtin_amdgcn_exp2f(x); }
__device__ __forceinline__ float lg2(float x) { return __builtin_amdgcn_logf(x); }

template <int KS> __device__ __forceinline__ f32x16 qk_sub(LAS const unsigned char* Kt, int kpitch, const bf16x8 (&qf)[KS], int r32, int hi) {
    f32x16 p = {0.f, 0.f, 0.f, 0.f, 0.f, 0.f, 0.f, 0.f, 0.f, 0.f, 0.f, 0.f, 0.f, 0.f, 0.f, 0.f};
    LAS const unsigned char* kb = Kt + r32 * kpitch + hi * 16;
#pragma unroll
    for (int ks = 0; ks < KS; ++ks) { const bf16x8 kf = *(LAS const bf16x8*)(kb + ks * 32); p = __builtin_amdgcn_mfma_f32_32x32x16_bf16(kf, qf[ks], p, 0, 0, 0); }
    return p;
}
__device__ __forceinline__ bf16x8 v_frag(LAS const unsigned char* Vt, int vpitch, int dt, int s, int lane) {
    const int i = lane & 15, g1 = (lane >> 4) & 1, hi = lane >> 5;
    LAS const unsigned char* a = Vt + (16 * s + 4 * hi + (i >> 2)) * vpitch + (32 * dt + 16 * g1 + 4 * (i & 3)) * 2;
    const s16x4 lo = vtr(a), hh = vtr(a + 8 * vpitch);
    return (bf16x8){lo[0], lo[1], lo[2], lo[3], hh[0], hh[1], hh[2], hh[3]};
}

__device__ __forceinline__ void store_pair16(bf16* p, v2u wk, v2u wk1, int hi) {
    auto r0 = __builtin_amdgcn_permlane32_swap(wk.x, wk1.x, false, false); auto r1 = __builtin_amdgcn_permlane32_swap(wk.y, wk1.y, false, false);
    v4u o; o.x = r0[0]; o.y = r1[0]; o.z = r0[1]; o.w = r1[1];
    *(v4u*)(p + (hi ? 8 : 0)) = o;
}
__device__ __forceinline__ void softmax_update(f32x16& p, float& m, float& l, float& alpha) {
    float mx = p[0];
#pragma unroll
    for (int r = 1; r < 16; ++r) mx = fmaxf(mx, p[r]);
    mx = half_max(mx);
    const float mn = fmaxf(m, mx); alpha = ex2(m - mn); m = mn;
    float s = 0.f;
#pragma unroll
    for (int r = 0; r < 16; ++r) { p[r] = ex2(p[r] - mn); s += p[r]; }
    l = l * alpha + s;
}
__device__ __forceinline__ void softmax_update2(f32x16& pa, f32x16& pb, float& m, float& l, float& alpha) {
    float mx = fmaxf(pa[0], pb[0]);
#pragma unroll
    for (int r = 1; r < 16; ++r) mx = fmaxf(mx, fmaxf(pa[r], pb[r]));
    mx = half_max(mx);
    const float mn = fmaxf(m, mx); alpha = ex2(m - mn); m = mn;
    float s0 = 0.f, s1 = 0.f;
#pragma unroll
    for (int r = 0; r < 16; ++r) { pa[r] = ex2(pa[r] - mn); pb[r] = ex2(pb[r] - mn); s0 += pa[r]; s1 += pb[r]; }
    l = l * alpha + (s0 + s1);
}
__device__ __forceinline__ void sb_update(f32x16& p, unsigned vmask, float& C, int hi) {
    float lnb[16];
#pragma unroll
    for (int r = 0; r < 16; ++r) { const float t = p[r]; const float w = t > 64.0f ? t : lg2(1.0f + ex2(t));
        const bool ok = (vmask >> r) & 1u; lnb[r] = ok ? -w : 0.f; p[r] = t - w; }
    float e[16], T[4], Tp[4];
#pragma unroll
    for (int g = 0; g < 4; ++g) { e[4 * g + 3] = 0.f; e[4 * g + 2] = lnb[4 * g + 3]; e[4 * g + 1] = e[4 * g + 2] + lnb[4 * g + 2]; e[4 * g + 0] = e[4 * g + 1] + lnb[4 * g + 1]; T[g] = e[4 * g] + lnb[4 * g]; }
#pragma unroll
    for (int g = 0; g < 4; ++g) Tp[g] = half_other(T[g], hi);
    const float ps0 = T[0] + Tp[0], ps1 = T[1] + Tp[1], ps2 = T[2] + Tp[2], ps3 = T[3] + Tp[3];
    float Rg[4]; Rg[3] = 0.f; Rg[2] = ps3; Rg[1] = ps3 + ps2; Rg[0] = Rg[1] + ps1;
    const float tot = Rg[0] + ps0;
#pragma unroll
    for (int g = 0; g < 4; ++g) { const float sg = C + Rg[g] + (hi == 0 ? Tp[g] : 0.f);
#pragma unroll
        for (int j = 0; j < 4; ++j) { const int r = 4 * g + j; const bool ok = (vmask >> r) & 1u; p[r] = ok ? ex2(p[r] + sg + e[r]) : 0.f; } }
    C += tot;
}

template <int MODE>
__device__ __forceinline__ void prompt_unit(LAS unsigned char* lds, const bf16* Qb, int qp, const bf16* Kb, int kp, const bf16* Vb, int vp, bf16* Ob, int op, int q0,
                                            int tid, int lane, int wave, float slope2, float lam, float onem_lam_init, const float* subln_g) {
    typedef Cfg<MODE> C;
    constexpr int KS = C::KS, DT = C::DT, KP = C::KP, VP = C::VP;
    constexpr int QROWS = MODE == DIFF ? 128 : 256;
    constexpr int KTB = 64 * KP, VTB = 64 * VP, BUFB = KTB + VTB;
    constexpr int KCR = C::KW / 8, VCR = C::DV / 8;
    constexpr int NKC = (64 * KCR + 511) / 512, NVC = (64 * VCR + 511) / 512;
    constexpr int KTPR = KCR / NKC, VTPR = VCR / NVC;
    static_assert(KCR % NKC == 0 && VCR % NVC == 0 && 64 * KTPR <= 512 && 64 * VTPR <= 512 && 2 * BUFB <= RING_BYTES, "staging map");
    const int r32 = lane & 31, hi = lane >> 5;
    const int wq = MODE == DIFF ? (wave & 3) : wave, map = MODE == DIFF ? (wave >> 2) : 0;
    const int qrow = q0 + 32 * wq + r32;
    bf16x8 qf[KS];
#pragma unroll
    for (int ks = 0; ks < KS; ++ks) qf[ks] = *(const bf16x8*)(Qb + (size_t)qrow * qp + map * 64 + ks * 16 + hi * 8);
    f32x16 o[DT];
#pragma unroll
    for (int dt = 0; dt < DT; ++dt)
#pragma unroll
        for (int r = 0; r < 16; ++r) o[dt][r] = 0.f;
    float mrun = -INFINITY, lrun = 0.f, Ccar = 0.f;
    bool dead = false;
    LAS volatile unsigned* sbflag = (LAS volatile unsigned*)(lds + RING_BYTES + 4352);
    if (MODE == SBK && tid < 16) sbflag[tid] = 0u;
    const int ntiles = (q0 + QROWS) / 64;
    const int cw = (q0 + 32 * wq) / 64;
    v4u kreg[NKC], vreg[NVC];
    const bool kact = tid < 64 * KTPR, vact = tid < 64 * VTPR;
    const int krow = tid / KTPR, kcc = (tid % KTPR) * NKC, vrow = tid / VTPR, vcc = (tid % VTPR) * NVC;
    const bf16* kgp = Kb + (size_t)krow * kp + kcc * 8; const bf16* vgp = Vb + (size_t)vrow * vp + vcc * 8;
    LAS unsigned char* klp = lds + krow * KP + kcc * 16; LAS unsigned char* vlp = lds + KTB + vrow * VP + vcc * 16;
    LAS const unsigned char* kfp = lds + r32 * KP + hi * 16 + map * 128;
    LAS const unsigned char* vfp = lds + KTB + (4 * hi + ((lane & 15) >> 2)) * VP + (16 * ((lane >> 4) & 1) + 4 * (lane & 3)) * 2;
    auto issue = [&](int jt) {
        if (kact) {
#pragma unroll
            for (int i = 0; i < NKC; ++i) kreg[i] = *(const v4u*)(kgp + (size_t)jt * 64 * kp + i * 8); }
        if (vact) {
#pragma unroll
            for (int i = 0; i < NVC; ++i) vreg[i] = *(const v4u*)(vgp + (size_t)jt * 64 * vp + i * 8); }
    };
    auto commit = [&](auto BUFC) {
        constexpr int buf = decltype(BUFC)::value;
        if (kact) {
#pragma unroll
            for (int i = 0; i < NKC; ++i) *(LAS v4u*)(klp + buf * BUFB + i * 16) = kreg[i]; }
        if (vact) {
#pragma unroll
            for (int i = 0; i < NVC; ++i) *(LAS v4u*)(vlp + buf * BUFB + i * 16) = vreg[i]; }
    };
    auto step = [&](int it, auto CURC) {
        constexpr int cur = decltype(CURC)::value;
        const int jt = ntiles - 1 - it;
        if (it + 1 < ntiles) issue(jt - 1);
        if (jt <= cw && !dead) {
            f32x16 p1 = {0.f, 0.f, 0.f, 0.f, 0.f, 0.f, 0.f, 0.f, 0.f, 0.f, 0.f, 0.f, 0.f, 0.f, 0.f, 0.f}, p0 = p1;
            bf16x8 kf1[KS], kf0[KS];
#pragma unroll
            for (int ks = 0; ks < KS; ++ks) { kf1[ks] = *(LAS const bf16x8*)(kfp + cur * BUFB + 32 * KP + ks * 32); kf0[ks] = *(LAS const bf16x8*)(kfp + cur * BUFB + ks * 32); }
            __builtin_amdgcn_s_setprio(1);
#pragma unroll
            for (int ks = 0; ks < KS; ++ks) { p1 = __builtin_amdgcn_mfma_f32_32x32x16_bf16(kf1[ks], qf[ks], p1, 0, 0, 0); p0 = __builtin_amdgcn_mfma_f32_32x32x16_bf16(kf0[ks], qf[ks], p0, 0, 0, 0); }
            __builtin_amdgcn_s_setprio(0);
            auto loadv = [&](int dt, bf16x8 (&vf)[4]) {
#pragma unroll
                for (int s = 0; s < 4; ++s) { LAS const unsigned char* va = vfp + cur * BUFB + (16 * s) * VP + dt * 64;
                    const s16x4 lo = vtr(va), hh = vtr(va + 8 * VP); vf[s] = (bf16x8){lo[0], lo[1], lo[2], lo[3], hh[0], hh[1], hh[2], hh[3]}; } };
            bf16x8 vfa[4]; loadv(0, vfa);
            const int base0 = qrow - jt * 64 - 4 * hi, base1 = base0 - 32;
            if constexpr (MODE == SBK) {
                unsigned vm1 = 0xffffu, vm0 = 0xffffu;
                if (jt == cw) { vm1 = 0u; vm0 = 0u;
#pragma unroll
                    for (int r = 0; r < 16; ++r) { vm1 |= (((r & 3) + 8 * (r >> 2)) < base1 ? 1u : 0u) << r; vm0 |= (((r & 3) + 8 * (r >> 2)) < base0 ? 1u : 0u) << r; } }
                sb_update(p1, vm1, Ccar, hi); sb_update(p0, vm0, Ccar, hi);
            } else {
                if constexpr (MODE == DIFF) { const float f0 = (float)base0, f1 = (float)base1;
#pragma unroll
                    for (int r = 0; r < 16; ++r) { const float cr = (float)((r & 3) + 8 * (r >> 2)); p0[r] -= slope2 * fabsf(f0 - cr); p1[r] -= slope2 * fabsf(f1 - cr); } }
                float alpha; softmax_update2(p0, p1, mrun, lrun, alpha);
                if (__any(alpha != 1.0f)) {
#pragma unroll
                    for (int dt = 0; dt < DT; ++dt)
#pragma unroll
                        for (int r = 0; r < 16; ++r) o[dt][r] *= alpha; }
            }
            const bf16x8 pf[4] = {pack8(p0, 0), pack8(p0, 8), pack8(p1, 0), pack8(p1, 8)};
#pragma unroll
            for (int dt = 0; dt < DT; ++dt) {
                bf16x8 vfn[4];
                if (dt + 1 < DT) loadv(dt + 1, vfn);
                __builtin_amdgcn_s_setprio(1);
#pragma unroll
                for (int s = 0; s < 4; ++s) o[dt] = __builtin_amdgcn_mfma_f32_32x32x16_bf16(vfa[s], pf[s], o[dt], 0, 0, 0);
                __builtin_amdgcn_s_setprio(0);
                if (dt + 1 < DT) {
#pragma unroll
                    for (int s = 0; s < 4; ++s) vfa[s] = vfn[s]; }
            }
            if constexpr (MODE == SBK) { if (__all(Ccar < -160.0f)) { dead = true; if (lane == 0) sbflag[wave] = 1u; } }
        }
        if (it + 1 < ntiles) commit(IC<(cur ^ 1)>{});
        __syncthreads();
    };
    issue(ntiles - 1); commit(IC<0>{});
    __syncthreads();
    __builtin_amdgcn_s_waitcnt(0x0F70);
#pragma unroll 1
    for (int it = 0; it < ntiles; it += 2) {
        if constexpr (MODE == SBK) {
            if (it > 0) { if (tid == 0) { unsigned n = 0; for (int w = 0; w < 8; ++w) n += sbflag[w]; sbflag[8] = n; }
                __syncthreads(); if (sbflag[8] == 8u) break; }
        }
        step(it, IC<0>{}); step(it + 1, IC<1>{});
    }
    bf16* orow = Ob + (size_t)qrow * op;
    if constexpr (MODE == MLA) {
        const float inv = 1.0f / half_sum(lrun);
#pragma unroll
        for (int dt = 0; dt < DT; ++dt)
#pragma unroll
            for (int g = 0; g < 4; g += 2) { v2u w0, w1; w0.x = cvtpk(o[dt][4 * g] * inv, o[dt][4 * g + 1] * inv); w0.y = cvtpk(o[dt][4 * g + 2] * inv, o[dt][4 * g + 3] * inv);
                w1.x = cvtpk(o[dt][4 * g + 4] * inv, o[dt][4 * g + 5] * inv); w1.y = cvtpk(o[dt][4 * g + 6] * inv, o[dt][4 * g + 7] * inv);
                store_pair16(orow + 32 * dt + 8 * g, w0, w1, hi); }
    } else if constexpr (MODE == SBK) {
#pragma unroll
        for (int dt = 0; dt < DT; ++dt)
#pragma unroll
            for (int g = 0; g < 4; g += 2) { v2u w0, w1; w0.x = cvtpk(o[dt][4 * g], o[dt][4 * g + 1]); w0.y = cvtpk(o[dt][4 * g + 2], o[dt][4 * g + 3]);
                w1.x = cvtpk(o[dt][4 * g + 4], o[dt][4 * g + 5]); w1.y = cvtpk(o[dt][4 * g + 6], o[dt][4 * g + 7]);
                store_pair16(orow + 32 * dt + 8 * g, w0, w1, hi); }
    } else {
        LAS float* xo = (LAS float*)lds + wq * (128 * 32);
        const float inv = (map == 1 ? lam : 1.0f) / half_sum(lrun);
        if (map == 1) {
#pragma unroll
            for (int dt = 0; dt < DT; ++dt)
#pragma unroll
                for (int r = 0; r < 16; ++r) xo[(32 * dt + 8 * (r >> 2) + 4 * hi + (r & 3)) * 32 + r32] = o[dt][r] * inv;
        }
        __syncthreads();
        if (map == 0) {
            float ss = 0.f;
#pragma unroll
            for (int dt = 0; dt < DT; ++dt)
#pragma unroll
                for (int r = 0; r < 16; ++r) { const float v = o[dt][r] * inv - xo[(32 * dt + 8 * (r >> 2) + 4 * hi + (r & 3)) * 32 + r32]; o[dt][r] = v; ss += v * v; }
            ss = half_sum(ss);
            const float rs = rsqrtf(ss * (1.0f / 128.0f) + kEPS) * onem_lam_init;
#pragma unroll
            for (int dt = 0; dt < DT; ++dt)
#pragma unroll
                for (int g = 0; g < 4; g += 2) { const int d = 32 * dt + 8 * g + 4 * hi; const f32x4 g0 = *(const f32x4*)(subln_g + d), g1 = *(const f32x4*)(subln_g + d + 8);
                    v2u w0, w1; w0.x = cvtpk(o[dt][4 * g] * rs * g0.x, o[dt][4 * g + 1] * rs * g0.y); w0.y = cvtpk(o[dt][4 * g + 2] * rs * g0.z, o[dt][4 * g + 3] * rs * g0.w);
                    w1.x = cvtpk(o[dt][4 * g + 4] * rs * g1.x, o[dt][4 * g + 5] * rs * g1.y); w1.y = cvtpk(o[dt][4 * g + 6] * rs * g1.z, o[dt][4 * g + 7] * rs * g1.w);
                    store_pair16(orow + 32 * dt + 8 * g, w0, w1, hi); }
        }
        __syncthreads();
    }
}

struct SampleSrc {
    const void* kc; int kcp; const void* vc; int vcp;
    const bf16* kn; int knp; const bf16* vn; int vnp;
    const bf16* q; int qp;
};
template <int MODE>
__device__ __forceinline__ void sample_unit(LAS unsigned char* lds, LAS unsigned char* xch, const SampleSrc& S, bf16* Ob  , int op,
                                            int tid, int lane, int wave, float slope2, float lam, float onem_lam_init, const float* subln_g, const float* wuv = nullptr  ) {
    typedef Cfg<MODE> C;
    constexpr int KS = C::KS, KP = C::KPS, KWS = C::KWS, DV = MODE == MLA ? 128 : C::DV, DT = DV / 32, VP = MODE == MLA ? 272 : C::VP;
    constexpr bool CF32 = MODE != MLA;
    constexpr int KTB = 32 * KP, VTB = 32 * VP, WB = (KTB + VTB + 255) & ~255;
    constexpr int NKC = 32 * KWS / 8 / 64, NVH = 16 * DV / 8 / 64;
    static_assert(8 * WB <= RING_BYTES, "sample staging");
    constexpr int KLPR = (KWS / 8) / NKC, VLPR = (DV / 8) / NVH;
    static_assert(32 * KLPR == 64 && 16 * VLPR == 64, "sample staging map");
    const int r32 = lane & 31, hi = lane >> 5;
    const int krow = lane / KLPR, kcc = (lane % KLPR) * NKC, vrow = lane / VLPR, vcc = (lane % VLPR) * NVH;
    constexpr int NG = MODE == DIFF ? 2 : 1, WPG = 8 / NG;
    const int wi = wave % WPG;
    LAS unsigned char* kb = lds + wave * WB; LAS unsigned char* vb = kb + KTB;
    constexpr bool QLDS = MODE == DIFF || MODE == MLA;
    bf16x8 qf[QLDS ? 1 : KS];
    LAS unsigned char* qlp = lds + 8 * WB + (wave / WPG) * (KS * 1024) + lane * 16;
    static_assert(!QLDS || 8 * WB + NG * KS * 1024 <= RING_BYTES, "sample Q LDS");
#pragma unroll
    for (int ks = 0; ks < KS; ++ks) { const bf16x8 q_ = *(const bf16x8*)(S.q + (size_t)r32 * S.qp + ks * 16 + hi * 8); if constexpr (QLDS) *(LAS bf16x8*)(qlp + ks * 1024) = q_; else qf[ks] = q_; }
    f32x16 o[DT];
#pragma unroll
    for (int dt = 0; dt < DT; ++dt)
#pragma unroll
        for (int r = 0; r < 16; ++r) o[dt][r] = 0.f;
    float mrun = -INFINITY, lrun = 0.f, Ccar = 0.f;
    const int qpos = PASTL + r32;

    bf16x8 pf[2];
    auto computeA = [&](int kpos0, bool diag) {
        f32x16 p = {0.f, 0.f, 0.f, 0.f, 0.f, 0.f, 0.f, 0.f, 0.f, 0.f, 0.f, 0.f, 0.f, 0.f, 0.f, 0.f};
        { LAS const unsigned char* kq = kb + r32 * KP + hi * 16;
#pragma unroll
          for (int ks = 0; ks < KS; ++ks) { const bf16x8 kf = *(LAS const bf16x8*)(kq + ks * 32); bf16x8 qq; if constexpr (QLDS) qq = *(LAS const bf16x8*)(qlp + ks * 1024); else qq = qf[ks];
              p = __builtin_amdgcn_mfma_f32_32x32x16_bf16(kf, qq, p, 0, 0, 0); } }
        const int base = qpos - kpos0 - 4 * hi;
        if constexpr (MODE == SBK) {
            unsigned vmask = 0xffffu;
            if (diag) { vmask = 0u;
#pragma unroll
                for (int r = 0; r < 16; ++r) vmask |= (((r & 3) + 8 * (r >> 2)) < base ? 1u : 0u) << r; }
            sb_update(p, vmask, Ccar, hi);
        } else {
            if constexpr (MODE == DIFF) { const float fb = (float)base;
#pragma unroll
                for (int r = 0; r < 16; ++r) p[r] -= slope2 * fabsf(fb - (float)((r & 3) + 8 * (r >> 2))); }
            float alpha; softmax_update(p, mrun, lrun, alpha);
            if (__any(alpha != 1.0f)) {
#pragma unroll
                for (int dt = 0; dt < DT; ++dt)
#pragma unroll
                    for (int r = 0; r < 16; ++r) o[dt][r] *= alpha; }
        }
        pf[0] = pack8(p, 0); pf[1] = pack8(p, 8);
#pragma unroll
        for (int dt = 0; dt < DT; ++dt) { const bf16x8 vf = v_frag(vb, VP, dt, 0, lane); o[dt] = __builtin_amdgcn_mfma_f32_32x32x16_bf16(vf, pf[0], o[dt], 0, 0, 0); }
    };
    auto computeB = [&]() {
#pragma unroll
        for (int dt = 0; dt < DT; ++dt) { const bf16x8 vf = v_frag(vb, VP, dt, 1, lane); o[dt] = __builtin_amdgcn_mfma_f32_32x32x16_bf16(vf, pf[1], o[dt], 0, 0, 0); }
    };
    auto new_rows = [&]() {
        int ln2 = lane; asm volatile("" : "+v"(ln2));
        const int krow = ln2 / KLPR, kcc = (ln2 % KLPR) * NKC, vrow = ln2 / VLPR, vcc = (ln2 % VLPR) * NVH;
#pragma unroll
        for (int i = 0; i < NKC; ++i) *(LAS v4u*)(kb + krow * KP + (kcc + i) * 16) = *(const v4u*)(S.kn + (size_t)krow * S.knp + (kcc + i) * 8);
#pragma unroll
        for (int hf = 0; hf < 2; ++hf)
#pragma unroll
            for (int i = 0; i < NVH; ++i) *(LAS v4u*)(vb + (16 * hf + vrow) * VP + (vcc + i) * 16) = *(const v4u*)(S.vn + (size_t)(16 * hf + vrow) * S.vnp + (vcc + i) * 8);
        computeA(PASTL, true); computeB();
    };
    if (MODE == SBK && wi == WPG - 1) new_rows();
    constexpr int SPW = 128 / WPG;
    const int s_lo = wi * SPW, s_hi = s_lo + SPW;
    constexpr int NKR = CF32 ? 2 * NKC : NKC, NVR = CF32 ? 2 * NVH : NVH;
    v4u kr[NKR], vr[2][NVR];
    auto cvt8 = [&](const v4u& a, const v4u& b) { v4u w; w.x = cvtpk(__uint_as_float(a.x), __uint_as_float(a.y)); w.y = cvtpk(__uint_as_float(a.z), __uint_as_float(a.w));
        w.z = cvtpk(__uint_as_float(b.x), __uint_as_float(b.y)); w.w = cvtpk(__uint_as_float(b.z), __uint_as_float(b.w)); return w; };
    constexpr int ESZ = CF32 ? 4 : 2;
    const unsigned kgo = (unsigned)((krow * S.kcp + kcc * 8) * ESZ), vgo = (unsigned)((vrow * S.vcp + vcc * 8) * ESZ);
    LAS unsigned char* kll = kb + krow * KP + kcc * 16; LAS unsigned char* vll = vb + vrow * VP + vcc * 16;
    constexpr int LK = KWS * 4 / 16, LV = DV * 4 / 16;
    const unsigned kgo32 = (unsigned)(((lane / LK) * S.kcp) * 4 + (lane % LK) * 16), vgo32 = (unsigned)(((lane / LV) * S.vcp) * 4 + (lane % LV) * 16);
    LAS unsigned char* kll32 = kb + (lane / LK) * KP + (lane % LK) * 8; LAS unsigned char* vll32 = vb + (lane / LV) * VP + (lane % LV) * 8;
    unsigned kof[CF32 ? 1 : NKC]; unsigned vof0 = 0;
    if constexpr (!CF32) { int lnk = lane; asm volatile("" : "+v"(lnk));
#pragma unroll
        for (int i = 0; i < NKC; ++i) { const int p = 64 * i + lnk, row = p / (KWS / 8), ch = p % (KWS / 8); kof[i] = (unsigned)((row * S.kcp + ch * 8) * 2); }
        vof0 = (unsigned)(((lnk / (DV / 8)) * S.vcp + (lnk % (DV / 8)) * 8) * 2); }
    auto issue = [&](int s) {
        if constexpr (CF32) {
            const unsigned char* g = (const unsigned char*)S.kc + (size_t)(32 * s) * S.kcp * 4;
#pragma unroll
            for (int i = 0; i < NKR; ++i) kr[i] = __builtin_nontemporal_load((const v4u*)(g + kgo32 + (size_t)i * (64 / LK) * S.kcp * 4));
#pragma unroll
            for (int hf = 0; hf < 2; ++hf) { const unsigned char* gv = (const unsigned char*)S.vc + (size_t)(32 * s + 16 * hf) * S.vcp * 4;
#pragma unroll
                for (int i = 0; i < NVR; ++i) vr[hf][i] = __builtin_nontemporal_load((const v4u*)(gv + vgo32 + (size_t)i * (64 / LV) * S.vcp * 4)); }
        } else {
            const unsigned char* g = (const unsigned char*)S.kc + (size_t)(32 * s) * S.kcp * 2;
#pragma unroll
            for (int i = 0; i < NKR; ++i) kr[i] = __builtin_nontemporal_load((const v4u*)(g + kof[i]));
#pragma unroll
            for (int hf = 0; hf < 2; ++hf) { const unsigned char* gv = (const unsigned char*)S.vc + (size_t)(32 * s + 16 * hf) * S.vcp * 2;
#pragma unroll
                for (int i = 0; i < NVR; ++i) vr[hf][i] = __builtin_nontemporal_load((const v4u*)(gv + vof0 + (unsigned)(i * (64 / (DV / 8)) * S.vcp * 2))); }
        }
    };
    auto cvt4 = [&](const v4u& x) { v2u w; w.x = cvtpk(__uint_as_float(x.x), __uint_as_float(x.y)); w.y = cvtpk(__uint_as_float(x.z), __uint_as_float(x.w)); return w; };
    auto commit = [&]() {
        if constexpr (CF32) {
#pragma unroll
            for (int i = 0; i < NKR; ++i) *(LAS v2u*)(kll32 + i * (64 / LK) * KP) = cvt4(kr[i]);
#pragma unroll
            for (int hf = 0; hf < 2; ++hf)
#pragma unroll
                for (int i = 0; i < NVR; ++i) *(LAS v2u*)(vll32 + (16 * hf + i * (64 / LV)) * VP) = cvt4(vr[hf][i]);
        } else {
#pragma unroll
            for (int i = 0; i < NKC; ++i) { const int p = 64 * i + lane, row = p / (KWS / 8), ch = p % (KWS / 8); *(LAS v4u*)(kb + row * KP + ch * 16) = kr[i]; }
#pragma unroll
            for (int hf = 0; hf < 2; ++hf)
#pragma unroll
                for (int i = 0; i < NVH; ++i) { const int p = 64 * i + lane, row = 16 * hf + p / (DV / 8), ch = p % (DV / 8); *(LAS v4u*)(vb + row * VP + ch * 16) = vr[hf][i]; }
        }
    };
    issue(s_hi - 1);
#pragma unroll 1
    for (int s = s_hi - 1; s >= s_lo; --s) {
        commit();
        if (s > s_lo) issue(s - 1);
        computeA(32 * s, false);
        computeB();
    }
    if (MODE != SBK && wi == WPG - 1) new_rows();
    f32x4 wreg[MODE == MLA ? 4 : 1];
    if constexpr (MODE == MLA) {
#pragma unroll
        for (int i = 0; i < 4; ++i) { const int p = tid + 512 * i; wreg[i] = *(const f32x4*)(wuv + (size_t)(p >> 4) * 512 + (p & 15) * 4); } }
    __syncthreads();
    LAS float* part = (LAS float*)lds;
    LAS float* st = (LAS float*)xch;
#pragma unroll
    for (int dt = 0; dt < DT; ++dt)
#pragma unroll
        for (int r = 0; r < 16; ++r) part[(wave * DV + 32 * dt + 8 * (r >> 2) + 4 * hi + (r & 3)) * 32 + r32] = o[dt][r];
    if (hi == 0) { st[wave * 32 + r32] = MODE == SBK ? Ccar : mrun; }
    { const float lt = half_sum(lrun); if (hi == 0) st[256 + wave * 32 + r32] = lt; }
    __syncthreads();
    {
        const int q = tid & 31, dg = tid >> 5;
        constexpr int DPG = DV / 16;
        float sc[8];
        if constexpr (MODE == SBK) { float car = 0.f;
#pragma unroll
            for (int w = 7; w >= 0; --w) { sc[w] = ex2(car); car += st[w * 32 + q]; }
        } else {
#pragma unroll
            for (int g = 0; g < NG; ++g) { float M = -INFINITY;
#pragma unroll
                for (int w = 0; w < WPG; ++w) M = fmaxf(M, st[(g * WPG + w) * 32 + q]);
                float L = 0.f;
#pragma unroll
                for (int w = 0; w < WPG; ++w) { const float e = ex2(st[(g * WPG + w) * 32 + q] - M); sc[g * WPG + w] = e; L += e * st[256 + (g * WPG + w) * 32 + q]; }
                const float invL = (g == 1 ? -lam : 1.0f) / L;
#pragma unroll
                for (int w = 0; w < WPG; ++w) sc[g * WPG + w] *= invL; }
        }
        float v[DPG]; float ss = 0.f;
#pragma unroll
        for (int j = 0; j < DPG; ++j) { const int d = dg * DPG + j; float a = 0.f;
#pragma unroll
            for (int w = 0; w < 8; ++w) a += sc[w] * part[(w * DV + d) * 32 + q];
            v[j] = a; ss += a * a; }
        if constexpr (MODE == DIFF) {
            __syncthreads();
            st[dg * 32 + q] = ss;
            __syncthreads();
            float tot = 0.f;
#pragma unroll
            for (int g = 0; g < 16; ++g) tot += st[g * 32 + q];
            const float rs = rsqrtf(tot * (1.0f / 128.0f) + kEPS) * onem_lam_init;
#pragma unroll
            for (int j = 0; j < DPG; ++j) v[j] *= rs * subln_g[dg * DPG + j];
        }
        if constexpr (MODE == MLA) {
            __syncthreads();
            LAS float* lat = (LAS float*)lds;
            LAS float* wl_ = lat + 8192;
            *(LAS f32x4*)(lat + q * 132 + dg * 8) = (f32x4){v[0], v[1], v[2], v[3]}; *(LAS f32x4*)(lat + q * 132 + dg * 8 + 4) = (f32x4){v[4], v[5], v[6], v[7]};
#pragma unroll
            for (int i = 0; i < 4; ++i) { const int p = tid + 512 * i; *(LAS f32x4*)(wl_ + (p >> 4) * 64 + (p & 15) * 4) = wreg[i]; }
            __syncthreads();
            f32x4 acc = {0.f, 0.f, 0.f, 0.f};
#pragma unroll 4
            for (int d0 = 0; d0 < 128; d0 += 4) { const f32x4 l4 = *(LAS const f32x4*)(lat + q * 132 + d0);
#pragma unroll
                for (int j = 0; j < 4; ++j) { const f32x4 w4 = *(LAS const f32x4*)(wl_ + (d0 + j) * 64 + dg * 4); acc += l4[j] * w4; } }
            v2u w; w.x = cvtpk(acc[0], acc[1]); w.y = cvtpk(acc[2], acc[3]); *(v2u*)(Ob + (size_t)q * op + dg * 4) = w;
        } else {
        bf16* od = Ob + (size_t)q * op + dg * DPG;
        if constexpr (DPG == 4) { v2u w; w.x = cvtpk(v[0], v[1]); w.y = cvtpk(v[2], v[3]); *(v2u*)od = w; }
        else { v4u w; w.x = cvtpk(v[0], v[1]); w.y = cvtpk(v[2], v[3]); w.z = cvtpk(v[4], v[5]); w.w = cvtpk(v[6], v[7]); *(v4u*)od = w; }
        }
    }
    __syncthreads();
}
__device__ __forceinline__ void sample_unit_sb(LAS unsigned char* lds, LAS unsigned char* xch, const SampleSrc& S, bf16* Ob, int op, int tid, int lane, int wave) {
    typedef Cfg<SBK> C;
    constexpr int KS = C::KS, DT = C::DT, KP = C::KPS, VP = C::VP, DV = C::DV;
    constexpr int KTB = 32 * KP, VTB = 32 * VP, WB = (KTB + VTB + 255) & ~255;
    static_assert(8 * WB + DV * 32 * 4 <= RING_BYTES && DV * 32 * 4 <= WB, "sb sample LDS");
    const int r32 = lane & 31, hi = lane >> 5;
    LAS unsigned char* kb = lds + wave * WB; LAS unsigned char* vb = kb + KTB;
    LAS float* part = (LAS float*)(lds + wave * WB);
    LAS float* accum = (LAS float*)(lds + 8 * WB);
    LAS float* st = (LAS float*)xch;
    bf16x8 qf[KS];
#pragma unroll
    for (int ks = 0; ks < KS; ++ks) qf[ks] = *(const bf16x8*)(S.q + (size_t)r32 * S.qp + ks * 16 + hi * 8);
    const int qpos = PASTL + r32;
    const int krow = lane >> 1, kcc = (lane & 1) * 4, vrow = lane >> 2, vcc = (lane & 3) * 2;
    for (int i = tid; i < DV * 32; i += 512) accum[i] = 0.f;
    if (tid < 32) st[256 + tid] = 0.f;
    __syncthreads();
    __builtin_amdgcn_s_waitcnt(0x0F70);
    f32x16 o[DT]; float Ccar;
    bf16x8 pf[2];
    auto compute = [&](int kpos0, bool diag) {
        f32x16 p = qk_sub<KS>(kb, KP, qf, r32, hi);
        const int base = qpos - kpos0 - 4 * hi;
        unsigned vmask = 0xffffu;
        if (diag) { vmask = 0u;
#pragma unroll
            for (int r = 0; r < 16; ++r) vmask |= (((r & 3) + 8 * (r >> 2)) < base ? 1u : 0u) << r; }
        sb_update(p, vmask, Ccar, hi);
        pf[0] = pack8(p, 0); pf[1] = pack8(p, 8);
#pragma unroll
        for (int dt = 0; dt < DT; ++dt)
#pragma unroll
            for (int s = 0; s < 2; ++s) { const bf16x8 vf = v_frag(vb, VP, dt, s, lane); o[dt] = __builtin_amdgcn_mfma_f32_32x32x16_bf16(vf, pf[s], o[dt], 0, 0, 0); }
    };
#pragma unroll 1
    for (int rnd = 0; rnd < 16; ++rnd) {
#pragma unroll
        for (int dt = 0; dt < DT; ++dt)
#pragma unroll
            for (int r = 0; r < 16; ++r) o[dt][r] = 0.f;
        Ccar = 0.f;
        const int s = 128 - 8 * (rnd + 1) + wave;
        const float* kc = (const float*)S.kc + (size_t)(32 * s + krow) * S.kcp + kcc * 8; const float* vc = (const float*)S.vc + (size_t)(32 * s + vrow) * S.vcp + vcc * 8;
        v4u kr[8], vr[8];
#pragma unroll
        for (int i = 0; i < 8; ++i) kr[i] = __builtin_nontemporal_load((const v4u*)kc + i);
#pragma unroll
        for (int hf = 0; hf < 2; ++hf)
#pragma unroll
            for (int i = 0; i < 4; ++i) vr[4 * hf + i] = __builtin_nontemporal_load((const v4u*)(vc + (size_t)16 * hf * S.vcp) + i);
        if (rnd == 0 && wave == 7) {
#pragma unroll
            for (int i = 0; i < 4; ++i) *(LAS v4u*)(kb + krow * KP + (kcc + i) * 16) = *(const v4u*)(S.kn + (size_t)krow * S.knp + (kcc + i) * 8);
#pragma unroll
            for (int hf = 0; hf < 2; ++hf)
#pragma unroll
                for (int i = 0; i < 2; ++i) *(LAS v4u*)(vb + (16 * hf + vrow) * VP + (vcc + i) * 16) = *(const v4u*)(S.vn + (size_t)(16 * hf + vrow) * S.vnp + (vcc + i) * 8);
            compute(PASTL, true);
        }
        auto cvt8 = [&](const v4u& x, const v4u& y) { v4u w; w.x = cvtpk(__uint_as_float(x.x), __uint_as_float(x.y)); w.y = cvtpk(__uint_as_float(x.z), __uint_as_float(x.w));
            w.z = cvtpk(__uint_as_float(y.x), __uint_as_float(y.y)); w.w = cvtpk(__uint_as_float(y.z), __uint_as_float(y.w)); return w; };
#pragma unroll
        for (int i = 0; i < 4; ++i) *(LAS v4u*)(kb + krow * KP + (kcc + i) * 16) = cvt8(kr[2 * i], kr[2 * i + 1]);
#pragma unroll
        for (int hf = 0; hf < 2; ++hf)
#pragma unroll
            for (int i = 0; i < 2; ++i) *(LAS v4u*)(vb + (16 * hf + vrow) * VP + (vcc + i) * 16) = cvt8(vr[4 * hf + 2 * i], vr[4 * hf + 2 * i + 1]);
        compute(32 * s, false);
#pragma unroll
        for (int dt = 0; dt < DT; ++dt)
#pragma unroll
            for (int r = 0; r < 16; ++r) part[(32 * dt + 8 * (r >> 2) + 4 * hi + (r & 3)) * 32 + r32] = o[dt][r];
        if (hi == 0) st[wave * 32 + r32] = Ccar;
        __syncthreads();
        {
            const int q = tid & 31, dg = tid >> 5;
            float car = st[256 + q]; float sc[8];
#pragma unroll
            for (int w = 7; w >= 0; --w) { sc[w] = ex2(car); car += st[w * 32 + q]; }
#pragma unroll
            for (int j = 0; j < 4; ++j) { const int d = dg * 4 + j; float v = accum[d * 32 + q];
#pragma unroll
                for (int w = 0; w < 8; ++w) v += sc[w] * ((LAS const float*)(lds + w * WB))[d * 32 + q];
                accum[d * 32 + q] = v; }
            __syncthreads();
            if (tid < 64) { const bool dd = (tid < 32) ? (car < -160.0f) : true; const bool alld = __all(dd); if (tid < 32) st[256 + q] = car; if (tid == 0) st[320] = alld ? 1.f : 0.f; }
            __syncthreads();
        }
        if (st[320] != 0.f) break;
    }
    {
        const int q = tid & 31, dg = tid >> 5;
        v2u w; w.x = cvtpk(accum[(dg * 4 + 0) * 32 + q], accum[(dg * 4 + 1) * 32 + q]); w.y = cvtpk(accum[(dg * 4 + 2) * 32 + q], accum[(dg * 4 + 3) * 32 + q]);
        *(v2u*)(Ob + (size_t)q * op + dg * 4) = w;
    }
    __syncthreads();
}
}

#ifndef ATT_MASK
#define ATT_MASK 63
#endif
#define ATT_LAMBDA() const float* lv = a->in[IN_LAMBDA] + l * 256; const float p1 = wave_sum(lv[lane] * lv[64 + lane]), p2 = wave_sum(lv[128 + lane] * lv[192 + lane]); \
    const float lam_init = 0.8f - 0.6f * expf(-0.3f * (float)l); const float lam = expf(p1) - expf(p2) + lam_init, oml = 1.0f - lam_init; const float* subg = a->in[IN_SUBLN_G] + l * 128;
#define ATT_SITE() const int wave = wave_in; const int lane = hw_lane(); const int tid = wave * 64 + lane;
#define ATT_POP(qi) if (tid == 0) *slot = __hip_atomic_fetch_add(wq + (qi), 1u, __ATOMIC_RELAXED, __HIP_MEMORY_SCOPE_AGENT); __syncthreads(); const int u = (int)*slot; __syncthreads();
template <int AMASK = ATT_MASK> __device__ __forceinline__ void attn_phase(CArgsP a, int l, LAS unsigned char* lds, unsigned* wq  , int wave_in  ) {
    unsigned char* ws = a->ws;
    const bf16* Z = (const bf16*)(ws + WS_Z); const bf16* Qm = (const bf16*)(ws + WS_Q); const bf16* Km = (const bf16*)(ws + WS_KMLA); const bf16* KNMV = (const bf16*)(ws + WS_KNMV);
    const bf16* KMC = (const bf16*)(ws + WS_KMLAC) + (size_t)l * NCACHE * 768; const bf16* KNMVC = (const bf16*)(ws + WS_KNMVC);
    bf16* Omla = (bf16*)(ws + WS_O); bf16* Osb = Omla + (size_t)kR * 512; bf16* Odiff = Osb + (size_t)kR * 512;
    LAS unsigned char* xch = lds + RING_BYTES;
    LAS volatile unsigned* slot = (LAS volatile unsigned*)(xch + 4096);
    if constexpr (AMASK & 1) { ATT_SITE() ATT_LAMBDA() for (;;) { ATT_POP(0) if (u >= 64) break;
        const int b = u >> 2, h = u & 3, gm = wave >> 2;
        att::SampleSrc S;
        S.kc = a->in[IN_CDK] + ((size_t)l * NCACHE + (size_t)b * PASTL) * 512 + (2 * h + gm) * 64; S.kcp = 512;
        S.vc = a->in[IN_CDV] + ((size_t)l * NCACHE + (size_t)b * PASTL) * 512 + h * 128; S.vcp = 512;
        const bf16* zr = Z + (size_t)(kRP + b * 32) * kZW;
        S.kn = zr + ZC_DK + (2 * h + gm) * 64; S.knp = kZW; S.vn = zr + ZC_DV + h * 128; S.vnp = kZW; S.q = zr + ZC_DQ + (2 * h + gm) * 64; S.qp = kZW;
        const float slope2 = exp2f(-2.0f * (float)(h + 1)) * LOG2E;
        att::sample_unit<att::DIFF>(lds, xch, S, Odiff + (size_t)(kRP + b * 32) * 512 + h * 128, 512, tid, lane, wave, slope2, lam, oml, subg); } }
    if constexpr (AMASK & 4) { ATT_SITE() for (;;) { ATT_POP(5) if (u >= 128) break;
        const int b = u >> 3, h = u & 7;
        att::SampleSrc S;
        S.kc = KMC + (size_t)b * PASTL * 768 + h * 96; S.kcp = 768; S.vc = (const bf16*)(ws + WS_CKVB) + ((size_t)l * NCACHE + (size_t)b * PASTL) * 128; S.vcp = 128;
        S.kn = Km + (size_t)(kRP + b * 32) * 768 + h * 96; S.knp = 768; S.vn = Z + (size_t)(kRP + b * 32) * kZW + ZC_CKV; S.vnp = kZW;
        S.q = Qm + (size_t)(kRP + b * 32) * 768 + h * 96; S.qp = 768;
        att::sample_unit<att::MLA>(lds, xch, S, Omla + (size_t)(kRP + b * 32) * 512 + h * 64, 512, tid, lane, wave, 0.f, 0.f, 0.f, nullptr, a->in[IN_WUV] + (size_t)l * 128 * 512 + h * 64); } }
    if constexpr (AMASK & 2) { ATT_SITE() for (;;) { ATT_POP(4) if (u >= 128) break;
        const int b = u >> 3, h = u & 7;
        att::SampleSrc S;
        S.kc = a->in[IN_CSBK] + ((size_t)l * NCACHE + (size_t)b * PASTL) * 512 + h * 64; S.kcp = 512;
        S.vc = a->in[IN_CSBV] + ((size_t)l * NCACHE + (size_t)b * PASTL) * 512 + h * 64; S.vcp = 512;
        const bf16* zr = Z + (size_t)(kRP + b * 32) * kZW;
        S.kn = zr + ZC_SK + h * 64; S.knp = kZW; S.vn = zr + ZC_SV + h * 64; S.vnp = kZW; S.q = zr + ZC_SQ + h * 64; S.qp = kZW;
        att::sample_unit_sb(lds, xch, S, Osb + (size_t)(kRP + b * 32) * 512 + h * 64, 512, tid, lane, wave); } }
    if constexpr (AMASK & 8) { ATT_SITE() ATT_LAMBDA() for (;;) { ATT_POP(1) if (u >= 512) break;
        const int qb = 15 - (u >> 5), w = u & 31, b = w >> 2, h = w & 3; const bf16* zr = Z + (size_t)(b * 2048) * kZW;
        const float slope2 = exp2f(-2.0f * (float)(h + 1)) * LOG2E;
        att::prompt_unit<att::DIFF>(lds, zr + ZC_DQ + h * 128, kZW, zr + ZC_DK + h * 128, kZW, zr + ZC_DV + h * 128, kZW, Odiff + (size_t)(b * 2048) * 512 + h * 128, 512, qb * 128, tid, lane, wave, slope2, lam, oml, subg); } }
    if constexpr (AMASK & 16) { ATT_SITE() for (;;) { ATT_POP(2) if (u >= 512) break;
        const int qb = 7 - (u >> 6), w = u & 63, b = w >> 3, h = w & 7; const bf16* zr = Z + (size_t)(b * 2048) * kZW;
        att::prompt_unit<att::SBK>(lds, zr + ZC_SQ + h * 64, kZW, zr + ZC_SK + h * 64, kZW, zr + ZC_SV + h * 64, kZW, Osb + (size_t)(b * 2048) * 512 + h * 64, 512, qb * 256, tid, lane, wave, 0.f, 0.f, 0.f, nullptr); } }
    if constexpr (AMASK & 32) { ATT_SITE() for (;;) { ATT_POP(3) if (u >= 512) break;
        const int qb = 7 - (u >> 6), w = u & 63, b = w >> 3, h = w & 7;
        att::prompt_unit<att::MLA>(lds, Qm + (size_t)(b * 2048) * 768 + h * 96, 768, Km + (size_t)(b * 2048) * 768 + h * 96, 768, KNMV + (size_t)(b * 2048) * 1024 + 512 + h * 64, 1024,
                                   Omla + (size_t)(b * 2048) * 512 + h * 64, 512, qb * 256, tid, lane, wave, 0.f, 0.f, 0.f, nullptr); } }
    if (l == 0) { ATT_SITE() LAS float* scr = (LAS float*)(lds + wave * 16384);
        for (;;) { ATT_POP(6) if (u >= p0w::NCHUNK) break;
#pragma unroll 1
            for (int k = 0; k < 8; ++k) { const int it = p0w::CL + u * p0w::CHUNK + k * 8 + wave; if (it < 2 * p0w::CL) p0_weight_item(a, it, scr, lane); } } }
}
namespace sm {
typedef short bf16x8 __attribute__((ext_vector_type(8)));
typedef float f32x16 __attribute__((ext_vector_type(16)));
constexpr int ROW0 = 16384, MROWS = 512, NCOLS = 1024, NTILES = (MROWS / 32) * (NCOLS / 32);
template <int KSTEPS  , class Epi>
__device__ __forceinline__ void small_gemm(LAS unsigned char* lds, const bf16* A, int lda, const bf16* Bt, int K, const Epi& E, int blk, int nblk, int wave, int lane) {
    constexpr int CH = KSTEPS <= 11 ? KSTEPS : KSTEPS / 2; static_assert(KSTEPS <= 11 || KSTEPS % 2 == 0, "k split");
    const int c = lane & 31, hi = lane >> 5;
    LAS float* part = (LAS float*)lds;
    for (int t0 = blk; t0 < NTILES; t0 += 2 * nblk) {
        const int t1 = t0 + nblk; const bool two = t1 < NTILES;
        const int ta = t0, tb = two ? t1 : t0;
        const int m0a = ROW0 + 32 * (ta >> 5), n0a = 32 * (ta & 31), m0b = ROW0 + 32 * (tb >> 5), n0b = 32 * (tb & 31);
        const bf16* apa = A + (size_t)(m0a + c) * lda + wave * (KSTEPS * 16) + hi * 8; const bf16* bpa = Bt + (size_t)(n0a + c) * K + wave * (KSTEPS * 16) + hi * 8;
        const bf16* apb = A + (size_t)(m0b + c) * lda + wave * (KSTEPS * 16) + hi * 8; const bf16* bpb = Bt + (size_t)(n0b + c) * K + wave * (KSTEPS * 16) + hi * 8;
        f32x16 acca = {0.f, 0.f, 0.f, 0.f, 0.f, 0.f, 0.f, 0.f, 0.f, 0.f, 0.f, 0.f, 0.f, 0.f, 0.f, 0.f}, accb = acca;
#pragma unroll
        for (int k0 = 0; k0 < KSTEPS; k0 += CH) {
            bf16x8 afa[CH], bfa[CH], afb[CH], bfb[CH];
#pragma unroll
            for (int j = 0; j < CH; ++j) { afa[j] = *(const bf16x8*)(apa + (k0 + j) * 16); bfa[j] = *(const bf16x8*)(bpa + (k0 + j) * 16);
                                           afb[j] = *(const bf16x8*)(apb + (k0 + j) * 16); bfb[j] = *(const bf16x8*)(bpb + (k0 + j) * 16); }
#pragma unroll
            for (int j = 0; j < CH; ++j) { acca = __builtin_amdgcn_mfma_f32_32x32x16_bf16(bfa[j], afa[j], acca, 0, 0, 0); accb = __builtin_amdgcn_mfma_f32_32x32x16_bf16(bfb[j], afb[j], accb, 0, 0, 0); }
        }
#pragma unroll
        for (int r = 0; r < 16; ++r) { part[(wave * 16 + r) * 64 + lane] = acca[r]; part[8192 + (wave * 16 + r) * 64 + lane] = accb[r]; }
        __syncthreads();
        {
            const int g = wave & 3; const bool second = wave >= 4;
            if (!second || two) {
                LAS const float* pp = part + (second ? 8192 : 0);
                f32x4 v = {0.f, 0.f, 0.f, 0.f};
#pragma unroll
                for (int w = 0; w < 8; ++w)
#pragma unroll
                    for (int i = 0; i < 4; ++i) v[i] += pp[(w * 16 + 4 * g + i) * 64 + lane];
                E(v, (second ? m0b : m0a) + c, (second ? n0b : n0a) + 4 * hi + 8 * g, lane);
            }
        }
        __syncthreads();
    }
}
template <int J> struct EpiBranchS {
    const bf16* Z; bf16* P; bf16* Mb;
    __device__ __forceinline__ void operator()(f32x4 v, int row, int col, int lane) const {
        const v2u gw_ = *(const v2u*)(Z + (size_t)row * pg8::kZW + pg8::ZC_G + J * 1024 + col);
        v[0] *= pg8::fast_sigmoid(bflo(gw_.x)); v[1] *= pg8::fast_sigmoid(bfhi(gw_.x)); v[2] *= pg8::fast_sigmoid(bflo(gw_.y)); v[3] *= pg8::fast_sigmoid(bfhi(gw_.y));
        bf16* pp = P + (size_t)row * 1024 + col;
        if (J >= 1) { const v2u q = *(const v2u*)pp; v[0] += bflo(q.x); v[1] += bfhi(q.x); v[2] += bflo(q.y); v[3] += bfhi(q.y); }
        v2u w; w.x = pk2(v[0], v[1]); w.y = pk2(v[2], v[3]);
        *(v2u*)((J <= 1 ? pp : Mb + (size_t)row * 1024 + col)) = w;
    }
};
struct EpiResS {
    float* X; bf16* Xb; float* ssq_next;
    __device__ __forceinline__ void operator()(f32x4 v, int row, int col, int lane) const {
        float* xp = X + (size_t)row * 1024 + col;
        v += *(const f32x4*)xp; *(f32x4*)xp = v;
        if (Xb) { v2u w; w.x = pk2(v[0], v[1]); w.y = pk2(v[2], v[3]); *(v2u*)(Xb + (size_t)row * 1024 + col) = w; }
        if (ssq_next) { float s = (v[0] * v[0] + v[1] * v[1]) + (v[2] * v[2] + v[3] * v[3]); s = half_sum(s); if (lane < 32) __hip_atomic_fetch_add(ssq_next + row, s, __ATOMIC_RELAXED, __HIP_MEMORY_SCOPE_AGENT); }
    }
};
}

#ifndef GEMM_ALIGN
#define GEMM_ALIGN true
#endif
#define GRID_BAR() do { CArgsP ab_ = (CArgsP)__builtin_amdgcn_kernarg_segment_ptr(); asm volatile("" : "+s"(ab_)); unsigned char* wsb_ = ab_->ws; XcdBarrier bar_; bar_.bar = (unsigned*)(wsb_ + WS_CTL) + CW_BAR; bar_.x = xb_xcc_id(); \
    bar_.st = (volatile LAS unsigned*)(lds + MISC_OFF) + 8; xcd_barrier(bar_, wave0 == 0 && hw_lane() == 0); } while (0)
#define FRESH() CArgsP a = (CArgsP)__builtin_amdgcn_kernarg_segment_ptr(); asm volatile("" : "+s"(a)); const int wave = wave0; const int lane = hw_lane(); const int tid = wave * 64 + lane; \
    const int gw = blockIdx.x * NWAVES + wave, NGW = gridDim.x * NWAVES, G = gridDim.x; \
    unsigned char* ws = a->ws; float* ssq = (float*)(ws + WS_CTL) + CW_SSQ; (void)lane; (void)gw; (void)NGW; (void)G; (void)ssq


template <int l> __device__ __forceinline__ void layer_phases(LAS unsigned char* lds, const int wave0) {
        {
            FRESH(); bf16* wl = (bf16*)(ws + WS_W + (size_t)l * WL_SIZE);
            pg8::Gemm g{(const bf16*)(ws + WS_XB), (const bf16*)((unsigned char*)wl + WL_IN), kR, kZW, 1024, 1024}; pg8::StaticOrder S; S.init(kR, kZW, G, (int)blockIdx.x);
            pg8::EpiIn E{(const void __attribute__((address_space(4)))*)a, l, (PG8_LAS float*)(lds + RING_BYTES),
                         WS_Z, WS_CTL + (size_t)(CW_SSQ + 2 * l * kR) * 4, WS_ROPE, WS_KMLA, OUT_PCKV, OUT_SCKV, OUT_PKR, OUT_SKR, OUT_PSBK, OUT_SSBK,
                         N_INPUTS, N_INPUTS + 1, IN_QNG, IN_KVNG, IN_KR_G, IN_DQN_G, IN_DKN_G};
            pg8::gemm_phase<pg8::EpiIn, pg8::StaticOrder, true, true>(lds, g, S, E, tid);
        }
        { FRESH(); bf16* wl = (bf16*)(ws + WS_W + (size_t)l * WL_SIZE);
          pg8::Gemm g{(const bf16*)(ws + WS_CKVB) + (size_t)l * NCACHE * 128, (const bf16*)((unsigned char*)wl + WL_UKV), NCACHE, 512, 128, 128}; typedef pg8::TailOrder<2, (NCACHE / 256) * 2, (kR / 256) * (kZW / 256), 3> KcOrder;   KcOrder S; S.init(G, (int)blockIdx.x);
          pg8::EpiKV E{(bf16*)(ws + WS_KMLAC) + (size_t)l * NCACHE * 768, (bf16*)(ws + WS_KNMVC), a->in[IN_KN_G] + l * 64}; pg8::gemm_phase<pg8::EpiKV, KcOrder, GEMM_ALIGN, true>(lds, g, S, E, tid); }
        GRID_BAR();
        {
            { FRESH(); bf16* wl = (bf16*)(ws + WS_W + (size_t)l * WL_SIZE);
              pg8::Gemm g{(const bf16*)(ws + WS_Z) + ZC_CQ, (const bf16*)((unsigned char*)wl + WL_UQ), kR, 768, 256, kZW}; pg8::StaticOrder S; S.init(kR, 768, G, (int)blockIdx.x);
              pg8::EpiQ E{(bf16*)(ws + WS_Q), a->in[IN_QN_G] + l * 64, a->in[IN_QR_G] + l * 32, (const float*)(ws + WS_ROPE)}; pg8::gemm_phase<pg8::EpiQ, pg8::StaticOrder, GEMM_ALIGN, true>(lds, g, S, E, tid); }
            { FRESH(); bf16* wl = (bf16*)(ws + WS_W + (size_t)l * WL_SIZE);
              pg8::Gemm g{(const bf16*)(ws + WS_Z) + ZC_CKV, (const bf16*)((unsigned char*)wl + WL_UKV), kR, 1024, 128, kZW}; pg8::StaticOrder S; S.init(kR, 1024, G, (int)blockIdx.x);
              pg8::EpiKV E{(bf16*)(ws + WS_KMLA), (bf16*)(ws + WS_KNMV), a->in[IN_KN_G] + l * 64}; pg8::gemm_phase<pg8::EpiKV, pg8::StaticOrder, GEMM_ALIGN, true>(lds, g, S, E, tid); }
        }
        GRID_BAR();
        { FRESH(); attn_phase(a, l, lds, (unsigned*)(ws + WS_CTL) + CW_WQ + 8 * l, wave0); }
        GRID_BAR();
        {
            { FRESH(); bf16* wl = (bf16*)(ws + WS_W + (size_t)l * WL_SIZE);
              pg8::Gemm g{(const bf16*)(ws + WS_O), (const bf16*)((unsigned char*)wl + WL_BR), 3 * kR, 3 * 1024, 512, 512}; pg8::BranchOrder S; S.init(kRP, G, (int)blockIdx.x);
              pg8::EpiBranchAll E{(const bf16*)(ws + WS_Z), (bf16*)(ws + WS_MP), (bf16*)(ws + WS_MB)}; pg8::gemm_phase<pg8::EpiBranchAll, pg8::BranchOrder, GEMM_ALIGN, true>(lds, g, S, E, tid);
              { sm::EpiBranchS<0> Es{(const bf16*)(ws + WS_Z), (bf16*)(ws + WS_MP), (bf16*)(ws + WS_MB)}; sm::small_gemm<4>(lds, g.A, 512, g.Bt, 512, Es, (int)blockIdx.x, G, wave, lane); }
              { sm::EpiBranchS<1> Es{(const bf16*)(ws + WS_Z), (bf16*)(ws + WS_MP), (bf16*)(ws + WS_MB)}; sm::small_gemm<4>(lds, g.A + (size_t)kR * 512, 512, g.Bt + (size_t)1024 * 512, 512, Es, (int)blockIdx.x, G, wave, lane); }
              { sm::EpiBranchS<2> Es{(const bf16*)(ws + WS_Z), (bf16*)(ws + WS_MP), (bf16*)(ws + WS_MB)}; sm::small_gemm<4>(lds, g.A + (size_t)2 * kR * 512, 512, g.Bt + (size_t)2 * 1024 * 512, 512, Es, (int)blockIdx.x, G, wave, lane); } }
        }
        GRID_BAR();
        {
            FRESH(); bf16* wl = (bf16*)(ws + WS_W + (size_t)l * WL_SIZE);
            pg8::Gemm g{(const bf16*)(ws + WS_MB), (const bf16*)((unsigned char*)wl + WL_OUT), kRP, 1024, 1024, 1024}; pg8::StaticOrder S; S.init(kRP, 1024, G, (int)blockIdx.x);
            pg8::EpiRes E{a->out, (bf16*)(ws + WS_XB), ssq + (2 * l + 1) * kR};
            pg8::gemm_phase<pg8::EpiRes, pg8::StaticOrder, GEMM_ALIGN, true>(lds, g, S, E, tid);
            sm::EpiResS Es{a->out, (bf16*)(ws + WS_XB), ssq + (2 * l + 1) * kR}; sm::small_gemm<8>(lds, g.A, 1024, g.Bt, 1024, Es, (int)blockIdx.x, G, wave, lane);
        }
        GRID_BAR();
        {
            FRESH(); bf16* wl = (bf16*)(ws + WS_W + (size_t)l * WL_SIZE);
            pg8::Gemm g{(const bf16*)(ws + WS_XB) - 2 * 1024, (const bf16*)((unsigned char*)wl + WL_UP), 67 * 256, 5632, 1024, 1024, 254}; pg8::StaticOrder S; S.init(67 * 256, 5632, G, (int)blockIdx.x);
            pg8::EpiUpConv E{(bf16*)(ws + WS_ACT), ssq + (2 * l + 1) * kR, a->in[IN_CONVW] + (size_t)l * 3 * DFF, a->in[IN_CONVB] + (size_t)l * DFF, a->in[IN_CONV] + (size_t)l * 16 * 2 * DFF, a->out,
                             OUT_PCONV + (size_t)l * 8 * 2 * DFF, OUT_SCONV + (size_t)l * 16 * 2 * DFF, (PG8_LAS float*)(lds + RING_BYTES)};
            pg8::gemm_phase<pg8::EpiUpConv, pg8::StaticOrder, true, true>(lds, g, S, E, tid);
        }
        GRID_BAR();
        {
            FRESH(); bf16* wl = (bf16*)(ws + WS_W + (size_t)l * WL_SIZE);
            pg8::Gemm g{(const bf16*)(ws + WS_ACT), (const bf16*)((unsigned char*)wl + WL_DOWN), kRP, 1024, DFF, DFF}; pg8::StaticOrder S; S.init(kRP, 1024, G, (int)blockIdx.x);
            pg8::EpiRes E{a->out, l == 0 ? (bf16*)(ws + WS_XB) : nullptr, l == 0 ? ssq + 2 * kR : nullptr};
            pg8::gemm_phase<pg8::EpiRes, pg8::StaticOrder, GEMM_ALIGN, true>(lds, g, S, E, tid);
            sm::EpiResS Es{a->out, l == 0 ? (bf16*)(ws + WS_XB) : nullptr, l == 0 ? ssq + 2 * kR : nullptr}; sm::small_gemm<22>(lds, g.A, DFF, g.Bt, DFF, Es, (int)blockIdx.x, G, wave, lane);
        }
}

__global__ void __launch_bounds__(512, 2) k_mega(Args a_) {
    extern __shared__ __attribute__((aligned(16))) unsigned char lds_[];
    LAS unsigned char* lds = (LAS unsigned char*)lds_;
    const int wave0 = __builtin_amdgcn_readfirstlane((int)threadIdx.x >> 6);
    {
        volatile LAS unsigned* MISC0 = (volatile LAS unsigned*)(lds + MISC_OFF);
        if (wave0 == 0) { const int l0 = hw_lane(); if (l0 < 32) MISC0[l0] = 0u; }
        __syncthreads();
    }
    (void)xcd_barrier_post((unsigned*)(a_.ws + WS_CTL) + CW_BAR, (volatile LAS unsigned*)(lds + MISC_OFF) + 8, wave0 == 0 && hw_lane() == 0);
    { FRESH(); p0_phase(a, lds, gw, NGW, wave, lane); }
    GRID_BAR();
    layer_phases<0>(lds, wave0);
    GRID_BAR();
    layer_phases<1>(lds, wave0);
}

extern "C" void kernel_launch(void* const* d_in, const int* in_sizes, int n_in, void* d_out, int out_size, void* d_ws, size_t ws_size, hipStream_t stream) {
    static int grid = 0;
    if (grid == 0) {
        int dev = 0, cus = 0, per_cu = 0;
        if (hipGetDevice(&dev) != hipSuccess || hipDeviceGetAttribute(&cus, hipDeviceAttributeMultiprocessorCount, dev) != hipSuccess) { fprintf(stderr, "kernel_launch: device query failed\n"); grid = -1; return; }
        if (hipFuncSetAttribute((const void*)k_mega, hipFuncAttributeMaxDynamicSharedMemorySize, LDS_BYTES) != hipSuccess) { fprintf(stderr, "kernel_launch: hipFuncSetAttribute failed\n"); grid = -1; return; }
        if (hipOccupancyMaxActiveBlocksPerMultiprocessor(&per_cu, (const void*)k_mega, 512, LDS_BYTES) != hipSuccess || per_cu < 1) { fprintf(stderr, "kernel_launch: occupancy query reports %d blocks per CU\n", per_cu); per_cu = 1; }
        (void)hipGetLastError();
        grid = cus;
    }
    if (grid < 0) return;
    static_assert(WS_FAST_END <= (size_t)1374208512, "workspace");
    if (hipMemsetAsync((char*)d_ws + WS_CTL, 0, CTL_ZERO_BYTES, stream) != hipSuccess) return;
    Args a{};
    for (int i = 0; i < N_INPUTS; ++i) a.in[i] = (const float*)d_in[i];
    a.out = (float*)d_out; a.ws = (unsigned char*)d_ws; a.layer = 0; a.pad = 0;
    hipLaunchKernelGGL(k_mega, dim3(grid), dim3(512), LDS_BYTES, stream, a);
}
```

```cpp
#include <hip/hip_runtime.h>
#include <math.h>
#include <cstdio>
#include <cstdint>
__device__ __forceinline__ int hw_lane() { int l; asm volatile("v_mbcnt_lo_u32_b32 %0, -1, 0\n\tv_mbcnt_hi_u32_b32 %0, -1, %0" : "=v"(l)); return l; }
template <int M> __device__ __forceinline__ float sw_xor(float v) { return __builtin_bit_cast(float, __builtin_amdgcn_ds_swizzle(__builtin_bit_cast(int, v), 0x1f | (M << 10))); }
__device__ __forceinline__ float half_sum(float v) { const unsigned u = __builtin_bit_cast(unsigned, v); auto rr = __builtin_amdgcn_permlane32_swap(u, u, false, false); return __builtin_bit_cast(float, (unsigned)rr[0]) + __builtin_bit_cast(float, (unsigned)rr[1]); }
__device__ __forceinline__ float half_max(float v) { const unsigned u = __builtin_bit_cast(unsigned, v); auto rr = __builtin_amdgcn_permlane32_swap(u, u, false, false); return fmaxf(__builtin_bit_cast(float, (unsigned)rr[0]), __builtin_bit_cast(float, (unsigned)rr[1])); }
__device__ __forceinline__ float half_other(float v, int hi) { const unsigned u = __builtin_bit_cast(unsigned, v); auto rr = __builtin_amdgcn_permlane32_swap(u, u, false, false); return __builtin_bit_cast(float, (unsigned)(hi ? rr[0] : rr[1])); }
namespace pg8 {
#define PG8_LAS __attribute__((address_space(3)))
typedef unsigned short bf16_t;
typedef short bf16x8 __attribute__((ext_vector_type(8)));
typedef float f32x4 __attribute__((ext_vector_type(4)));
typedef unsigned u32x4 __attribute__((ext_vector_type(4)));
constexpr int BM = 256, BK = 64, HALF = 128, HTB = HALF * BK * 2  , STAGE_BYTES = 8 * HTB, NXCD = 8, WGM = 8;

__host__ __device__ __forceinline__ int lds_byte(int r, int c) { const int st = (r >> 4) * 2 + (c >> 5), rr = r & 15, cc = c & 31, ob = rr * 64 + cc * 2; return st * 1024 + (ob ^ (((ob >> 9) & 1) << 5)); }
__host__ __device__ __forceinline__ void stage_rc(int b, int& R, int& C) { const int st = b / 1024, sb = b % 1024, swz = sb ^ (((sb >> 9) & 1) << 5); R = (st >> 1) * 16 + swz / 64; C = (st & 1) * 32 + (swz % 64) / 2; }
__host__ __device__ __forceinline__ int perm32(int rho) { const int n = rho >> 4, i = rho & 15; return 8 * (i >> 2) + 4 * n + (i & 3); }

struct Unit { int pm, pn; };
struct Gemm { const bf16_t* A; const bf16_t* Bt; int M, N, K, lda; int prows = 256; };

struct StaticOrder {
    int nM, nN, nwg, G, c;
    __host__ __device__ void init(int M, int N, int G_, int c_) { nM = M / BM; nN = N / BM; nwg = nM * nN; G = G_; c = c_; }
    __host__ __device__ bool next(int i, Unit& u) const {
        const long L = (long)i * G + c; if (L >= nwg) return false;
        int wgid = (int)L; { const int q = nwg / NXCD, r = nwg % NXCD, xcd = wgid % NXCD, off = wgid / NXCD; wgid = (xcd < r ? xcd * (q + 1) : r * (q + 1) + (xcd - r) * q) + off; }
        const int nig = WGM * nN, gid = wgid / nig, fm = gid * WGM, gsz = (nM - fm) < WGM ? (nM - fm) : WGM;
        u.pm = fm + ((wgid % nig) % gsz); u.pn = (wgid % nig) / gsz; return true;
    }
    __device__ __forceinline__ void a_ready(const Unit&) const {}
    __device__ __forceinline__ void done(const Unit&) const {}
};

struct BranchOrder {
    StaticOrder S;
    __host__ __device__ void init(int M, int G_, int c_) { S.init(M, 1024, G_, c_); }
    __host__ __device__ bool next(int i, Unit& u) const { Unit t; const int j = i % 3; if (!S.next(i / 3, t)) return false; u.pm = 66 * j + t.pm; u.pn = 4 * j + t.pn; return true; }
    __device__ __forceinline__ void a_ready(const Unit&) const {}
    __device__ __forceinline__ void done(const Unit&) const {}
};
template <int NN  , int NWG  , int FIRST  , int E> struct TailOrder {
    int G, c, rem, e;
    __host__ __device__ void init(int G_, int c_) { G = G_; c = c_; rem = FIRST % G_; e = rem ? E : 0; }
    __host__ __device__ bool next(int i, Unit& u) const {
        const int extra = (G - rem) * e; int L;
        if (c >= rem) L = i < e ? (c - rem) * e + i : extra + (i - e) * G + c; else L = extra + i * G + c;
        if (L >= NWG) return false; u.pm = L / NN; u.pn = L % NN; return true; }
    __device__ __forceinline__ void a_ready(const Unit&) const {}
    __device__ __forceinline__ void done(const Unit&) const {}
};
struct SubOrder {
    StaticOrder S; int pn0;
    __host__ __device__ void init(int M, int ntn, int pn0_, int G_, int c_) { S.init(M, ntn * BM, G_, c_); pn0 = pn0_; }
    __host__ __device__ bool next(int i, Unit& u) const { const bool ok = S.next(i, u); u.pn += pn0; return ok; }
    __device__ __forceinline__ void a_ready(const Unit&) const {}
    __device__ __forceinline__ void done(const Unit&) const {}
};

__device__ __forceinline__ unsigned cvt_pk_bf16(float lo, float hi) { unsigned r; asm volatile("v_cvt_pk_bf16_f32 %0, %1, %2" : "=v"(r) : "v"(lo), "v"(hi)); return r; }
constexpr int kR = 16896, kRP = 16384, kRS = 512, kZW = 6656;
constexpr int ZC_CQ = 0, ZC_CKV = 256, ZC_KR = 384, ZC_SQ = 512, ZC_SK = 1024, ZC_SV = 1536, ZC_DQ = 2048, ZC_DK = 2560, ZC_DV = 3072, ZC_G = 3584;
constexpr float kEPS = 1e-6f;
typedef float f32x2 __attribute__((ext_vector_type(2)));
__device__ __forceinline__ float bf_lo(unsigned w) { return __uint_as_float(w << 16); }
__device__ __forceinline__ float bf_hi(unsigned w) { return __uint_as_float(w & 0xffff0000u); }
__device__ __forceinline__ float fast_sigmoid(float x) { return __builtin_amdgcn_rcpf(1.0f + __expf(-x)); }

#ifndef EPI_SC1
#define EPI_SC1 0
#endif
template <class T> __device__ __forceinline__ void st16(const void __attribute__((address_space(1)))* p, T v) {
#if EPI_SC1
    asm volatile("global_store_dwordx4 %0, %1, off sc1" :: "v"(p), "v"(v));
#else
    *(T __attribute__((address_space(1)))*)p = v;
#endif
}
template <class T> __device__ __forceinline__ void st16(const void* p, T v) { st16((const void __attribute__((address_space(1)))*)p, v); }
__device__ __forceinline__ void epi_bar() { asm volatile("s_waitcnt lgkmcnt(0)" ::: "memory"); __builtin_amdgcn_s_barrier(); asm volatile("" ::: "memory"); }
__device__ __forceinline__ float sq8(const f32x4& a, const f32x4& b) { return (a[0] * a[0] + a[1] * a[1]) + (a[2] * a[2] + a[3] * a[3]) + (b[0] * b[0] + b[1] * b[1]) + (b[2] * b[2] + b[3] * b[3]); }
__device__ __forceinline__ u32x4 pack8f(const f32x4& a, const f32x4& b) { u32x4 w; w.x = cvt_pk_bf16(a[0], a[1]); w.y = cvt_pk_bf16(a[2], a[3]); w.z = cvt_pk_bf16(b[0], b[1]); w.w = cvt_pk_bf16(b[2], b[3]); return w; }
constexpr float kQS64 = 0.125f * 1.4426950408889634f, kQSMLA = 0.10206207261596577f * 1.4426950408889634f;

__device__ __forceinline__ void rope_cs4(int pos, int j0, f32x4& c, f32x4& s) {
#pragma unroll
    for (int i = 0; i < 4; ++i) { const float invrev = __builtin_amdgcn_exp2f(-(float)(j0 + i) * (13.287712379549449f / 16.0f)) * 0.15915494309189535f;
        const float ph = __builtin_amdgcn_fractf((float)pos * invrev); c[i] = __builtin_amdgcn_cosf(ph); s[i] = __builtin_amdgcn_sinf(ph); }
}
struct EpiIn {
    static constexpr bool PERM = true, AFTER_DRAIN = false;
    const void __attribute__((address_space(4)))* kargs; int layer; PG8_LAS float* xs;
    size_t ws_z, ws_ssq, ws_rope, ws_kmla;
    size_t off_p_ckv, off_s_ckv, off_p_kr, off_s_kr, off_p_sbk, off_s_sbk;
    int i_out, i_ws, i_qng, i_kvng, i_krg, i_dqg, i_dkg;
    __device__ __forceinline__ void operator()(const f32x4 (&acc)[2][2][4][2], const Unit& u, int wr, int wc, int fr_in, int fq_in) const {
        const int ln_ = hw_lane(); const int fr = ln_ & 15, fq = ln_ >> 4; (void)fr_in; (void)fq_in;
        const void __attribute__((address_space(4)))* ka = kargs; asm volatile("" : "+s"(ka));
        typedef const unsigned long long __attribute__((address_space(4)))* KP_;
#define EPI_G __attribute__((address_space(1)))
#define EPI_ARG(T, i) ((T EPI_G*)(((KP_)ka)[i]))
        unsigned char EPI_G* wsb = EPI_ARG(unsigned char, i_ws); float EPI_G* out = EPI_ARG(float, i_out);
        bf16_t EPI_G* Z = (bf16_t EPI_G*)(wsb + ws_z); const float EPI_G* ssq = (const float EPI_G*)(wsb + ws_ssq);
        const int pn = u.pn; const bool prompt = u.pm < 64;
        const int row0 = u.pm * BM + wr * 64 + fr, col0 = pn * BM + wc * 64 + 8 * fq;
        const size_t nrows = prompt ? (size_t)kRP : (size_t)kRS;
        float rs[2][4];
#pragma unroll
        for (int ai = 0; ai < 2; ++ai)
#pragma unroll
            for (int m = 0; m < 4; ++m) rs[ai][m] = __hip_atomic_load(ssq + row0 + ai * HALF + m * 16, __ATOMIC_RELAXED, __HIP_MEMORY_SCOPE_AGENT);
#pragma unroll
        for (int ai = 0; ai < 2; ++ai)
#pragma unroll
            for (int m = 0; m < 4; ++m) rs[ai][m] = rsqrtf(rs[ai][m] * (1.0f / 1024.0f) + kEPS);
        if (pn >= 14 || pn == 2 || pn == 3) {
            const float sc = pn < 14 ? kQS64 : 1.0f;
#pragma unroll
            for (int ai = 0; ai < 2; ++ai)
#pragma unroll
                for (int m = 0; m < 4; ++m) { const int row = row0 + ai * HALF + m * 16; const float r_ = rs[ai][m] * sc;
#pragma unroll
                    for (int bj = 0; bj < 2; ++bj) st16((Z + (size_t)row * kZW + col0 + 32 * bj), pack8f(acc[ai][bj][m][0] * r_, acc[ai][bj][m][1] * r_)); }
        } else if ((pn >= 4 && pn < 8) || pn == 12 || pn == 13) {
            const int sel = pn < 6 ? 0 : (pn < 8 ? 1 : 3);
            float EPI_G* fdst = out + (prompt ? off_p_sbk : off_s_sbk) + ((size_t)sel * 2 + layer) * nrows * 512 + (pn & 1) * 256 + wc * 64 + 8 * fq;
#pragma unroll
            for (int ai = 0; ai < 2; ++ai)
#pragma unroll
                for (int m = 0; m < 4; ++m) { const int row = row0 + ai * HALF + m * 16; const int orow = prompt ? row : row - kRP; const float r_ = rs[ai][m];
#pragma unroll
                    for (int bj = 0; bj < 2; ++bj) { const f32x4 v0 = acc[ai][bj][m][0] * r_, v1 = acc[ai][bj][m][1] * r_;
                        st16((Z + (size_t)row * kZW + col0 + 32 * bj), pack8f(v0, v1));
                        float EPI_G* fp = fdst + (size_t)orow * 512 + 32 * bj; st16(fp, v0); st16((fp + 4), v1); } }
        } else if (pn >= 8 && pn < 12) {
            const bool isq = pn < 10; const float EPI_G* g = (isq ? EPI_ARG(const float, i_dqg) + layer * 64 : EPI_ARG(const float, i_dkg) + layer * 64); const float sc = isq ? kQS64 : 1.0f;
            f32x4 g0[2][2];
#pragma unroll
            for (int bj = 0; bj < 2; ++bj) { g0[bj][0] = *(const f32x4 EPI_G*)(g + 32 * bj + 8 * fq); g0[bj][1] = *(const f32x4 EPI_G*)(g + 32 * bj + 8 * fq + 4); }
            float EPI_G* fdst = out + (prompt ? off_p_sbk : off_s_sbk) + ((size_t)2 * 2 + layer) * nrows * 512 + (pn & 1) * 256 + wc * 64 + 8 * fq;
#pragma unroll
            for (int ai = 0; ai < 2; ++ai)
#pragma unroll
                for (int m = 0; m < 4; ++m) { const int row = row0 + ai * HALF + m * 16; const int orow = prompt ? row : row - kRP; const float r_ = rs[ai][m];
                    f32x4 v[2][2]; float s = 0.f;
#pragma unroll
                    for (int bj = 0; bj < 2; ++bj) { v[bj][0] = acc[ai][bj][m][0] * r_; v[bj][1] = acc[ai][bj][m][1] * r_; s += sq8(v[bj][0], v[bj][1]); }
                    s += sw_xor<16>(s); s = half_sum(s);
                    const float rn = rsqrtf(s * (1.0f / 64.0f) + kEPS) * sc;
#pragma unroll
                    for (int bj = 0; bj < 2; ++bj) { const f32x4 w0 = v[bj][0] * rn * g0[bj][0], w1 = v[bj][1] * rn * g0[bj][1];
                        st16((Z + (size_t)row * kZW + col0 + 32 * bj), pack8f(w0, w1));
                        if (!isq) { float EPI_G* fp = fdst + (size_t)orow * 512 + 32 * bj; st16(fp, w0); st16((fp + 4), w1); } } }
        } else {
            PG8_LAS unsigned char* xsb = (PG8_LAS unsigned char*)xs + (wr * 64 + fr) * 16;
            float sown[2][4];
#pragma unroll
            for (int ai = 0; ai < 2; ++ai)
#pragma unroll
                for (int m = 0; m < 4; ++m) { const float r_ = rs[ai][m]; float s = 0.f;
#pragma unroll
                    for (int bj = 0; bj < 2; ++bj) s += sq8(acc[ai][bj][m][0] * r_, acc[ai][bj][m][1] * r_);
                    s += sw_xor<16>(s); s = half_sum(s); sown[ai][m] = s;
                    if (fq == 0) *(PG8_LAS float*)(xsb + (ai * HALF + m * 16) * 16 + wc * 4) = s; }
            epi_bar();
            if (pn == 0) {
                const float EPI_G* qng = EPI_ARG(const float, i_qng) + layer * 256;
                f32x4 g0[2][2];
#pragma unroll
                for (int bj = 0; bj < 2; ++bj) { g0[bj][0] = *(const f32x4 EPI_G*)(qng + wc * 64 + 32 * bj + 8 * fq); g0[bj][1] = *(const f32x4 EPI_G*)(qng + wc * 64 + 32 * bj + 8 * fq + 4); }
#pragma unroll
                for (int ai = 0; ai < 2; ++ai)
#pragma unroll
                    for (int m = 0; m < 4; ++m) { const int rl = ai * HALF + wr * 64 + m * 16 + fr; const int row = u.pm * BM + rl;
                        const f32x4 pp = *(const PG8_LAS f32x4*)(xsb + (ai * HALF + m * 16) * 16); const float rn = rsqrtf(((pp[0] + pp[1]) + (pp[2] + pp[3])) * (1.0f / 256.0f) + kEPS) * rs[ai][m];
#pragma unroll
                        for (int bj = 0; bj < 2; ++bj) st16((Z + (size_t)row * kZW + col0 + 32 * bj), pack8f(acc[ai][bj][m][0] * rn * g0[bj][0], acc[ai][bj][m][1] * rn * g0[bj][1])); }
            } else if (wc < 2) {
                const float EPI_G* kvng = EPI_ARG(const float, i_kvng) + layer * 128;
                f32x4 g0[2][2];
#pragma unroll
                for (int bj = 0; bj < 2; ++bj) { g0[bj][0] = *(const f32x4 EPI_G*)(kvng + wc * 64 + 32 * bj + 8 * fq); g0[bj][1] = *(const f32x4 EPI_G*)(kvng + wc * 64 + 32 * bj + 8 * fq + 4); }
                float EPI_G* fdst = out + (prompt ? off_p_ckv : off_s_ckv) + (size_t)layer * nrows * 128 + wc * 64 + 8 * fq;
#pragma unroll
                for (int ai = 0; ai < 2; ++ai)
#pragma unroll
                    for (int m = 0; m < 4; ++m) { const int rl = ai * HALF + wr * 64 + m * 16 + fr; const int row = u.pm * BM + rl; const int orow = prompt ? row : row - kRP;
                        const f32x2 pq = *(const PG8_LAS f32x2*)(xsb + (ai * HALF + m * 16) * 16); const float rn = rsqrtf((pq[0] + pq[1]) * (1.0f / 128.0f) + kEPS) * rs[ai][m];
#pragma unroll
                        for (int bj = 0; bj < 2; ++bj) { const f32x4 w0 = acc[ai][bj][m][0] * rn * g0[bj][0], w1 = acc[ai][bj][m][1] * rn * g0[bj][1];
                            st16((Z + (size_t)row * kZW + col0 + 32 * bj), pack8f(w0, w1));
                            float EPI_G* fp = fdst + (size_t)orow * 128 + 32 * bj; st16(fp, w0); st16((fp + 4), w1); } }
            } else if (wc == 2) {
                const float EPI_G* krg = EPI_ARG(const float, i_krg) + layer * 32; const float EPI_G* rope = (const float EPI_G*)(wsb + ws_rope); bf16_t EPI_G* Kmla = (bf16_t EPI_G*)(wsb + ws_kmla);
                const f32x4 g0 = *(const f32x4 EPI_G*)(krg + 8 * fq), g1 = *(const f32x4 EPI_G*)(krg + 8 * fq + 4);
                float EPI_G* fdst = out + (prompt ? off_p_kr : off_s_kr) + (size_t)layer * nrows * 32 + 8 * fq;
                const bool up = fq >= 2;
#pragma unroll
                for (int ai = 0; ai < 2; ++ai)
#pragma unroll
                    for (int m = 0; m < 4; ++m) { const int row = row0 + ai * HALF + m * 16; const int orow = prompt ? row : row - kRP; const float r_ = rs[ai][m];
                        float s = sq8(acc[ai][0][m][0], acc[ai][0][m][1]) * (r_ * r_); s += sw_xor<16>(s); s = half_sum(s);
                        const float rn = rsqrtf(s * (1.0f / 32.0f) + kEPS) * r_;
                        const int pos = prompt ? (row & 2047) : 4096 + ((row - kRP) & 31);
                        float EPI_G* fp = fdst + (size_t)orow * 32;
                        f32x4 oo[2];
#pragma unroll
                        for (int n = 0; n < 2; ++n) {
                            const f32x4 v = acc[ai][0][m][n] * rn * (n == 0 ? g0 : g1);
                            f32x4 cc, ss; rope_cs4(pos, 8 * (fq & 1) + 4 * n, cc, ss);
#pragma unroll
                            for (int i = 0; i < 4; ++i) { const float pp = half_other(v[i], up ? 1 : 0);
                                oo[n][i] = up ? (pp * ss[i] + v[i] * cc[i]) : (v[i] * cc[i] - pp * ss[i]); }
                            st16((fp + 4 * n), oo[n]);
                        }
                        const u32x4 w = pack8f(oo[0], oo[1]);
                        st16((Z + (size_t)row * kZW + ZC_KR + 8 * fq), w);
#pragma unroll
                        for (int h = 0; h < 8; ++h) st16((Kmla + (size_t)row * 768 + h * 96 + 64 + 8 * fq), w);
                        asm volatile("" ::: "memory"); }
            }
            epi_bar();
        }
#undef EPI_ARG
#undef EPI_G
    }
};

struct EpiQ {
    static constexpr bool PERM = true, AFTER_DRAIN = false;
    bf16_t* Q; const float *qng, *qrg; const float* rope;
    __device__ __forceinline__ void operator()(const f32x4 (&acc)[2][2][4][2], const Unit& u, int wr, int wc, int fr_in, int fq_in) const {
        const int ln_ = hw_lane(); const int fr = ln_ & 15, fq = ln_ >> 4; (void)fr_in; (void)fq_in;
        const int row0 = u.pm * BM + wr * 64 + fr;
        if (u.pn < 2) {
            const int head = 4 * u.pn + wc;
            f32x4 g0[2][2];
#pragma unroll
            for (int bj = 0; bj < 2; ++bj) { g0[bj][0] = *(const f32x4*)(qng + 32 * bj + 8 * fq); g0[bj][1] = *(const f32x4*)(qng + 32 * bj + 8 * fq + 4); }
#pragma unroll
            for (int ai = 0; ai < 2; ++ai)
#pragma unroll
                for (int m = 0; m < 4; ++m) { const int row = row0 + ai * HALF + m * 16;
                    float s = sq8(acc[ai][0][m][0], acc[ai][0][m][1]) + sq8(acc[ai][1][m][0], acc[ai][1][m][1]); s += sw_xor<16>(s); s = half_sum(s);
                    const float rn = rsqrtf(s * (1.0f / 64.0f) + kEPS) * kQSMLA;
#pragma unroll
                    for (int bj = 0; bj < 2; ++bj) st16((Q + (size_t)row * 768 + head * 96 + 32 * bj + 8 * fq), pack8f(acc[ai][bj][m][0] * rn * g0[bj][0], acc[ai][bj][m][1] * rn * g0[bj][1])); }
        } else {
            const f32x4 g0 = *(const f32x4*)(qrg + 8 * fq), g1 = *(const f32x4*)(qrg + 8 * fq + 4);
            const bool up = fq >= 2;
#pragma unroll
            for (int ai = 0; ai < 2; ++ai)
#pragma unroll
                for (int m = 0; m < 4; ++m) { const int row = row0 + ai * HALF + m * 16;
                    const int pos = row < kRP ? (row & 2047) : 4096 + ((row - kRP) & 31);
                    f32x4 c0, c1, s0, s1; rope_cs4(pos, 8 * (fq & 1), c0, s0); rope_cs4(pos, 8 * (fq & 1) + 4, c1, s1);
#pragma unroll
                    for (int bj = 0; bj < 2; ++bj) { const int head = 2 * wc + bj;
                        f32x4 v0 = acc[ai][bj][m][0], v1 = acc[ai][bj][m][1];
                        float s = sq8(v0, v1); s += sw_xor<16>(s); s = half_sum(s);
                        const float rn = rsqrtf(s * (1.0f / 32.0f) + kEPS); v0 = v0 * rn * g0; v1 = v1 * rn * g1;
                        f32x4 o0, o1;
#pragma unroll
                        for (int i = 0; i < 4; ++i) { const float p0 = half_other(v0[i], up ? 1 : 0), p1 = half_other(v1[i], up ? 1 : 0);
                            o0[i] = (up ? (p0 * s0[i] + v0[i] * c0[i]) : (v0[i] * c0[i] - p0 * s0[i])) * kQSMLA;
                            o1[i] = (up ? (p1 * s1[i] + v1[i] * c1[i]) : (v1[i] * c1[i] - p1 * s1[i])) * kQSMLA; }
                        st16((Q + (size_t)row * 768 + head * 96 + 64 + 8 * fq), pack8f(o0, o1)); } }
        }
    }
};

struct EpiKV {
    static constexpr bool PERM = true, AFTER_DRAIN = false;
    bf16_t* Kmla; bf16_t* V; const float* kng;
    __device__ __forceinline__ void operator()(const f32x4 (&acc)[2][2][4][2], const Unit& u, int wr, int wc, int fr_in, int fq_in) const {
        const int ln_ = hw_lane(); const int fr = ln_ & 15, fq = ln_ >> 4; (void)fr_in; (void)fq_in;
        const int row0 = u.pm * BM + wr * 64 + fr;
        if (u.pn < 2) {
            const int head = 4 * u.pn + wc;
            f32x4 g0[2][2];
#pragma unroll
            for (int bj = 0; bj < 2; ++bj) { g0[bj][0] = *(const f32x4*)(kng + 32 * bj + 8 * fq); g0[bj][1] = *(const f32x4*)(kng + 32 * bj + 8 * fq + 4); }
#pragma unroll
            for (int ai = 0; ai < 2; ++ai)
#pragma unroll
                for (int m = 0; m < 4; ++m) { const int row = row0 + ai * HALF + m * 16;
                    float s = sq8(acc[ai][0][m][0], acc[ai][0][m][1]) + sq8(acc[ai][1][m][0], acc[ai][1][m][1]); s += sw_xor<16>(s); s = half_sum(s);
                    const float rn = rsqrtf(s * (1.0f / 64.0f) + kEPS);
#pragma unroll
                    for (int bj = 0; bj < 2; ++bj) st16((Kmla + (size_t)row * 768 + head * 96 + 32 * bj + 8 * fq), pack8f(acc[ai][bj][m][0] * rn * g0[bj][0], acc[ai][bj][m][1] * rn * g0[bj][1])); }
        } else {
#pragma unroll
            for (int ai = 0; ai < 2; ++ai)
#pragma unroll
                for (int m = 0; m < 4; ++m) { const int row = row0 + ai * HALF + m * 16;
#pragma unroll
                    for (int bj = 0; bj < 2; ++bj) st16((V + (size_t)row * 1024 + u.pn * BM + wc * 64 + 32 * bj + 8 * fq), pack8f(acc[ai][bj][m][0], acc[ai][bj][m][1])); }
        }
    }
};

struct EpiPlain {
    static constexpr bool PERM = true, AFTER_DRAIN = false;
    bf16_t* O; int ldc; const float* ssq;
    __device__ __forceinline__ void operator()(const f32x4 (&acc)[2][2][4][2], const Unit& u, int wr, int wc, int fr_in, int fq_in) const {
        const int ln_ = hw_lane(); const int fr = ln_ & 15, fq = ln_ >> 4; (void)fr_in; (void)fq_in;
        const int row0 = u.pm * BM + wr * 64 + fr, col0 = u.pn * BM + wc * 32 + 8 * fq;
#pragma unroll
        for (int ai = 0; ai < 2; ++ai)
#pragma unroll
            for (int m = 0; m < 4; ++m) {
                const int row = row0 + ai * HALF + m * 16;
                const float rs = ssq ? rsqrtf(__hip_atomic_load(ssq + row, __ATOMIC_RELAXED, __HIP_MEMORY_SCOPE_AGENT) * (1.0f / 1024.0f) + kEPS) : 1.0f;
                bf16_t* op = O + (size_t)row * ldc + col0;
#pragma unroll
                for (int bj = 0; bj < 2; ++bj) {
                    const f32x4 v0 = acc[ai][bj][m][0] * rs, v1 = acc[ai][bj][m][1] * rs;
                    u32x4 w; w.x = cvt_pk_bf16(v0[0], v0[1]); w.y = cvt_pk_bf16(v0[2], v0[3]); w.z = cvt_pk_bf16(v1[0], v1[1]); w.w = cvt_pk_bf16(v1[2], v1[3]);
                    st16((op + bj * HALF), w);
                }
            }
    }
};

template <int J> struct EpiBranch {
    static constexpr bool PERM = true, AFTER_DRAIN = false;
    const bf16_t* Z; bf16_t* P; bf16_t* Mb;
    __device__ __forceinline__ void operator()(const f32x4 (&acc)[2][2][4][2], const Unit& u, int wr, int wc, int fr_in, int fq_in) const {
        const int ln_ = hw_lane(); const int fr = ln_ & 15, fq = ln_ >> 4; (void)fr_in; (void)fq_in;
        const int row0 = u.pm * BM + wr * 64 + fr, col0 = u.pn * BM + wc * 32 + 8 * fq;
        const bf16_t* zg = Z + (size_t)row0 * kZW + ZC_G + J * 1024 + col0; bf16_t* pp0 = P + (size_t)row0 * 1024 + col0; bf16_t* mb0 = Mb + (size_t)row0 * 1024 + col0;
        u32x4 gq[2][4], pq[2][4];
        auto load = [&](int slot, int b) {
            const int ai = b >> 1, mh = b & 1;
#pragma unroll
            for (int k = 0; k < 4; ++k) { const int m = 2 * mh + (k >> 1), bj = k & 1; const size_t ro = (size_t)(ai * HALF + m * 16);
                gq[slot][k] = *(const u32x4*)(zg + ro * kZW + bj * HALF);
                if (J >= 1) pq[slot][k] = *(const u32x4*)(pp0 + ro * 1024 + bj * HALF); }
        };
        load(0, 0);
#pragma unroll
        for (int b = 0; b < 4; ++b) {
            const int slot = b & 1, ai = b >> 1, mh = b & 1;
            if (b < 3) load(slot ^ 1, b + 1);
#pragma unroll
            for (int k = 0; k < 4; ++k) { const int m = 2 * mh + (k >> 1), bj = k & 1; const size_t ro = (size_t)(ai * HALF + m * 16);
                const u32x4 g = gq[slot][k];
                f32x4 v0 = acc[ai][bj][m][0], v1 = acc[ai][bj][m][1];
                v0[0] *= fast_sigmoid(bf_lo(g.x)); v0[1] *= fast_sigmoid(bf_hi(g.x)); v0[2] *= fast_sigmoid(bf_lo(g.y)); v0[3] *= fast_sigmoid(bf_hi(g.y));
                v1[0] *= fast_sigmoid(bf_lo(g.z)); v1[1] *= fast_sigmoid(bf_hi(g.z)); v1[2] *= fast_sigmoid(bf_lo(g.w)); v1[3] *= fast_sigmoid(bf_hi(g.w));
                if (J >= 1) { const u32x4 q = pq[slot][k];
                    v0[0] += bf_lo(q.x); v0[1] += bf_hi(q.x); v0[2] += bf_lo(q.y); v0[3] += bf_hi(q.y); v1[0] += bf_lo(q.z); v1[1] += bf_hi(q.z); v1[2] += bf_lo(q.w); v1[3] += bf_hi(q.w); }
                *(u32x4*)((J <= 1 ? pp0 : mb0) + ro * 1024 + bj * HALF) = pack8f(v0, v1); }
        }
    }
};


__device__ __forceinline__ float dpp_ror1(float v) { return __builtin_bit_cast(float, __builtin_amdgcn_update_dpp(0, __builtin_bit_cast(int, v), 0x121, 0xf, 0xf, false)); }
__device__ __forceinline__ float dpp_ror2(float v) { return __builtin_bit_cast(float, __builtin_amdgcn_update_dpp(0, __builtin_bit_cast(int, v), 0x122, 0xf, 0xf, false)); }
struct EpiUpConv {
    static constexpr bool PERM = true, AFTER_DRAIN = false;
    bf16_t* ACT; const float* ssq; const float* cw; const float* cb; const float* cpast; float* out; size_t off_p_conv, off_s_conv; PG8_LAS float* hx;
    __device__ __forceinline__ void operator()(const f32x4 (&acc)[2][2][4][2], const Unit& u, int wr, int wc, int fr_in, int fq_in) const {
        const int ln_ = hw_lane(); const int fr = ln_ & 15, fq = ln_ >> 4; (void)fr_in; (void)fq_in;
        const int cj = wc * 32 + 8 * fq;
        const int gc = u.pn * 128 + cj;
        const int tok0 = 254 * u.pm - 2 + wr * 64 + fr;
        f32x4 w0[2], w1[2], w2[2], bb[2];
#pragma unroll
        for (int n = 0; n < 2; ++n) { w0[n] = *(const f32x4*)(cw + gc + 4 * n); w1[n] = *(const f32x4*)(cw + 2816 + gc + 4 * n); w2[n] = *(const f32x4*)(cw + 2 * 2816 + gc + 4 * n); bb[n] = *(const f32x4*)(cb + gc + 4 * n); }
        float rs[2][4];
#pragma unroll
        for (int ai = 0; ai < 2; ++ai)
#pragma unroll
            for (int m = 0; m < 4; ++m) { const int tok = tok0 + ai * HALF + m * 16;
                rs[ai][m] = (tok >= 0 && tok < kR) ? __hip_atomic_load(ssq + tok, __ATOMIC_RELAXED, __HIP_MEMORY_SCOPE_AGENT) : -1.0f; }
#pragma unroll
        for (int ai = 0; ai < 2; ++ai)
#pragma unroll
            for (int m = 0; m < 4; ++m) rs[ai][m] = rs[ai][m] >= 0.f ? rsqrtf(rs[ai][m] * (1.0f / 1024.0f) + kEPS) : 0.f;
        if (fr >= 14) {
#pragma unroll
            for (int ai = 0; ai < 2; ++ai)
#pragma unroll
                for (int n = 0; n < 2; ++n) *(PG8_LAS f32x4*)(hx + (((2 * ai + wr) * 2 + (fr - 14)) * 128 + cj + 4 * n)) = acc[ai][0][3][n] * rs[ai][3];
        }
        epi_bar();
#pragma unroll
        for (int ai = 0; ai < 2; ++ai) {
            const int slab = 2 * ai + wr;
            f32x4 H1[2], H2[2];
#pragma unroll
            for (int n = 0; n < 2; ++n) { H1[n] = (f32x4){0.f, 0.f, 0.f, 0.f}; H2[n] = H1[n];
                if (slab > 0 && fr < 2) { H1[n] = *(const PG8_LAS f32x4*)(hx + (((slab - 1) * 2 + 1) * 128 + cj + 4 * n)); H2[n] = *(const PG8_LAS f32x4*)(hx + (((slab - 1) * 2 + 0) * 128 + cj + 4 * n)); } }
            f32x4 pr1[2], pr2[2];
#pragma unroll
            for (int m = 0; m < 4; ++m) {
                const int tok = tok0 + ai * HALF + m * 16;
                const bool owned = !(ai == 0 && wr == 0 && m == 0 && fr < 2) && tok < kR;
                const bool prompt = tok < kRP; const int t = prompt ? (tok & 2047) : ((tok - kRP) & 31); const int b = prompt ? (tok >> 11) : ((tok - kRP) >> 5); const int S = prompt ? 2048 : 32;
                unsigned pk[4];
#pragma unroll
                for (int n = 0; n < 2; ++n) {
                    const f32x4 cur = acc[ai][0][m][n] * rs[ai][m];
                    f32x4 r1, r2;
#pragma unroll
                    for (int i = 0; i < 4; ++i) { r1[i] = dpp_ror1(cur[i]); r2[i] = dpp_ror2(cur[i]); }
                    f32x4 p1, p2;
                    if (m == 0) {
#pragma unroll
                        for (int i = 0; i < 4; ++i) { p1[i] = fr == 0 ? H1[n][i] : r1[i]; p2[i] = fr == 0 ? H2[n][i] : (fr == 1 ? H1[n][i] : r2[i]); }
                    } else {
#pragma unroll
                        for (int i = 0; i < 4; ++i) { p1[i] = fr == 0 ? pr1[n][i] : r1[i]; p2[i] = fr < 2 ? pr2[n][i] : r2[i]; }
                    }
                    pr1[n] = r1; pr2[n] = r2;
                    if (owned && t < 2) {
                        const f32x4 z4 = {0.f, 0.f, 0.f, 0.f};
                        const f32x4 q1 = prompt ? z4 : *(const f32x4*)(cpast + ((size_t)b * 2 + 1) * 2816 + gc + 4 * n);
                        const f32x4 q0 = prompt ? z4 : *(const f32x4*)(cpast + ((size_t)b * 2 + 0) * 2816 + gc + 4 * n);
                        if (t == 0) { p1 = q1; p2 = q0; } else p2 = q1;
                    }
                    const f32x4 uu = acc[ai][1][m][n] * rs[ai][m];
                    f32x4 o;
#pragma unroll
                    for (int i = 0; i < 4; ++i) { const float cv = p2[i] * w0[n][i] + p1[i] * w1[n][i] + cur[i] * w2[n][i] + bb[n][i];
                        o[i] = cv * __builtin_amdgcn_rcpf(1.0f + __expf(-cv)) * uu[i]; }
                    pk[2 * n] = cvt_pk_bf16(o[0], o[1]); pk[2 * n + 1] = cvt_pk_bf16(o[2], o[3]);
                    if (owned && t >= S - 2) { float* od = out + (prompt ? off_p_conv + (size_t)b * 2 * 2816 : off_s_conv + (size_t)b * 2 * 2816) + (size_t)(t - (S - 2)) * 2816 + gc + 4 * n; *(f32x4*)od = cur; }
                }
                if (owned) *(u32x4*)(ACT + (size_t)tok * 2816 + gc) = (u32x4){pk[0], pk[1], pk[2], pk[3]};
            }
        }
        epi_bar();
    }
};

struct EpiBranchAll {
    static constexpr bool PERM = true, AFTER_DRAIN = false;
    const bf16_t* Z; bf16_t* P; bf16_t* Mb;
    __device__ __forceinline__ void operator()(const f32x4 (&acc)[2][2][4][2], const Unit& u, int wr, int wc, int fr, int fq) const {
        const int j = u.pn >> 2; Unit t; t.pm = u.pm - 66 * j; t.pn = u.pn - 4 * j;
        if (j == 0) EpiBranch<0>{Z, P, Mb}(acc, t, wr, wc, fr, fq); else if (j == 1) EpiBranch<1>{Z, P, Mb}(acc, t, wr, wc, fr, fq); else EpiBranch<2>{Z, P, Mb}(acc, t, wr, wc, fr, fq);
    }
};

struct EpiRes {
    static constexpr bool PERM = true, AFTER_DRAIN = false;
    const float* Xr; float* X; bf16_t* Xb; float* ssq_next;
    __device__ __forceinline__ void operator()(const f32x4 (&acc)[2][2][4][2], const Unit& u, int wr, int wc, int fr_in, int fq_in) const {
        const int ln_ = hw_lane(); const int fr = ln_ & 15, fq = ln_ >> 4; (void)fr_in; (void)fq_in;
        const int row0 = u.pm * BM + wr * 64 + fr, col0 = u.pn * BM + wc * 32 + 8 * fq;
        const float* xr0 = Xr + (size_t)row0 * 1024 + col0;
        float* x0 = X + (size_t)row0 * 1024 + col0; bf16_t* xb0 = Xb ? Xb + (size_t)row0 * 1024 + col0 : nullptr;
        f32x4 xq[2][4][2];
        auto load = [&](int slot, int b) {
            const int ai = b >> 1, mh = b & 1;
#pragma unroll
            for (int k = 0; k < 4; ++k) { const int m = 2 * mh + (k >> 1), bj = k & 1; const float* xp = xr0 + (size_t)(ai * HALF + m * 16) * 1024 + bj * HALF;
                xq[slot][k][0] = *(const f32x4*)xp; xq[slot][k][1] = *(const f32x4*)(xp + 4); }
        };
        load(0, 0);
#pragma unroll
        for (int b = 0; b < 4; ++b) {
            const int slot = b & 1, ai = b >> 1, mh = b & 1;
            if (b < 3) load(slot ^ 1, b + 1);
#pragma unroll
            for (int mm = 0; mm < 2; ++mm) { const int m = 2 * mh + mm; const size_t ro = (size_t)(ai * HALF + m * 16);
                float s = 0.f;
#pragma unroll
                for (int bj = 0; bj < 2; ++bj) { const int k = 2 * mm + bj;
                    const f32x4 v0 = acc[ai][bj][m][0] + xq[slot][k][0], v1 = acc[ai][bj][m][1] + xq[slot][k][1];
                    float* xp = x0 + ro * 1024 + bj * HALF; st16(xp, v0); st16((xp + 4), v1);
                    s += sq8(v0, v1);
                    if (Xb) st16((xb0 + ro * 1024 + bj * HALF), pack8f(v0, v1)); }
                if (ssq_next) { s += sw_xor<16>(s); s = half_sum(s);
                    if (fq == 0) __hip_atomic_fetch_add(ssq_next + row0 + ai * HALF + m * 16, s, __ATOMIC_RELAXED, __HIP_MEMORY_SCOPE_AGENT); } }
        }
    }
};

template <class Epi, class Sched, bool ALIGN_EPI = false, bool SP2 = false>
__device__ __forceinline__ void gemm_phase(PG8_LAS unsigned char* lds, const Gemm g, const Sched& S, const Epi& E, int tid_in  ) {
    int tid_ = tid_in; asm volatile("" : "+v"(tid_));
    const int tid = tid_, wid = __builtin_amdgcn_readfirstlane(tid >> 6), lane = tid & 63, wr = wid >> 2, wc = wid & 3, fr = lane & 15, fq = lane >> 4;
    const int K = g.K, nt = K / BK;
    unsigned voffA[2], voffB[2];
#pragma unroll
    for (int i = 0; i < 2; ++i) { int R, C; stage_rc(tid * 16 + i * 8192, R, C); const int Rb = Epi::PERM ? ((R & ~31) + perm32(R & 31)) : R;
        voffA[i] = (unsigned)(R * g.lda + C) * 2u; voffB[i] = (unsigned)(Rb * K + C) * 2u; }
    const size_t kstep = (size_t)(BK * 2);
    const size_t hstep = (size_t)HALF * K * 2;
    const size_t tstep = 2 * hstep; const size_t hstepA = (size_t)HALF * g.lda * 2, tstepA = (size_t)g.prows * g.lda * 2;
    const unsigned ldsw = (unsigned)wid * 1024u;
    const int aoff = lds_byte(wr * 64 + fr, fq * 8), boff = lds_byte(wc * 32 + fr, fq * 8);
#define PG8_SA(b, h) (((b) * 2 + (h)) * HTB)
#define PG8_SB(b, h) ((4 + (b) * 2 + (h)) * HTB)
#define PG8_STAGE(bufoff, gbase, voff) do { _Pragma("unroll") for (int _i = 0; _i < 2; ++_i) \
        __builtin_amdgcn_global_load_lds((const unsigned*)((const char*)(gbase) + (voff)[_i]), (PG8_LAS unsigned*)(lds + (bufoff) + ldsw + _i * 8192), 16, 0, 0); } while (0)
#define PG8_LDA(dst, b, h) do { _Pragma("unroll") for (int m = 0; m < 4; ++m) _Pragma("unroll") for (int k = 0; k < 2; ++k) dst[m][k] = *(const PG8_LAS bf16x8*)(lds + PG8_SA(b, h) + aoff + m * 2048 + k * 1024); } while (0)
#define PG8_LDB(dst, b, h) do { _Pragma("unroll") for (int n = 0; n < 2; ++n) _Pragma("unroll") for (int k = 0; k < 2; ++k) dst[n][k] = *(const PG8_LAS bf16x8*)(lds + PG8_SB(b, h) + boff + n * 2048 + k * 1024); } while (0)
#define PG8_MMA(ai, bj, At, Bt) do { __builtin_amdgcn_s_setprio(1); _Pragma("unroll") for (int m = 0; m < 4; ++m) _Pragma("unroll") for (int n = 0; n < 2; ++n) _Pragma("unroll") for (int k = 0; k < 2; ++k) \
        acc[ai][bj][m][n] = __builtin_amdgcn_mfma_f32_16x16x32_bf16(Bt[n][k], At[m][k], acc[ai][bj][m][n], 0, 0, 0); __builtin_amdgcn_s_setprio(0); } while (0)
#define PG8_WAIT_V(n) asm volatile("s_waitcnt vmcnt(" #n ")" ::: "memory")
#define PG8_WAIT_L(n) asm volatile("s_waitcnt lgkmcnt(" #n ")" ::: "memory")
#define PG8_BAR __builtin_amdgcn_s_barrier()
#define PG8_SCHED __builtin_amdgcn_sched_barrier(0)
    Unit cur, nxt; int ui = 0;
    if (!S.next(0, cur)) return;
    f32x4 acc[2][2][4][2];
#pragma unroll
    for (int a = 0; a < 2; ++a)
#pragma unroll
        for (int b = 0; b < 2; ++b)
#pragma unroll
            for (int m = 0; m < 4; ++m)
#pragma unroll
                for (int n = 0; n < 2; ++n) acc[a][b][m][n] = (f32x4){0.f, 0.f, 0.f, 0.f};
    bf16x8 At[4][2], B0[2][2], B1[2][2];
    const char* cA = (const char*)g.A + (size_t)cur.pm * tstepA; const char* cB = (const char*)g.Bt + (size_t)cur.pn * tstep;
    S.a_ready(cur);
    if constexpr (SP2) {
        PG8_STAGE(PG8_SB(0, 0), cB, voffB); PG8_STAGE(PG8_SB(0, 1), cB + hstep, voffB); PG8_STAGE(PG8_SA(0, 0), cA, voffA); PG8_STAGE(PG8_SA(0, 1), cA + hstepA, voffA);
        if (wr == 1) PG8_BAR;
        PG8_WAIT_V(2); PG8_BAR;
        PG8_STAGE(PG8_SB(1, 0), cB + kstep, voffB); PG8_STAGE(PG8_SA(1, 0), cA + kstep, voffA); PG8_STAGE(PG8_SB(1, 1), cB + hstep + kstep, voffB);
        PG8_WAIT_V(6); PG8_BAR;
    } else {
        PG8_STAGE(PG8_SB(0, 0), cB, voffB); PG8_STAGE(PG8_SA(0, 0), cA, voffA); PG8_STAGE(PG8_SB(0, 1), cB + hstep, voffB); PG8_STAGE(PG8_SA(0, 1), cA + hstepA, voffA);
        if (wr == 1) PG8_BAR;
        PG8_WAIT_V(4); PG8_BAR;
        PG8_STAGE(PG8_SB(1, 0), cB + kstep, voffB); PG8_STAGE(PG8_SA(1, 0), cA + kstep, voffA); PG8_STAGE(PG8_SB(1, 1), cB + hstep + kstep, voffB);
        PG8_WAIT_V(6); PG8_BAR;
    }
    for (;;) {
        const bool has_next = S.next(ui + 1, nxt);
        const char* nA = has_next ? (const char*)g.A + (size_t)nxt.pm * tstepA : cA; const char* nB = has_next ? (const char*)g.Bt + (size_t)nxt.pn * tstep : cB;
        for (int t = 0; t < nt; t += 2) {
            const bool last = (t == nt - 2);
            const char* a1 = cA + (size_t)(t + 1) * kstep;
            const char* a2 = last ? nA : cA + (size_t)(t + 2) * kstep; const char* b2 = last ? nB : cB + (size_t)(t + 2) * kstep;
            const char* a3 = a2 + kstep; const char* b3 = b2 + kstep;
            if (last && has_next) S.a_ready(nxt);
            if constexpr (SP2) {
            PG8_LDB(B0, 0, 0); PG8_LDB(B1, 0, 1); PG8_SCHED; PG8_LDA(At, 0, 0); PG8_STAGE(PG8_SA(1, 1), a1 + hstepA, voffA);
            PG8_WAIT_V(8); PG8_WAIT_L(0); PG8_BAR; PG8_MMA(0, 0, At, B0); PG8_MMA(0, 1, At, B1); PG8_BAR; PG8_SCHED;
            PG8_LDA(At, 0, 1); PG8_STAGE(PG8_SB(0, 0), b2, voffB); PG8_STAGE(PG8_SB(0, 1), b2 + hstep, voffB); PG8_STAGE(PG8_SA(0, 0), a2, voffA);
            PG8_WAIT_V(8); PG8_WAIT_L(0); PG8_BAR; PG8_MMA(1, 0, At, B0); PG8_MMA(1, 1, At, B1); PG8_BAR; PG8_SCHED;
            PG8_LDB(B0, 1, 0); PG8_LDB(B1, 1, 1); PG8_SCHED; PG8_LDA(At, 1, 0); PG8_STAGE(PG8_SA(0, 1), a2 + hstepA, voffA);
            PG8_WAIT_V(8); PG8_WAIT_L(0); PG8_BAR; PG8_MMA(0, 0, At, B0); PG8_MMA(0, 1, At, B1); PG8_BAR; PG8_SCHED;
            PG8_LDA(At, 1, 1); PG8_STAGE(PG8_SB(1, 0), b3, voffB); PG8_STAGE(PG8_SB(1, 1), b3 + hstep, voffB); PG8_STAGE(PG8_SA(1, 0), a3, voffA);
            PG8_WAIT_V(8); PG8_WAIT_L(0); PG8_BAR; PG8_MMA(1, 0, At, B0); PG8_MMA(1, 1, At, B1); PG8_BAR; PG8_SCHED;
            } else {
            PG8_LDB(B0, 0, 0); PG8_SCHED; PG8_LDA(At, 0, 0); PG8_STAGE(PG8_SA(1, 1), a1 + hstepA, voffA);
            PG8_WAIT_L(8); PG8_BAR; PG8_WAIT_L(0); PG8_MMA(0, 0, At, B0); PG8_BAR; PG8_SCHED;
            PG8_LDB(B1, 0, 1); PG8_STAGE(PG8_SB(0, 0), b2, voffB);
            PG8_BAR; PG8_WAIT_L(0); PG8_MMA(0, 1, At, B1); PG8_BAR;
            PG8_LDA(At, 0, 1); PG8_STAGE(PG8_SA(0, 0), a2, voffA);
            PG8_BAR; PG8_WAIT_L(0); PG8_MMA(1, 0, At, B0); PG8_BAR; PG8_SCHED;
            PG8_STAGE(PG8_SB(0, 1), b2 + hstep, voffB);
            PG8_WAIT_V(6); PG8_BAR; PG8_MMA(1, 1, At, B1); PG8_BAR;
            PG8_LDB(B0, 1, 0); PG8_SCHED; PG8_LDA(At, 1, 0); PG8_STAGE(PG8_SA(0, 1), a2 + hstepA, voffA);
            PG8_WAIT_L(8); PG8_BAR; PG8_WAIT_L(0); PG8_MMA(0, 0, At, B0); PG8_BAR; PG8_SCHED;
            PG8_LDB(B1, 1, 1); PG8_STAGE(PG8_SB(1, 0), b3, voffB);
            PG8_BAR; PG8_WAIT_L(0); PG8_MMA(0, 1, At, B1); PG8_BAR;
            PG8_LDA(At, 1, 1); PG8_STAGE(PG8_SA(1, 0), a3, voffA);
            PG8_BAR; PG8_WAIT_L(0); PG8_MMA(1, 0, At, B0); PG8_BAR; PG8_SCHED;
            PG8_STAGE(PG8_SB(1, 1), b3 + hstep, voffB);
            PG8_WAIT_V(6); PG8_BAR; PG8_MMA(1, 1, At, B1); PG8_BAR;
            }
        }
        if constexpr (ALIGN_EPI) { if (wr == 0) PG8_BAR; }
        if constexpr (!Epi::AFTER_DRAIN) { E(acc, cur, wr, wc, fr, fq); S.done(cur); }
        if (!has_next) break;
#pragma unroll
        for (int a = 0; a < 2; ++a)
#pragma unroll
            for (int b = 0; b < 2; ++b)
#pragma unroll
                for (int m = 0; m < 4; ++m)
#pragma unroll
                    for (int n = 0; n < 2; ++n) acc[a][b][m][n] = (f32x4){0.f, 0.f, 0.f, 0.f};
        cur = nxt; cA = nA; cB = nB; ++ui;
        if constexpr (ALIGN_EPI) { if (wr == 1) PG8_BAR; }
    }
    PG8_WAIT_V(0);
    if constexpr (!ALIGN_EPI) { if (wr == 0) PG8_BAR; }
    PG8_BAR;
    if constexpr (Epi::AFTER_DRAIN) { E.fused(acc, cur, wr, wc, fr, fq, lds, wid, lane); S.done(cur); }
#undef PG8_SA
#undef PG8_SB
#undef PG8_STAGE
#undef PG8_LDA
#undef PG8_LDB
#undef PG8_MMA
#undef PG8_WAIT_V
#undef PG8_WAIT_L
#undef PG8_BAR
#undef PG8_SCHED
}
}
using pg8::kR; using pg8::kRP; using pg8::kRS; using pg8::kZW; using pg8::kEPS;
using pg8::ZC_CQ; using pg8::ZC_CKV; using pg8::ZC_KR; using pg8::ZC_SQ; using pg8::ZC_SK; using pg8::ZC_SV; using pg8::ZC_DQ; using pg8::ZC_DK; using pg8::ZC_DV; using pg8::ZC_G;
constexpr int NWAVES = 8;
constexpr int NIN0 = 6560, DFF = 2816, PASTL = 4096, NCACHE = 16 * 4096;
constexpr float LOG2E = 1.4426950408889634f;
constexpr float QS_MLA = 0.10206207261596577f * LOG2E;
constexpr float QS_64 = 0.125f * LOG2E;

constexpr size_t OUT_YP = 0;
constexpr size_t OUT_YS = OUT_YP + (size_t)kRP * 1024;
constexpr size_t OUT_PCKV = OUT_YS + (size_t)kRS * 1024;
constexpr size_t OUT_PKR = OUT_PCKV + (size_t)2 * kRP * 128;
constexpr size_t OUT_PSBK = OUT_PKR + (size_t)2 * kRP * 32;
constexpr size_t OUT_PSBV = OUT_PSBK + (size_t)2 * kRP * 512;
constexpr size_t OUT_PDK = OUT_PSBV + (size_t)2 * kRP * 512;
constexpr size_t OUT_PDV = OUT_PDK + (size_t)2 * kRP * 512;
constexpr size_t OUT_PCONV = OUT_PDV + (size_t)2 * kRP * 512;
constexpr size_t OUT_SCKV = OUT_PCONV + (size_t)2 * 8 * 2 * DFF;
constexpr size_t OUT_SKR = OUT_SCKV + (size_t)2 * kRS * 128;
constexpr size_t OUT_SSBK = OUT_SKR + (size_t)2 * kRS * 32;
constexpr size_t OUT_SSBV = OUT_SSBK + (size_t)2 * kRS * 512;
constexpr size_t OUT_SDK = OUT_SSBV + (size_t)2 * kRS * 512;
constexpr size_t OUT_SDV = OUT_SDK + (size_t)2 * kRS * 512;
constexpr size_t OUT_SCONV = OUT_SDV + (size_t)2 * kRS * 512;

enum { IN_XP = 0, IN_XS, IN_CCKV, IN_CKR, IN_CSBK, IN_CSBV, IN_CDK, IN_CDV, IN_CONV, IN_MIXG, IN_WIN, IN_QNG, IN_WUQ, IN_KVNG, IN_WUK, IN_WUV, IN_QN_G, IN_KN_G, IN_QR_G, IN_KR_G,
       IN_DQN_G, IN_DKN_G, IN_LAMBDA, IN_SUBLN_G, IN_WBR_MLA, IN_WBR_SB, IN_WBR_DIFF, IN_WOUT, IN_FFNG, IN_WUP, IN_CONVW, IN_CONVB, IN_WDOWN, N_INPUTS };

constexpr size_t MiB = 1u << 20;
constexpr size_t WS_CTL = 0, CTL_ZERO_BYTES = 2 * MiB;
constexpr int CW_BAR = 1024;
constexpr int CW_WQ = 8192;
constexpr int CW_SSQ = 16384;
static_assert((CW_SSQ + 4 * kR) * 4 <= (int)CTL_ZERO_BYTES, "ctl region");
constexpr size_t WL_IN = 0, WL_UQ = WL_IN + (size_t)kZW * 1024 * 2, WL_UKV = WL_UQ + (size_t)768 * 256 * 2, WL_BR = WL_UKV + (size_t)1024 * 128 * 2,
                 WL_OUT = WL_BR + (size_t)3 * 1024 * 512 * 2, WL_UP = WL_OUT + (size_t)1024 * 1024 * 2, WL_DOWN = WL_UP + (size_t)5632 * 1024 * 2, WL_SIZE = WL_DOWN + (size_t)1024 * 2816 * 2;
constexpr size_t WS_W = 2 * MiB;
constexpr size_t WS_XB = WS_W + 2 * WL_SIZE;
#ifndef WS_TRANS_BASE
#define WS_TRANS_BASE (WS_XB + (size_t)kR * 1024 * 2)
#endif
constexpr size_t WS_Z = WS_TRANS_BASE;
constexpr size_t WS_Q = WS_Z + (size_t)kR * kZW * 2;
constexpr size_t WS_KNMV = WS_Q + (size_t)kR * 768 * 2;
constexpr size_t WS_KMLA = WS_KNMV + (size_t)kR * 1024 * 2;
constexpr size_t WS_CKVB = WS_KMLA + (size_t)kR * 768 * 2;
constexpr size_t WS_KNMVC = WS_CKVB + (size_t)2 * NCACHE * 128 * 2;
constexpr size_t WS_KMLAC = WS_KNMVC + (size_t)NCACHE * 1024 * 2;
constexpr size_t WS_ROPE = WS_KMLAC + (size_t)2 * NCACHE * 768 * 2;
constexpr size_t WS_O = WS_ROPE + (size_t)2080 * 32 * 4;
constexpr size_t WS_MP = WS_O + (size_t)3 * kR * 512 * 2;
constexpr size_t WS_MB = WS_MP + (size_t)kR * 1024 * 4;
constexpr size_t WS_ACT = WS_MB + (size_t)kR * 1024 * 2;
constexpr size_t WS_FAST_END = WS_ACT + (size_t)kR * DFF * 2;
constexpr size_t WS_AU = WS_Z;

constexpr int RING_BYTES = 131072;
constexpr int MISC_OFF = RING_BYTES + 8192;
constexpr int LDS_BYTES = 147456;

#define GAS __attribute__((address_space(1)))
#define LAS __attribute__((address_space(3)))
typedef unsigned short bf16;
typedef unsigned v4u __attribute__((ext_vector_type(4)));
typedef unsigned v2u __attribute__((ext_vector_type(2)));
typedef float f32x4 __attribute__((ext_vector_type(4)));
typedef float f32x2 __attribute__((ext_vector_type(2)));
__device__ __forceinline__ unsigned f2bf(float f) { unsigned u = __builtin_bit_cast(unsigned, f); return (u + 0x7fffu + ((u >> 16) & 1u)) >> 16; }
__device__ __forceinline__ unsigned pk2(float lo, float hi) { return f2bf(lo) | (f2bf(hi) << 16); }
__device__ __forceinline__ float bflo(unsigned w) { return __uint_as_float(w << 16); }
__device__ __forceinline__ float bfhi(unsigned w) { return __uint_as_float(w & 0xffff0000u); }
__device__ __forceinline__ float bf1(bf16 h) { return __uint_as_float((unsigned)h << 16); }
__device__ __forceinline__ float wave_sum(float v) {
    v += sw_xor<1>(v); v += sw_xor<2>(v); v += sw_xor<4>(v); v += sw_xor<8>(v); v += sw_xor<16>(v);
    return half_sum(v);
}
#define LDS_WAIT() asm volatile("s_waitcnt lgkmcnt(0)" ::: "memory")

struct Args { const float* in[N_INPUTS]; float* out; unsigned char* ws; int layer; int pad; };
typedef const Args __attribute__((address_space(4)))* CArgsP;

__device__ __forceinline__ int row_pos(int row) { return row < kRP ? (row & 2047) : PASTL + ((row - kRP) & 31); }
__device__ __forceinline__ float rope_inv16(int i) { return exp2f(-(float)i * (13.287712379549449f / 16.0f)); }

__device__ __forceinline__ void transpose_item(const float* W, int ldw, int k0, int scol, bf16* WT, int K, int n0, const float* gk, LAS float* scr, int lane) {
    float tv[32];
#pragma unroll
    for (int i = 0; i < 32; ++i) { const int kk = 2 * i + (lane >> 5); tv[i] = scol >= 0 ? __builtin_nontemporal_load(W + (size_t)(k0 + kk) * ldw + scol + (lane & 31)) : 0.f; }
    if (gk) {
#pragma unroll
        for (int i = 0; i < 32; ++i) tv[i] *= gk[k0 + 2 * i + (lane >> 5)]; }
#pragma unroll
    for (int i = 0; i < 32; ++i) scr[(2 * i + (lane >> 5)) * 33 + (lane & 31)] = tv[i];
    LDS_WAIT(); asm volatile("" ::: "memory");
    const int c = lane & 7;
#pragma unroll
    for (int j = 0; j < 4; ++j) { const int n = (lane >> 3) + 8 * j; const LAS float* s = scr + (8 * c) * 33 + n;
        v4u o; o.x = pk2(s[0 * 33], s[1 * 33]); o.y = pk2(s[2 * 33], s[3 * 33]); o.z = pk2(s[4 * 33], s[5 * 33]); o.w = pk2(s[6 * 33], s[7 * 33]);
        *(v4u*)(WT + (size_t)(n0 + n) * K + k0 + 8 * c) = o; }
    LDS_WAIT(); asm volatile("" ::: "memory");
}
struct TMat { const float* W; int ldw; int K; int Ndst; bf16* WT; const float* gk; int kind; int perm; };
__device__ __forceinline__ int tmat_items(const TMat& m) { return (m.K / 64) * (m.Ndst / 32); }
__device__ __forceinline__ void tmat_do(const TMat& m, int item, LAS float* scr, int lane) {
    const int ng = m.Ndst / 32, kb = item / ng, g = item % ng;
    int L = g * 32;
    if (m.perm) { const int tile = g >> 3, g32 = g & 7; L = tile * 256 + 64 * (g32 & 3) + 32 * (g32 >> 2); }
    int scol = L;
    if (m.kind == 1) scol = L < 416 ? L : (L < 512 ? -1 : L - 96);
    if (m.kind == 2) scol = L < 512 ? (L >> 6) * 96 + (L & 63) : ((L - 512) >> 5) * 96 + 64;
    if (m.kind == 3) { const int tile = g >> 3, g32 = g & 7; scol = g32 < 4 ? 128 * tile + 32 * g32 : 2816 + 128 * tile + 32 * (g32 - 4); }
    transpose_item(m.W, m.ldw, kb * 64, scol, m.WT, m.K, g * 32, m.gk, scr, lane);
}

namespace p0w {
constexpr int NI0 = (1024 / 64) * (kZW / 32), NI1 = (256 / 64) * (768 / 32), NI2 = (128 / 64) * (512 / 32), NI4 = (512 / 64) * (1024 / 32), NI7 = (1024 / 64) * (1024 / 32),
              NI8 = (1024 / 64) * (5632 / 32), NI9 = (DFF / 64) * (1024 / 32);
constexpr int C1 = NI0, C2 = C1 + NI1, C3 = C2 + NI2, C4 = C3 + NI2, C5 = C4 + NI4, C6 = C5 + NI4, C7 = C6 + NI4, C8 = C7 + NI7, C9 = C8 + NI8, CL = C9 + NI9;
constexpr int CHUNK = 64, NCHUNK = (CL + CHUNK - 1) / CHUNK;
}
__device__ __forceinline__ void p0_weight_item(CArgsP a, int it  , LAS float* scr, int lane) {
    using namespace p0w;
    unsigned char* ws = a->ws;
    const int l = it >= CL ? 1 : 0, r = it - l * CL;
    bf16* wl = (bf16*)(ws + WS_W + (size_t)l * WL_SIZE);
    if (r < C1)      tmat_do(TMat{a->in[IN_WIN] + (size_t)l * 1024 * NIN0, NIN0, 1024, kZW, (bf16*)((unsigned char*)wl + WL_IN), a->in[IN_MIXG] + l * 1024, 1, 1}, r, scr, lane);
    else if (r < C2) tmat_do(TMat{a->in[IN_WUQ] + (size_t)l * 256 * 768, 768, 256, 768, (bf16*)((unsigned char*)wl + WL_UQ), nullptr, 2, 1}, r - C1, scr, lane);
    else if (r < C3) tmat_do(TMat{a->in[IN_WUK] + (size_t)l * 128 * 512, 512, 128, 512, (bf16*)((unsigned char*)wl + WL_UKV), nullptr, 0, 1}, r - C2, scr, lane);
    else if (r < C4) tmat_do(TMat{a->in[IN_WUV] + (size_t)l * 128 * 512, 512, 128, 512, (bf16*)((unsigned char*)wl + WL_UKV) + (size_t)512 * 128, nullptr, 0, 1}, r - C3, scr, lane);
    else if (r < C5) tmat_do(TMat{a->in[IN_WBR_MLA] + (size_t)l * 512 * 1024, 1024, 512, 1024, (bf16*)((unsigned char*)wl + WL_BR), nullptr, 0, 0}, r - C4, scr, lane);
    else if (r < C6) tmat_do(TMat{a->in[IN_WBR_SB] + (size_t)l * 512 * 1024, 1024, 512, 1024, (bf16*)((unsigned char*)wl + WL_BR) + (size_t)1024 * 512, nullptr, 0, 0}, r - C5, scr, lane);
    else if (r < C7) tmat_do(TMat{a->in[IN_WBR_DIFF] + (size_t)l * 512 * 1024, 1024, 512, 1024, (bf16*)((unsigned char*)wl + WL_BR) + (size_t)2 * 1024 * 512, nullptr, 0, 0}, r - C6, scr, lane);
    else if (r < C8) tmat_do(TMat{a->in[IN_WOUT] + (size_t)l * 1024 * 1024, 1024, 1024, 1024, (bf16*)((unsigned char*)wl + WL_OUT), nullptr, 0, 0}, r - C7, scr, lane);
    else if (r < C9) tmat_do(TMat{a->in[IN_WUP] + (size_t)l * 1024 * 5632, 5632, 1024, 5632, (bf16*)((unsigned char*)wl + WL_UP), a->in[IN_FFNG] + l * 1024, 3, 0}, r - C8, scr, lane);
    else             tmat_do(TMat{a->in[IN_WDOWN] + (size_t)l * DFF * 1024, 1024, DFF, 1024, (bf16*)((unsigned char*)wl + WL_DOWN), nullptr, 0, 0}, r - C9, scr, lane);
}
__device__ __forceinline__ void p0_phase(CArgsP a, LAS unsigned char* lds, int gw, int NGW, int wave, int lane) {
    LAS float* scr = (LAS float*)(lds + wave * 16384);
    unsigned char* ws = a->ws;
    for (int it = gw; it < p0w::CL; it += NGW) p0_weight_item(a, it, scr, lane);
    float* ssq0 = (float*)(ws + WS_CTL) + CW_SSQ;
    bf16* xb = (bf16*)(ws + WS_XB);
    for (int row0 = gw; row0 < kR; row0 += 2 * NGW) {
        f32x4 v[2][4]; int rows[2]; bool ok[2];
#pragma unroll
        for (int k = 0; k < 2; ++k) { const int row = row0 + k * NGW; ok[k] = row < kR; rows[k] = ok[k] ? row : row0;
            const float* src = rows[k] < kRP ? a->in[IN_XP] + (size_t)rows[k] * 1024 : a->in[IN_XS] + (size_t)(rows[k] - kRP) * 1024;
#pragma unroll
            for (int j = 0; j < 4; ++j) v[k][j] = *((const f32x4*)src + lane + 64 * j); }
#pragma unroll
        for (int k = 0; k < 2; ++k) { if (!ok[k]) continue;
            float s = 0.f;
#pragma unroll
            for (int j = 0; j < 4; ++j) { const f32x4 x = v[k][j];
                s += (x.x * x.x + x.y * x.y) + (x.z * x.z + x.w * x.w);
                v2u w; w.x = pk2(x.x, x.y); w.y = pk2(x.z, x.w); *((v2u*)(xb + (size_t)rows[k] * 1024) + lane + 64 * j) = w; }
            s = wave_sum(s); if (lane == 0) ssq0[rows[k]] = s; }
    }
    { const float* src = a->in[IN_CKR]; bf16* dst = (bf16*)(ws + WS_KMLAC); const size_t n4 = (size_t)2 * NCACHE * 4;
      const size_t st = (size_t)NGW * 64;
      for (size_t i0 = (size_t)gw * 64 + lane; i0 < n4; i0 += 4 * st) { f32x4 v0[4], v1[4];
#pragma unroll
          for (int k = 0; k < 4; ++k) { const size_t i = i0 + k * st < n4 ? i0 + k * st : i0; const size_t row = i >> 2; const int c8 = (int)(i & 3) * 8;
              v0[k] = __builtin_nontemporal_load((const f32x4*)(src + row * 32 + c8)); v1[k] = __builtin_nontemporal_load((const f32x4*)(src + row * 32 + c8 + 4)); }
#pragma unroll
          for (int k = 0; k < 4; ++k) { const size_t i = i0 + k * st; if (i >= n4) continue; const size_t row = i >> 2; const int c8 = (int)(i & 3) * 8;
              v4u w; w.x = pk2(v0[k].x, v0[k].y); w.y = pk2(v0[k].z, v0[k].w); w.z = pk2(v1[k].x, v1[k].y); w.w = pk2(v1[k].z, v1[k].w);
#pragma unroll
              for (int h = 0; h < 8; ++h) *(v4u*)(dst + row * 768 + h * 96 + 64 + c8) = w; } } }
    { constexpr size_t n8 = (size_t)2 * NCACHE * 128 / 8; const float* src = a->in[IN_CCKV]; bf16* dst = (bf16*)(ws + WS_CKVB); const size_t st = (size_t)NGW * 64;
      for (size_t i0 = (size_t)gw * 64 + lane; i0 < n8; i0 += 4 * st) { f32x4 v0[4], v1[4];
#pragma unroll
          for (int k = 0; k < 4; ++k) { const size_t i = i0 + k * st < n8 ? i0 + k * st : i0; v0[k] = __builtin_nontemporal_load((const f32x4*)src + 2 * i); v1[k] = __builtin_nontemporal_load((const f32x4*)src + 2 * i + 1); }
#pragma unroll
          for (int k = 0; k < 4; ++k) { const size_t i = i0 + k * st; if (i < n8) { v4u w; w.x = pk2(v0[k].x, v0[k].y); w.y = pk2(v0[k].z, v0[k].w); w.z = pk2(v1[k].x, v1[k].y); w.w = pk2(v1[k].z, v1[k].w); *((v4u*)dst + i) = w; } } } }
}

__device__ __forceinline__ void post_in_phase(CArgsP a, int l, int gw, int NGW, int lane) {
    bf16* Z = (bf16*)(a->ws + WS_Z);
    const float* qng = a->in[IN_QNG] + l * 256; const float* kvng = a->in[IN_KVNG] + l * 128; const float* krg = a->in[IN_KR_G] + l * 32;
    const float* dqg = a->in[IN_DQN_G] + l * 64; const float* dkg = a->in[IN_DKN_G] + l * 64;
    for (int row = gw; row < kR; row += NGW) {
        bf16* z = Z + (size_t)row * kZW;
        const bool prompt = row < kRP; const size_t crow = prompt ? (size_t)l * kRP + row : (size_t)l * kRS + (row - kRP);
        const int pos = row_pos(row);
        { const v2u w = *(const v2u*)(z + ZC_CQ + 4 * lane); float f0 = bflo(w.x), f1 = bfhi(w.x), f2 = bflo(w.y), f3 = bfhi(w.y);
          const float rs = rsqrtf(wave_sum((f0 * f0 + f1 * f1) + (f2 * f2 + f3 * f3)) * (1.f / 256.f) + kEPS); const f32x4 g = *(const f32x4*)(qng + 4 * lane);
          v2u o; o.x = pk2(f0 * rs * g.x, f1 * rs * g.y); o.y = pk2(f2 * rs * g.z, f3 * rs * g.w); *(v2u*)(z + ZC_CQ + 4 * lane) = o; }
        { const unsigned w = *(const unsigned*)(z + ZC_CKV + 2 * lane); float f0 = bflo(w), f1 = bfhi(w);
          const float rs = rsqrtf(wave_sum(f0 * f0 + f1 * f1) * (1.f / 128.f) + kEPS); const f32x2 g = *(const f32x2*)(kvng + 2 * lane);
          f0 = f0 * rs * g.x; f1 = f1 * rs * g.y; *(unsigned*)(z + ZC_CKV + 2 * lane) = pk2(f0, f1);
          float* o = a->out + (prompt ? OUT_PCKV : OUT_SCKV) + crow * 128 + 2 * lane; *(f32x2*)o = (f32x2){f0, f1}; }
        { float f = lane < 32 ? bf1(z[ZC_KR + lane]) : 0.f; const float rs = rsqrtf(wave_sum(f * f) * (1.f / 32.f) + kEPS);
          const float fn = lane < 32 ? f * rs * krg[lane & 31] : 0.f; const float other = sw_xor<16>(fn);
          const int i = lane & 15; float sn, cs; sincosf((float)pos * rope_inv16(i), &sn, &cs);
          const float o = (lane & 16) ? (other * sn + fn * cs) : (fn * cs - other * sn);
          if (lane < 32) { a->out[(prompt ? OUT_PKR : OUT_SKR) + crow * 32 + lane] = o; z[ZC_KR + lane] = (bf16)f2bf(o); } }
        { v4u w = *(const v4u*)(z + ZC_SQ + 8 * lane);
          w.x = pk2(bflo(w.x) * QS_64, bfhi(w.x) * QS_64); w.y = pk2(bflo(w.y) * QS_64, bfhi(w.y) * QS_64); w.z = pk2(bflo(w.z) * QS_64, bfhi(w.z) * QS_64); w.w = pk2(bflo(w.w) * QS_64, bfhi(w.w) * QS_64);
          *(v4u*)(z + ZC_SQ + 8 * lane) = w; }
        { const v4u w = *(const v4u*)(z + ZC_DQ + 8 * lane); float f[8] = {bflo(w.x), bfhi(w.x), bflo(w.y), bfhi(w.y), bflo(w.z), bfhi(w.z), bflo(w.w), bfhi(w.w)};
          float s = 0.f;
#pragma unroll
          for (int i = 0; i < 8; ++i) s += f[i] * f[i];
          s += sw_xor<1>(s); s += sw_xor<2>(s); s += sw_xor<4>(s);
          const float rs = rsqrtf(s * (1.f / 64.f) + kEPS) * QS_64; const float* g = dqg + 8 * (lane & 7);
          v4u o; o.x = pk2(f[0] * rs * g[0], f[1] * rs * g[1]); o.y = pk2(f[2] * rs * g[2], f[3] * rs * g[3]); o.z = pk2(f[4] * rs * g[4], f[5] * rs * g[5]); o.w = pk2(f[6] * rs * g[6], f[7] * rs * g[7]);
          *(v4u*)(z + ZC_DQ + 8 * lane) = o; }
        { const v4u w = *(const v4u*)(z + ZC_DK + 8 * lane); float f[8] = {bflo(w.x), bfhi(w.x), bflo(w.y), bfhi(w.y), bflo(w.z), bfhi(w.z), bflo(w.w), bfhi(w.w)};
          float s = 0.f;
#pragma unroll
          for (int i = 0; i < 8; ++i) s += f[i] * f[i];
          s += sw_xor<1>(s); s += sw_xor<2>(s); s += sw_xor<4>(s);
          const float rs = rsqrtf(s * (1.f / 64.f) + kEPS); const float* g = dkg + 8 * (lane & 7);
#pragma unroll
          for (int i = 0; i < 8; ++i) f[i] = f[i] * rs * g[i];
          v4u o; o.x = pk2(f[0], f[1]); o.y = pk2(f[2], f[3]); o.z = pk2(f[4], f[5]); o.w = pk2(f[6], f[7]);
          *(v4u*)(z + ZC_DK + 8 * lane) = o;
          float* od = a->out + (prompt ? OUT_PDK : OUT_SDK) + crow * 512 + 8 * lane; *(f32x4*)od = (f32x4){f[0], f[1], f[2], f[3]}; *(f32x4*)(od + 4) = (f32x4){f[4], f[5], f[6], f[7]}; }
    }
}

__device__ __forceinline__ void post_qk_phase(CArgsP a, int l, int gw, int NGW, int lane) {
    bf16* Q = (bf16*)(a->ws + WS_Q); const bf16* KNMV = (const bf16*)(a->ws + WS_KNMV); bf16* KM = (bf16*)(a->ws + WS_KMLA); const bf16* Z = (const bf16*)(a->ws + WS_Z);
    const float* qng = a->in[IN_QN_G] + l * 64; const float* qrg = a->in[IN_QR_G] + l * 32; const float* kng = a->in[IN_KN_G] + l * 64;
    for (int row = gw; row < kR; row += NGW) {
        const int pos = row_pos(row);
        const int i = lane & 15; float sn, cs; sincosf((float)pos * rope_inv16(i), &sn, &cs);
        const bf16 krv = lane < 32 ? Z[(size_t)row * kZW + ZC_KR + lane] : (bf16)0;
        for (int h = 0; h < 8; ++h) {
            bf16* q = Q + (size_t)row * 768 + h * 96;
            const float v = bf1(q[lane]); const float rs = rsqrtf(wave_sum(v * v) * (1.f / 64.f) + kEPS);
            const float w = lane < 32 ? bf1(q[64 + lane]) : 0.f; const float rs2 = rsqrtf(wave_sum(w * w) * (1.f / 32.f) + kEPS);
            const float wn = lane < 32 ? w * rs2 * qrg[lane & 31] : 0.f; const float other = sw_xor<16>(wn);
            const float o = (lane & 16) ? (other * sn + wn * cs) : (wn * cs - other * sn);
            q[lane] = (bf16)f2bf(v * rs * qng[lane] * QS_MLA);
            if (lane < 32) q[64 + lane] = (bf16)f2bf(o * QS_MLA);
            const float kv = bf1(KNMV[(size_t)row * 1024 + h * 64 + lane]); const float rk = rsqrtf(wave_sum(kv * kv) * (1.f / 64.f) + kEPS);
            bf16* km = KM + (size_t)row * 768 + h * 96;
            km[lane] = (bf16)f2bf(kv * rk * kng[lane]);
            if (lane < 32) km[64 + lane] = krv;
        }
    }
}
__device__ __forceinline__ void post_kc_phase(CArgsP a, int l, int gw, int NGW, int lane) {
    const bf16* KNMVC = (const bf16*)(a->ws + WS_KNMVC); bf16* KMC = (bf16*)(a->ws + WS_KMLAC);
    const float* kng = a->in[IN_KN_G] + l * 64; const float* ckr = a->in[IN_CKR] + (size_t)l * NCACHE * 32;
    for (int row = gw; row < NCACHE; row += NGW) {
        const bf16 krv = lane < 32 ? (bf16)f2bf(ckr[(size_t)row * 32 + lane]) : (bf16)0;
        for (int h = 0; h < 8; ++h) {
            const float kv = bf1(KNMVC[(size_t)row * 1024 + h * 64 + lane]); const float rk = rsqrtf(wave_sum(kv * kv) * (1.f / 64.f) + kEPS);
            bf16* km = KMC + (size_t)row * 768 + h * 96;
            km[lane] = (bf16)f2bf(kv * rk * kng[lane]);
            if (lane < 32) km[64 + lane] = krv;
        }
    }
}

__device__ __forceinline__ void conv_phase(CArgsP a, int l, int gw, int NGW, int lane) {
    const bf16* __restrict__ AU = (const bf16*)(a->ws + WS_AU); bf16* __restrict__ ACT = (bf16*)(a->ws + WS_ACT);
    const float* __restrict__ cw = a->in[IN_CONVW] + (size_t)l * 3 * DFF; const float* __restrict__ cb = a->in[IN_CONVB] + (size_t)l * DFF; const float* __restrict__ cpast = a->in[IN_CONV] + (size_t)l * 16 * 2 * DFF;
    float* __restrict__ outp = a->out;
    constexpr int CG = DFF / 8;
    constexpr int NIT = kR * CG;
    constexpr int U = 4;
    const int stride = NGW * 64;
    for (int it0 = gw * 64 + lane; it0 < NIT; it0 += U * stride) {
        v4u wa[U], wu[U], w1[U], w2[U]; int row[U], c0[U]; bool ok[U];
#pragma unroll
        for (int k = 0; k < U; ++k) { const int it = it0 + k * stride; ok[k] = it < NIT; const int itc = ok[k] ? it : it0; row[k] = itc / CG; c0[k] = (itc % CG) * 8;
            const bool prompt = row[k] < kRP; const int t = prompt ? (row[k] & 2047) : ((row[k] - kRP) & 31);
            const bf16* ap = AU + (size_t)row[k] * 5632 + c0[k];
            wa[k] = *(const v4u*)ap; wu[k] = *(const v4u*)(ap + DFF);
            w1[k] = *(const v4u*)(ap - (t >= 1 ? 5632 : 0)); w2[k] = *(const v4u*)(ap - (t >= 2 ? 2 * 5632 : 0)); }
#pragma unroll
        for (int k = 0; k < U; ++k) { if (!ok[k]) continue;
            const bool prompt = row[k] < kRP; const int t = prompt ? (row[k] & 2047) : ((row[k] - kRP) & 31); const int b = prompt ? (row[k] >> 11) : ((row[k] - kRP) >> 5); const int S = prompt ? 2048 : 32;
            const int cc = c0[k];
            float a0[8] = {bflo(wa[k].x), bfhi(wa[k].x), bflo(wa[k].y), bfhi(wa[k].y), bflo(wa[k].z), bfhi(wa[k].z), bflo(wa[k].w), bfhi(wa[k].w)};
            float uu[8] = {bflo(wu[k].x), bfhi(wu[k].x), bflo(wu[k].y), bfhi(wu[k].y), bflo(wu[k].z), bfhi(wu[k].z), bflo(wu[k].w), bfhi(wu[k].w)};
            float a1[8] = {bflo(w1[k].x), bfhi(w1[k].x), bflo(w1[k].y), bfhi(w1[k].y), bflo(w1[k].z), bfhi(w1[k].z), bflo(w1[k].w), bfhi(w1[k].w)};
            float a2[8] = {bflo(w2[k].x), bfhi(w2[k].x), bflo(w2[k].y), bfhi(w2[k].y), bflo(w2[k].z), bfhi(w2[k].z), bflo(w2[k].w), bfhi(w2[k].w)};
            if (t < 1) {
#pragma unroll
                for (int i = 0; i < 8; ++i) a1[i] = prompt ? 0.f : cpast[((size_t)b * 2 + 1) * DFF + cc + i]; }
            if (t < 2) {
#pragma unroll
                for (int i = 0; i < 8; ++i) a2[i] = prompt ? 0.f : cpast[((size_t)b * 2 + t) * DFF + cc + i]; }
            const f32x4 c00 = *(const f32x4*)(cw + cc), c01 = *(const f32x4*)(cw + cc + 4), c10 = *(const f32x4*)(cw + DFF + cc), c11 = *(const f32x4*)(cw + DFF + cc + 4),
                        c20 = *(const f32x4*)(cw + 2 * DFF + cc), c21 = *(const f32x4*)(cw + 2 * DFF + cc + 4), b0 = *(const f32x4*)(cb + cc), b1 = *(const f32x4*)(cb + cc + 4);
            const float w0[8] = {c00.x, c00.y, c00.z, c00.w, c01.x, c01.y, c01.z, c01.w}, w1f[8] = {c10.x, c10.y, c10.z, c10.w, c11.x, c11.y, c11.z, c11.w},
                        w2f[8] = {c20.x, c20.y, c20.z, c20.w, c21.x, c21.y, c21.z, c21.w}, bb[8] = {b0.x, b0.y, b0.z, b0.w, b1.x, b1.y, b1.z, b1.w};
            float o[8];
#pragma unroll
            for (int i = 0; i < 8; ++i) { const float cv = a2[i] * w0[i] + a1[i] * w1f[i] + a0[i] * w2f[i] + bb[i];
                o[i] = cv * __builtin_amdgcn_rcpf(1.f + __expf(-cv)) * uu[i]; }
            v4u w; w.x = pk2(o[0], o[1]); w.y = pk2(o[2], o[3]); w.z = pk2(o[4], o[5]); w.w = pk2(o[6], o[7]);
            *(v4u*)(ACT + (size_t)row[k] * DFF + cc) = w;
            if (t >= S - 2) { float* od = outp + (prompt ? OUT_PCONV + ((size_t)l * 8 + b) * 2 * DFF : OUT_SCONV + ((size_t)l * 16 + b) * 2 * DFF) + (size_t)(t - (S - 2)) * DFF + cc;
                *(f32x4*)od = (f32x4){a0[0], a0[1], a0[2], a0[3]}; *(f32x4*)(od + 4) = (f32x4){a0[4], a0[5], a0[6], a0[7]}; }
        }
    }
}
#define XB_TMO      128
#define XB_XCNT(j)  (256  + 64 * (j))
#define XB_XSUB(j)  (1280 + 64 * (j))
#define XB_XGEN(j)  (2304 + 64 * (j))
#define XB_TOP      3328
#define XB_TOPGEN   3392
#define XCD_BAR_WORDS 3456
#define XB_SPIN_CAP (1u << 18)

__device__ __forceinline__ unsigned xb_ld(unsigned* p)              { return __hip_atomic_load(p, __ATOMIC_RELAXED, __HIP_MEMORY_SCOPE_AGENT); }
__device__ __forceinline__ unsigned xb_add(unsigned* p, unsigned v) { return __hip_atomic_fetch_add(p, v, __ATOMIC_RELAXED, __HIP_MEMORY_SCOPE_AGENT); }
__device__ __forceinline__ unsigned xb_xcc_id() { return (unsigned)__builtin_amdgcn_s_getreg((3 << 11) | 20) & 0xFu; }
#define XB_SPIN(cond, bar) do { unsigned _sp = 0; while (cond) { __builtin_amdgcn_s_sleep(1); \
    if ((++_sp & 255u) == 0u) { if (xb_ld(&(bar)[XB_TMO])) break; if (_sp > XB_SPIN_CAP) { atomicAdd(&(bar)[XB_TMO], 1u); break; } } } } while (0)

struct XcdBarrier {
    unsigned* bar; unsigned x;
    volatile LAS unsigned* st;
};

__device__ __forceinline__ XcdBarrier xcd_barrier_post(unsigned* bar, volatile LAS unsigned* st, bool t0  ) {
    XcdBarrier b; b.bar = bar; b.x = xb_xcc_id(); b.st = st;
    if (t0) (void)xb_add(&bar[XB_XCNT(b.x)], 1u);
    return b;
}
__device__ __forceinline__ void xcd_barrier_complete(unsigned* bar, unsigned x, unsigned& nloc, unsigned& nx) {
    const unsigned G = gridDim.x * gridDim.y * gridDim.z;
    unsigned sum, cnt, mine, sp = 0u;
    for (;;) {
        sum = 0u; cnt = 0u; mine = 0u;
#pragma unroll
        for (unsigned j = 0; j < 16; ++j) { const unsigned c = xb_ld(&bar[XB_XCNT(j)]); sum += c; cnt += (c > 0u) ? 1u : 0u; mine = (j == x) ? c : mine; }
        if (sum == G) break;
        __builtin_amdgcn_s_sleep(1);
        if ((++sp & 255u) == 0u) { if (xb_ld(&bar[XB_TMO])) break; if (sp > XB_SPIN_CAP) { atomicAdd(&bar[XB_TMO], 1u); break; } }
    }
    nloc = mine > 0u ? mine : 1u; nx = cnt > 0u ? cnt : 1u;
}

__device__ __forceinline__ void xcd_barrier(const XcdBarrier& b, bool t0  ) {
    asm volatile("s_waitcnt vmcnt(0)" ::: "memory");
    __syncthreads();
    if (t0) {
        unsigned* bar = b.bar;
        __builtin_amdgcn_s_waitcnt(0);
        unsigned nloc = b.st[0], nx = b.st[1];
        if (nloc == 0u) { xcd_barrier_complete(bar, b.x, nloc, nx); b.st[0] = nloc; b.st[1] = nx; }
        const unsigned old = xb_add(&bar[XB_XSUB(b.x)], 1u);
        const unsigned gen = old / nloc;
        if (old + 1u == (gen + 1u) * nloc) {
            __builtin_amdgcn_fence(__ATOMIC_RELEASE, "agent");
            asm volatile("s_waitcnt vmcnt(0)" ::: "memory");
            const unsigned og = xb_add(&bar[XB_TOP], 1u);
            const unsigned tg = og / nx;
            if (og + 1u == (tg + 1u) * nx) xb_add(&bar[XB_TOPGEN], 1u);
            else XB_SPIN(xb_ld(&bar[XB_TOPGEN]) == tg, bar);
            __builtin_amdgcn_fence(__ATOMIC_ACQUIRE, "agent");
            xb_add(&bar[XB_XGEN(b.x)], 1u);
            asm volatile("s_waitcnt vmcnt(0)" ::: "memory");
        } else {
            XB_SPIN(xb_ld(&bar[XB_XGEN(b.x)]) == gen, bar);
            __builtin_amdgcn_fence(__ATOMIC_ACQUIRE, "agent");
            asm volatile("s_waitcnt vmcnt(0)" ::: "memory");
        }
    }
    __syncthreads();
}
namespace att {
typedef short bf16x8 __attribute__((ext_vector_type(8)));
typedef short s16x4 __attribute__((ext_vector_type(4)));
typedef float f32x16 __attribute__((ext_vector_type(16)));
enum { MLA = 0, SBK = 1, DIFF = 2 };
template <int N> struct IC { static constexpr int value = N; };
template <int MODE> struct Cfg {
    static constexpr int DQK = MODE == MLA ? 96 : 64;
    static constexpr int NMAP = MODE == DIFF ? 2 : 1;
    static constexpr int KW = MODE == MLA ? 96 : (MODE == DIFF ? 128 : 64);
    static constexpr int DV = MODE == DIFF ? 128 : 64;
    static constexpr int KP = KW * 2 + 16;
    static constexpr int VP = MODE == DIFF ? 320 : 192;
    static constexpr int KS = DQK / 16, DT = DV / 32;
    static constexpr int KWS = MODE == MLA ? 96 : 64;
    static constexpr int KPS = KWS * 2 + 16;
};
__device__ __forceinline__ unsigned cvtpk(float lo, float hi) { typedef float f2 __attribute__((ext_vector_type(2))); typedef __bf16 b2 __attribute__((ext_vector_type(2)));
    f2 v = {lo, hi}; b2 b = __builtin_convertvector(v, b2); return __builtin_bit_cast(unsigned, b); }
__device__ __forceinline__ bf16x8 pack8(const f32x16& p, int s8) {
    v4u w; w.x = cvtpk(p[s8 + 0], p[s8 + 1]); w.y = cvtpk(p[s8 + 2], p[s8 + 3]); w.z = cvtpk(p[s8 + 4], p[s8 + 5]); w.w = cvtpk(p[s8 + 6], p[s8 + 7]); return __builtin_bit_cast(bf16x8, w); }
__device__ __forceinline__ s16x4 vtr(LAS const unsigned char* p) { typedef short v4i16_t __attribute__((ext_vector_type(4)));
    return __builtin_bit_cast(s16x4, __builtin_amdgcn_ds_read_tr16_b64_v4i16((LAS v4i16_t*)p)); }
__device__ __forceinline__ float ex2(float x) { return __builtin_amdgcn_exp2f(x); }
__device__ __forceinline__ float lg2(float x) { return __builtin_amdgcn_logf(x); }

template <int KS> __device__ __forceinline__ f32x16 qk_sub(LAS const unsigned char* Kt, int kpitch, const bf16x8 (&qf)[KS], int r32, int hi) {
    f32x16 p = {0.f, 0.f, 0.f, 0.f, 0.f, 0.f, 0.f, 0.f, 0.f, 0.f, 0.f, 0.f, 0.f, 0.f, 0.f, 0.f};
    LAS const unsigned char* kb = Kt + r32 * kpitch + hi * 16;
#pragma unroll
    for (int ks = 0; ks < KS; ++ks) { const bf16x8 kf = *(LAS const bf16x8*)(kb + ks * 32); p = __builtin_amdgcn_mfma_f32_32x32x16_bf16(kf, qf[ks], p, 0, 0, 0); }
    return p;
}
__device__ __forceinline__ bf16x8 v_frag(LAS const unsigned char* Vt, int vpitch, int dt, int s, int lane) {
    const int i = lane & 15, g1 = (lane >> 4) & 1, hi = lane >> 5;
    LAS const unsigned char* a = Vt + (16 * s + 4 * hi + (i >> 2)) * vpitch + (32 * dt + 16 * g1 + 4 * (i & 3)) * 2;
    const s16x4 lo = vtr(a), hh = vtr(a + 8 * vpitch);
    return (bf16x8){lo[0], lo[1], lo[2], lo[3], hh[0], hh[1], hh[2], hh[3]};
}

__device__ __forceinline__ void store_pair16(bf16* p, v2u wk, v2u wk1, int hi) {
    auto r0 = __builtin_amdgcn_permlane32_swap(wk.x, wk1.x, false, false); auto r1 = __builtin_amdgcn_permlane32_swap(wk.y, wk1.y, false, false);
    v4u o; o.x = r0[0]; o.y = r1[0]; o.z = r0[1]; o.w = r1[1];
    *(v4u*)(p + (hi ? 8 : 0)) = o;
}
__device__ __forceinline__ void softmax_update(f32x16& p, float& m, float& l, float& alpha) {
    float mx = p[0];
#pragma unroll
    for (int r = 1; r < 16; ++r) mx = fmaxf(mx, p[r]);
    mx = half_max(mx);
    const float mn = fmaxf(m, mx); alpha = ex2(m - mn); m = mn;
    float s = 0.f;
#pragma unroll
    for (int r = 0; r < 16; ++r) { p[r] = ex2(p[r] - mn); s += p[r]; }
    l = l * alpha + s;
}
__device__ __forceinline__ void softmax_update2(f32x16& pa, f32x16& pb, float& m, float& l, float& alpha) {
    float mx = fmaxf(pa[0], pb[0]);
#pragma unroll
    for (int r = 1; r < 16; ++r) mx = fmaxf(mx, fmaxf(pa[r], pb[r]));
    mx = half_max(mx);
    const float mn = fmaxf(m, mx); alpha = ex2(m - mn); m = mn;
    float s0 = 0.f, s1 = 0.f;
#pragma unroll
    for (int r = 0; r < 16; ++r) { pa[r] = ex2(pa[r] - mn); pb[r] = ex2(pb[r] - mn); s0 += pa[r]; s1 += pb[r]; }
    l = l * alpha + (s0 + s1);
}
__device__ __forceinline__ void sb_update(f32x16& p, unsigned vmask, float& C, int hi) {
    float lnb[16];
#pragma unroll
    for (int r = 0; r < 16; ++r) { const float t = p[r]; const float w = t > 64.0f ? t : lg2(1.0f + ex2(t));
        const bool ok = (vmask >> r) & 1u; lnb[r] = ok ? -w : 0.f; p[r] = t - w; }
    float e[16], T[4], Tp[4];
#pragma unroll
    for (int g = 0; g < 4; ++g) { e[4 * g + 3] = 0.f; e[4 * g + 2] = lnb[4 * g + 3]; e[4 * g + 1] = e[4 * g + 2] + lnb[4 * g + 2]; e[4 * g + 0] = e[4 * g + 1] + lnb[4 * g + 1]; T[g] = e[4 * g] + lnb[4 * g]; }
#pragma unroll
    for (int g = 0; g < 4; ++g) Tp[g] = half_other(T[g], hi);
    const float ps0 = T[0] + Tp[0], ps1 = T[1] + Tp[1], ps2 = T[2] + Tp[2], ps3 = T[3] + Tp[3];
    float Rg[4]; Rg[3] = 0.f; Rg[2] = ps3; Rg[1] = ps3 + ps2; Rg[0] = Rg[1] + ps1;
    const float tot = Rg[0] + ps0;
#pragma unroll
    for (int g = 0; g < 4; ++g) { const float sg = C + Rg[g] + (hi == 0 ? Tp[g] : 0.f);
#pragma unroll
        for (int j = 0; j < 4; ++j) { const int r = 4 * g + j; const bool ok = (vmask >> r) & 1u; p[r] = ok ? ex2(p[r] + sg + e[r]) : 0.f; } }
    C += tot;
}

template <int MODE>
__device__ __forceinline__ void prompt_unit(LAS unsigned char* lds, const bf16* Qb, int qp, const bf16* Kb, int kp, const bf16* Vb, int vp, bf16* Ob, int op, int q0,
                                            int tid, int lane, int wave, float slope2, float lam, float onem_lam_init, const float* subln_g) {
    typedef Cfg<MODE> C;
    constexpr int KS = C::KS, DT = C::DT, KP = C::KP, VP = C::VP;
    constexpr int QROWS = MODE == DIFF ? 128 : 256;
    constexpr int KTB = 64 * KP, VTB = 64 * VP, BUFB = KTB + VTB;
    constexpr int KCR = C::KW / 8, VCR = C::DV / 8;
    constexpr int NKC = (64 * KCR + 511) / 512, NVC = (64 * VCR + 511) / 512;
    constexpr int KTPR = KCR / NKC, VTPR = VCR / NVC;
    static_assert(KCR % NKC == 0 && VCR % NVC == 0 && 64 * KTPR <= 512 && 64 * VTPR <= 512 && 2 * BUFB <= RING_BYTES, "staging map");
    const int r32 = lane & 31, hi = lane >> 5;
    const int wq = MODE == DIFF ? (wave & 3) : wave, map = MODE == DIFF ? (wave >> 2) : 0;
    const int qrow = q0 + 32 * wq + r32;
    bf16x8 qf[KS];
#pragma unroll
    for (int ks = 0; ks < KS; ++ks) qf[ks] = *(const bf16x8*)(Qb + (size_t)qrow * qp + map * 64 + ks * 16 + hi * 8);
    f32x16 o[DT];
#pragma unroll
    for (int dt = 0; dt < DT; ++dt)
#pragma unroll
        for (int r = 0; r < 16; ++r) o[dt][r] = 0.f;
    float mrun = -INFINITY, lrun = 0.f, Ccar = 0.f;
    bool dead = false;
    LAS volatile unsigned* sbflag = (LAS volatile unsigned*)(lds + RING_BYTES + 4352);
    if (MODE == SBK && tid < 16) sbflag[tid] = 0u;
    const int ntiles = (q0 + QROWS) / 64;
    const int cw = (q0 + 32 * wq) / 64;
    v4u kreg[NKC], vreg[NVC];
    const bool kact = tid < 64 * KTPR, vact = tid < 64 * VTPR;
    const int krow = tid / KTPR, kcc = (tid % KTPR) * NKC, vrow = tid / VTPR, vcc = (tid % VTPR) * NVC;
    const bf16* kgp = Kb + (size_t)krow * kp + kcc * 8; const bf16* vgp = Vb + (size_t)vrow * vp + vcc * 8;
    LAS unsigned char* klp = lds + krow * KP + kcc * 16; LAS unsigned char* vlp = lds + KTB + vrow * VP + vcc * 16;
    LAS const unsigned char* kfp = lds + r32 * KP + hi * 16 + map * 128;
    LAS const unsigned char* vfp = lds + KTB + (4 * hi + ((lane & 15) >> 2)) * VP + (16 * ((lane >> 4) & 1) + 4 * (lane & 3)) * 2;
    auto issue = [&](int jt) {
        if (kact) {
#pragma unroll
            for (int i = 0; i < NKC; ++i) kreg[i] = *(const v4u*)(kgp + (size_t)jt * 64 * kp + i * 8); }
        if (vact) {
#pragma unroll
            for (int i = 0; i < NVC; ++i) vreg[i] = *(const v4u*)(vgp + (size_t)jt * 64 * vp + i * 8); }
    };
    auto commit = [&](auto BUFC) {
        constexpr int buf = decltype(BUFC)::value;
        if (kact) {
#pragma unroll
            for (int i = 0; i < NKC; ++i) *(LAS v4u*)(klp + buf * BUFB + i * 16) = kreg[i]; }
        if (vact) {
#pragma unroll
            for (int i = 0; i < NVC; ++i) *(LAS v4u*)(vlp + buf * BUFB + i * 16) = vreg[i]; }
    };
    auto step = [&](int it, auto CURC) {
        constexpr int cur = decltype(CURC)::value;
        const int jt = ntiles - 1 - it;
        if (it + 1 < ntiles) issue(jt - 1);
        if (jt <= cw && !dead) {
            f32x16 p1 = {0.f, 0.f, 0.f, 0.f, 0.f, 0.f, 0.f, 0.f, 0.f, 0.f, 0.f, 0.f, 0.f, 0.f, 0.f, 0.f}, p0 = p1;
            bf16x8 kf1[KS], kf0[KS];
#pragma unroll
            for (int ks = 0; ks < KS; ++ks) { kf1[ks] = *(LAS const bf16x8*)(kfp + cur * BUFB + 32 * KP + ks * 32); kf0[ks] = *(LAS const bf16x8*)(kfp + cur * BUFB + ks * 32); }
            __builtin_amdgcn_s_setprio(1);
#pragma unroll
            for (int ks = 0; ks < KS; ++ks) { p1 = __builtin_amdgcn_mfma_f32_32x32x16_bf16(kf1[ks], qf[ks], p1, 0, 0, 0); p0 = __builtin_amdgcn_mfma_f32_32x32x16_bf16(kf0[ks], qf[ks], p0, 0, 0, 0); }
            __builtin_amdgcn_s_setprio(0);
            const int base0 = qrow - jt * 64 - 4 * hi, base1 = base0 - 32;
            if constexpr (MODE == SBK) {
                unsigned vm1 = 0xffffu, vm0 = 0xffffu;
                if (jt == cw) { vm1 = 0u; vm0 = 0u;
#pragma unroll
                    for (int r = 0; r < 16; ++r) { vm1 |= (((r & 3) + 8 * (r >> 2)) < base1 ? 1u : 0u) << r; vm0 |= (((r & 3) + 8 * (r >> 2)) < base0 ? 1u : 0u) << r; } }
                sb_update(p1, vm1, Ccar, hi); sb_update(p0, vm0, Ccar, hi);
            } else {
                if constexpr (MODE == DIFF) { const float f0 = (float)base0, f1 = (float)base1;
#pragma unroll
                    for (int r = 0; r < 16; ++r) { const float cr = (float)((r & 3) + 8 * (r >> 2)); p0[r] -= slope2 * fabsf(f0 - cr); p1[r] -= slope2 * fabsf(f1 - cr); } }
                float alpha; softmax_update2(p0, p1, mrun, lrun, alpha);
                if (__any(alpha != 1.0f)) {
#pragma unroll
                    for (int dt = 0; dt < DT; ++dt)
#pragma unroll
                        for (int r = 0; r < 16; ++r) o[dt][r] *= alpha; }
            }
            const bf16x8 pf[4] = {pack8(p0, 0), pack8(p0, 8), pack8(p1, 0), pack8(p1, 8)};
#pragma unroll
            for (int dt = 0; dt < DT; ++dt) {
                bf16x8 vf[4];
#pragma unroll
                for (int s = 0; s < 4; ++s) { LAS const unsigned char* va = vfp + cur * BUFB + (16 * s) * VP + dt * 64;
                    const s16x4 lo = vtr(va), hh = vtr(va + 8 * VP); vf[s] = (bf16x8){lo[0], lo[1], lo[2], lo[3], hh[0], hh[1], hh[2], hh[3]}; }
                __builtin_amdgcn_s_setprio(1);
#pragma unroll
                for (int s = 0; s < 4; ++s) o[dt] = __builtin_amdgcn_mfma_f32_32x32x16_bf16(vf[s], pf[s], o[dt], 0, 0, 0);
                __builtin_amdgcn_s_setprio(0);
            }
            if constexpr (MODE == SBK) { if (__all(Ccar < -160.0f)) { dead = true; if (lane == 0) sbflag[wave] = 1u; } }
        }
        if (it + 1 < ntiles) commit(IC<(cur ^ 1)>{});
        __syncthreads();
    };
    issue(ntiles - 1); commit(IC<0>{});
    __syncthreads();
    __builtin_amdgcn_s_waitcnt(0x0F70);
#pragma unroll 1
    for (int it = 0; it < ntiles; it += 2) {
        if constexpr (MODE == SBK) {
            if (it > 0) { if (tid == 0) { unsigned n = 0; for (int w = 0; w < 8; ++w) n += sbflag[w]; sbflag[8] = n; }
                __syncthreads(); if (sbflag[8] == 8u) break; }
        }
        step(it, IC<0>{}); step(it + 1, IC<1>{});
    }
    bf16* orow = Ob + (size_t)qrow * op;
    if constexpr (MODE == MLA) {
        const float inv = 1.0f / half_sum(lrun);
#pragma unroll
        for (int dt = 0; dt < DT; ++dt)
#pragma unroll
            for (int g = 0; g < 4; g += 2) { v2u w0, w1; w0.x = cvtpk(o[dt][4 * g] * inv, o[dt][4 * g + 1] * inv); w0.y = cvtpk(o[dt][4 * g + 2] * inv, o[dt][4 * g + 3] * inv);
                w1.x = cvtpk(o[dt][4 * g + 4] * inv, o[dt][4 * g + 5] * inv); w1.y = cvtpk(o[dt][4 * g + 6] * inv, o[dt][4 * g + 7] * inv);
                store_pair16(orow + 32 * dt + 8 * g, w0, w1, hi); }
    } else if constexpr (MODE == SBK) {
#pragma unroll
        for (int dt = 0; dt < DT; ++dt)
#pragma unroll
            for (int g = 0; g < 4; g += 2) { v2u w0, w1; w0.x = cvtpk(o[dt][4 * g], o[dt][4 * g + 1]); w0.y = cvtpk(o[dt][4 * g + 2], o[dt][4 * g + 3]);
                w1.x = cvtpk(o[dt][4 * g + 4], o[dt][4 * g + 5]); w1.y = cvtpk(o[dt][4 * g + 6], o[dt][4 * g + 7]);
                store_pair16(orow + 32 * dt + 8 * g, w0, w1, hi); }
    } else {
        LAS float* xo = (LAS float*)lds + wq * (128 * 32);
        const float inv = (map == 1 ? lam : 1.0f) / half_sum(lrun);
        if (map == 1) {
#pragma unroll
            for (int dt = 0; dt < DT; ++dt)
#pragma unroll
                for (int r = 0; r < 16; ++r) xo[(32 * dt + 8 * (r >> 2) + 4 * hi + (r & 3)) * 32 + r32] = o[dt][r] * inv;
        }
        __syncthreads();
        if (map == 0) {
            float ss = 0.f;
#pragma unroll
            for (int dt = 0; dt < DT; ++dt)
#pragma unroll
                for (int r = 0; r < 16; ++r) { const float v = o[dt][r] * inv - xo[(32 * dt + 8 * (r >> 2) + 4 * hi + (r & 3)) * 32 + r32]; o[dt][r] = v; ss += v * v; }
            ss = half_sum(ss);
            const float rs = rsqrtf(ss * (1.0f / 128.0f) + kEPS) * onem_lam_init;
#pragma unroll
            for (int dt = 0; dt < DT; ++dt)
#pragma unroll
                for (int g = 0; g < 4; g += 2) { const int d = 32 * dt + 8 * g + 4 * hi; const f32x4 g0 = *(const f32x4*)(subln_g + d), g1 = *(const f32x4*)(subln_g + d + 8);
                    v2u w0, w1; w0.x = cvtpk(o[dt][4 * g] * rs * g0.x, o[dt][4 * g + 1] * rs * g0.y); w0.y = cvtpk(o[dt][4 * g + 2] * rs * g0.z, o[dt][4 * g + 3] * rs * g0.w);
                    w1.x = cvtpk(o[dt][4 * g + 4] * rs * g1.x, o[dt][4 * g + 5] * rs * g1.y); w1.y = cvtpk(o[dt][4 * g + 6] * rs * g1.z, o[dt][4 * g + 7] * rs * g1.w);
                    store_pair16(orow + 32 * dt + 8 * g, w0, w1, hi); }
        }
        __syncthreads();
    }
}

struct SampleSrc {
    const void* kc; int kcp; const void* vc; int vcp;
    const bf16* kn; int knp; const bf16* vn; int vnp;
    const bf16* q; int qp;
};
template <int MODE>
__device__ __forceinline__ void sample_unit(LAS unsigned char* lds, LAS unsigned char* xch, const SampleSrc& S, bf16* Ob  , int op,
                                            int tid, int lane, int wave, float slope2, float lam, float onem_lam_init, const float* subln_g, const float* wuv = nullptr  ) {
    typedef Cfg<MODE> C;
    constexpr int KS = C::KS, KP = C::KPS, KWS = C::KWS, DV = MODE == MLA ? 128 : C::DV, DT = DV / 32, VP = MODE == MLA ? 272 : C::VP;
    constexpr bool CF32 = MODE != MLA;
    constexpr int KTB = 32 * KP, VTB = 32 * VP, WB = (KTB + VTB + 255) & ~255;
    constexpr int NKC = 32 * KWS / 8 / 64, NVH = 16 * DV / 8 / 64;
    static_assert(8 * WB <= RING_BYTES, "sample staging");
    constexpr int KLPR = (KWS / 8) / NKC, VLPR = (DV / 8) / NVH;
    static_assert(32 * KLPR == 64 && 16 * VLPR == 64, "sample staging map");
    const int r32 = lane & 31, hi = lane >> 5;
    const int krow = lane / KLPR, kcc = (lane % KLPR) * NKC, vrow = lane / VLPR, vcc = (lane % VLPR) * NVH;
    constexpr int NG = MODE == DIFF ? 2 : 1, WPG = 8 / NG;
    const int wi = wave % WPG;
    LAS unsigned char* kb = lds + wave * WB; LAS unsigned char* vb = kb + KTB;
    constexpr bool QLDS = MODE == DIFF || MODE == MLA;
    bf16x8 qf[QLDS ? 1 : KS];
    LAS unsigned char* qlp = lds + 8 * WB + (wave / WPG) * (KS * 1024) + lane * 16;
    static_assert(!QLDS || 8 * WB + NG * KS * 1024 <= RING_BYTES, "sample Q LDS");
#pragma unroll
    for (int ks = 0; ks < KS; ++ks) { const bf16x8 q_ = *(const bf16x8*)(S.q + (size_t)r32 * S.qp + ks * 16 + hi * 8); if constexpr (QLDS) *(LAS bf16x8*)(qlp + ks * 1024) = q_; else qf[ks] = q_; }
    f32x16 o[DT];
#pragma unroll
    for (int dt = 0; dt < DT; ++dt)
#pragma unroll
        for (int r = 0; r < 16; ++r) o[dt][r] = 0.f;
    float mrun = -INFINITY, lrun = 0.f, Ccar = 0.f;
    const int qpos = PASTL + r32;

    bf16x8 pf[2];
    auto computeA = [&](int kpos0, bool diag) {
        f32x16 p = {0.f, 0.f, 0.f, 0.f, 0.f, 0.f, 0.f, 0.f, 0.f, 0.f, 0.f, 0.f, 0.f, 0.f, 0.f, 0.f};
        { LAS const unsigned char* kq = kb + r32 * KP + hi * 16;
#pragma unroll
          for (int ks = 0; ks < KS; ++ks) { const bf16x8 kf = *(LAS const bf16x8*)(kq + ks * 32); bf16x8 qq; if constexpr (QLDS) qq = *(LAS const bf16x8*)(qlp + ks * 1024); else qq = qf[ks];
              p = __builtin_amdgcn_mfma_f32_32x32x16_bf16(kf, qq, p, 0, 0, 0); } }
        const int base = qpos - kpos0 - 4 * hi;
        if constexpr (MODE == SBK) {
            unsigned vmask = 0xffffu;
            if (diag) { vmask = 0u;
#pragma unroll
                for (int r = 0; r < 16; ++r) vmask |= (((r & 3) + 8 * (r >> 2)) < base ? 1u : 0u) << r; }
            sb_update(p, vmask, Ccar, hi);
        } else {
            if constexpr (MODE == DIFF) { const float fb = (float)base;
#pragma unroll
                for (int r = 0; r < 16; ++r) p[r] -= slope2 * fabsf(fb - (float)((r & 3) + 8 * (r >> 2))); }
            float alpha; softmax_update(p, mrun, lrun, alpha);
            if (__any(alpha != 1.0f)) {
#pragma unroll
                for (int dt = 0; dt < DT; ++dt)
#pragma unroll
                    for (int r = 0; r < 16; ++r) o[dt][r] *= alpha; }
        }
        pf[0] = pack8(p, 0); pf[1] = pack8(p, 8);
#pragma unroll
        for (int dt = 0; dt < DT; ++dt) { const bf16x8 vf = v_frag(vb, VP, dt, 0, lane); o[dt] = __builtin_amdgcn_mfma_f32_32x32x16_bf16(vf, pf[0], o[dt], 0, 0, 0); }
    };
    auto computeB = [&]() {
#pragma unroll
        for (int dt = 0; dt < DT; ++dt) { const bf16x8 vf = v_frag(vb, VP, dt, 1, lane); o[dt] = __builtin_amdgcn_mfma_f32_32x32x16_bf16(vf, pf[1], o[dt], 0, 0, 0); }
    };
    auto new_rows = [&]() {
        int ln2 = lane; asm volatile("" : "+v"(ln2));
        const int krow = ln2 / KLPR, kcc = (ln2 % KLPR) * NKC, vrow = ln2 / VLPR, vcc = (ln2 % VLPR) * NVH;
#pragma unroll
        for (int i = 0; i < NKC; ++i) *(LAS v4u*)(kb + krow * KP + (kcc + i) * 16) = *(const v4u*)(S.kn + (size_t)krow * S.knp + (kcc + i) * 8);
#pragma unroll
        for (int hf = 0; hf < 2; ++hf)
#pragma unroll
            for (int i = 0; i < NVH; ++i) *(LAS v4u*)(vb + (16 * hf + vrow) * VP + (vcc + i) * 16) = *(const v4u*)(S.vn + (size_t)(16 * hf + vrow) * S.vnp + (vcc + i) * 8);
        computeA(PASTL, true); computeB();
    };
    if (MODE == SBK && wi == WPG - 1) new_rows();
    constexpr int SPW = 128 / WPG;
    const int s_lo = wi * SPW, s_hi = s_lo + SPW;
    constexpr int NKR = CF32 ? 2 * NKC : NKC, NVR = CF32 ? 2 * NVH : NVH;
    v4u kr[NKR], vr[2][NVR];
    auto cvt8 = [&](const v4u& a, const v4u& b) { v4u w; w.x = cvtpk(__uint_as_float(a.x), __uint_as_float(a.y)); w.y = cvtpk(__uint_as_float(a.z), __uint_as_float(a.w));
        w.z = cvtpk(__uint_as_float(b.x), __uint_as_float(b.y)); w.w = cvtpk(__uint_as_float(b.z), __uint_as_float(b.w)); return w; };
    constexpr int ESZ = CF32 ? 4 : 2;
    const unsigned kgo = (unsigned)((krow * S.kcp + kcc * 8) * ESZ), vgo = (unsigned)((vrow * S.vcp + vcc * 8) * ESZ);
    LAS unsigned char* kll = kb + krow * KP + kcc * 16; LAS unsigned char* vll = vb + vrow * VP + vcc * 16;
    constexpr int LK = KWS * 4 / 16, LV = DV * 4 / 16;
    const unsigned kgo32 = (unsigned)(((lane / LK) * S.kcp) * 4 + (lane % LK) * 16), vgo32 = (unsigned)(((lane / LV) * S.vcp) * 4 + (lane % LV) * 16);
    LAS unsigned char* kll32 = kb + (lane / LK) * KP + (lane % LK) * 8; LAS unsigned char* vll32 = vb + (lane / LV) * VP + (lane % LV) * 8;
    unsigned kof[CF32 ? 1 : NKC]; unsigned vof0 = 0;
    if constexpr (!CF32) { int lnk = lane; asm volatile("" : "+v"(lnk));
#pragma unroll
        for (int i = 0; i < NKC; ++i) { const int p = 64 * i + lnk, row = p / (KWS / 8), ch = p % (KWS / 8); kof[i] = (unsigned)((row * S.kcp + ch * 8) * 2); }
        vof0 = (unsigned)(((lnk / (DV / 8)) * S.vcp + (lnk % (DV / 8)) * 8) * 2); }
    auto issue = [&](int s) {
        if constexpr (CF32) {
            const unsigned char* g = (const unsigned char*)S.kc + (size_t)(32 * s) * S.kcp * 4;
#pragma unroll
            for (int i = 0; i < NKR; ++i) kr[i] = __builtin_nontemporal_load((const v4u*)(g + kgo32 + (size_t)i * (64 / LK) * S.kcp * 4));
#pragma unroll
            for (int hf = 0; hf < 2; ++hf) { const unsigned char* gv = (const unsigned char*)S.vc + (size_t)(32 * s + 16 * hf) * S.vcp * 4;
#pragma unroll
                for (int i = 0; i < NVR; ++i) vr[hf][i] = __builtin_nontemporal_load((const v4u*)(gv + vgo32 + (size_t)i * (64 / LV) * S.vcp * 4)); }
        } else {
            const unsigned char* g = (const unsigned char*)S.kc + (size_t)(32 * s) * S.kcp * 2;
#pragma unroll
            for (int i = 0; i < NKR; ++i) kr[i] = __builtin_nontemporal_load((const v4u*)(g + kof[i]));
#pragma unroll
            for (int hf = 0; hf < 2; ++hf) { const unsigned char* gv = (const unsigned char*)S.vc + (size_t)(32 * s + 16 * hf) * S.vcp * 2;
#pragma unroll
                for (int i = 0; i < NVR; ++i) vr[hf][i] = __builtin_nontemporal_load((const v4u*)(gv + vof0 + (unsigned)(i * (64 / (DV / 8)) * S.vcp * 2))); }
        }
    };
    auto cvt4 = [&](const v4u& x) { v2u w; w.x = cvtpk(__uint_as_float(x.x), __uint_as_float(x.y)); w.y = cvtpk(__uint_as_float(x.z), __uint_as_float(x.w)); return w; };
    auto commit = [&]() {
        if constexpr (CF32) {
#pragma unroll
            for (int i = 0; i < NKR; ++i) *(LAS v2u*)(kll32 + i * (64 / LK) * KP) = cvt4(kr[i]);
#pragma unroll
            for (int hf = 0; hf < 2; ++hf)
#pragma unroll
                for (int i = 0; i < NVR; ++i) *(LAS v2u*)(vll32 + (16 * hf + i * (64 / LV)) * VP) = cvt4(vr[hf][i]);
        } else {
#pragma unroll
            for (int i = 0; i < NKC; ++i) { const int p = 64 * i + lane, row = p / (KWS / 8), ch = p % (KWS / 8); *(LAS v4u*)(kb + row * KP + ch * 16) = kr[i]; }
#pragma unroll
            for (int hf = 0; hf < 2; ++hf)
#pragma unroll
                for (int i = 0; i < NVH; ++i) { const int p = 64 * i + lane, row = 16 * hf + p / (DV / 8), ch = p % (DV / 8); *(LAS v4u*)(vb + row * VP + ch * 16) = vr[hf][i]; }
        }
    };
    issue(s_hi - 1);
#pragma unroll 1
    for (int s = s_hi - 1; s >= s_lo; --s) {
        commit();
        if (s > s_lo) issue(s - 1);
        computeA(32 * s, false);
        computeB();
    }
    if (MODE != SBK && wi == WPG - 1) new_rows();
    f32x4 wreg[MODE == MLA ? 4 : 1];
    if constexpr (MODE == MLA) {
#pragma unroll
        for (int i = 0; i < 4; ++i) { const int p = tid + 512 * i; wreg[i] = *(const f32x4*)(wuv + (size_t)(p >> 4) * 512 + (p & 15) * 4); } }
    __syncthreads();
    LAS float* part = (LAS float*)lds;
    LAS float* st = (LAS float*)xch;
#pragma unroll
    for (int dt = 0; dt < DT; ++dt)
#pragma unroll
        for (int r = 0; r < 16; ++r) part[(wave * DV + 32 * dt + 8 * (r >> 2) + 4 * hi + (r & 3)) * 32 + r32] = o[dt][r];
    if (hi == 0) { st[wave * 32 + r32] = MODE == SBK ? Ccar : mrun; }
    { const float lt = half_sum(lrun); if (hi == 0) st[256 + wave * 32 + r32] = lt; }
    __syncthreads();
    {
        const int q = tid & 31, dg = tid >> 5;
        constexpr int DPG = DV / 16;
        float sc[8];
        if constexpr (MODE == SBK) { float car = 0.f;
#pragma unroll
            for (int w = 7; w >= 0; --w) { sc[w] = ex2(car); car += st[w * 32 + q]; }
        } else {
#pragma unroll
            for (int g = 0; g < NG; ++g) { float M = -INFINITY;
#pragma unroll
                for (int w = 0; w < WPG; ++w) M = fmaxf(M, st[(g * WPG + w) * 32 + q]);
                float L = 0.f;
#pragma unroll
                for (int w = 0; w < WPG; ++w) { const float e = ex2(st[(g * WPG + w) * 32 + q] - M); sc[g * WPG + w] = e; L += e * st[256 + (g * WPG + w) * 32 + q]; }
                const float invL = (g == 1 ? -lam : 1.0f) / L;
#pragma unroll
                for (int w = 0; w < WPG; ++w) sc[g * WPG + w] *= invL; }
        }
        float v[DPG]; float ss = 0.f;
#pragma unroll
        for (int j = 0; j < DPG; ++j) { const int d = dg * DPG + j; float a = 0.f;
#pragma unroll
            for (int w = 0; w < 8; ++w) a += sc[w] * part[(w * DV + d) * 32 + q];
            v[j] = a; ss += a * a; }
        if constexpr (MODE == DIFF) {
            __syncthreads();
            st[dg * 32 + q] = ss;
            __syncthreads();
            float tot = 0.f;
#pragma unroll
            for (int g = 0; g < 16; ++g) tot += st[g * 32 + q];
            const float rs = rsqrtf(tot * (1.0f / 128.0f) + kEPS) * onem_lam_init;
#pragma unroll
            for (int j = 0; j < DPG; ++j) v[j] *= rs * subln_g[dg * DPG + j];
        }
        if constexpr (MODE == MLA) {
            __syncthreads();
            LAS float* lat = (LAS float*)lds;
            LAS float* wl_ = lat + 8192;
            *(LAS f32x4*)(lat + q * 132 + dg * 8) = (f32x4){v[0], v[1], v[2], v[3]}; *(LAS f32x4*)(lat + q * 132 + dg * 8 + 4) = (f32x4){v[4], v[5], v[6], v[7]};
#pragma unroll
            for (int i = 0; i < 4; ++i) { const int p = tid + 512 * i; *(LAS f32x4*)(wl_ + (p >> 4) * 64 + (p & 15) * 4) = wreg[i]; }
            __syncthreads();
            f32x4 acc = {0.f, 0.f, 0.f, 0.f};
#pragma unroll 4
            for (int d0 = 0; d0 < 128; d0 += 4) { const f32x4 l4 = *(LAS const f32x4*)(lat + q * 132 + d0);
#pragma unroll
                for (int j = 0; j < 4; ++j) { const f32x4 w4 = *(LAS const f32x4*)(wl_ + (d0 + j) * 64 + dg * 4); acc += l4[j] * w4; } }
            v2u w; w.x = cvtpk(acc[0], acc[1]); w.y = cvtpk(acc[2], acc[3]); *(v2u*)(Ob + (size_t)q * op + dg * 4) = w;
        } else {
        bf16* od = Ob + (size_t)q * op + dg * DPG;
        if constexpr (DPG == 4) { v2u w; w.x = cvtpk(v[0], v[1]); w.y = cvtpk(v[2], v[3]); *(v2u*)od = w; }
        else { v4u w; w.x = cvtpk(v[0], v[1]); w.y = cvtpk(v[2], v[3]); w.z = cvtpk(v[4], v[5]); w.w = cvtpk(v[6], v[7]); *(v4u*)od = w; }
        }
    }
    __syncthreads();
}
__device__ __forceinline__ void sample_unit_sb(LAS unsigned char* lds, LAS unsigned char* xch, const SampleSrc& S, bf16* Ob, int op, int tid, int lane, int wave) {
    typedef Cfg<SBK> C;
    constexpr int KS = C::KS, DT = C::DT, KP = C::KPS, VP = C::VP, DV = C::DV;
    constexpr int KTB = 32 * KP, VTB = 32 * VP, WB = (KTB + VTB + 255) & ~255;
    static_assert(8 * WB + DV * 32 * 4 <= RING_BYTES && DV * 32 * 4 <= WB, "sb sample LDS");
    const int r32 = lane & 31, hi = lane >> 5;
    LAS unsigned char* kb = lds + wave * WB; LAS unsigned char* vb = kb + KTB;
    LAS float* part = (LAS float*)(lds + wave * WB);
    LAS float* accum = (LAS float*)(lds + 8 * WB);
    LAS float* st = (LAS float*)xch;
    bf16x8 qf[KS];
#pragma unroll
    for (int ks = 0; ks < KS; ++ks) qf[ks] = *(const bf16x8*)(S.q + (size_t)r32 * S.qp + ks * 16 + hi * 8);
    const int qpos = PASTL + r32;
    const int krow = lane >> 1, kcc = (lane & 1) * 4, vrow = lane >> 2, vcc = (lane & 3) * 2;
    for (int i = tid; i < DV * 32; i += 512) accum[i] = 0.f;
    if (tid < 32) st[256 + tid] = 0.f;
    __syncthreads();
    __builtin_amdgcn_s_waitcnt(0x0F70);
    f32x16 o[DT]; float Ccar;
    bf16x8 pf[2];
    auto compute = [&](int kpos0, bool diag) {
        f32x16 p = qk_sub<KS>(kb, KP, qf, r32, hi);
        const int base = qpos - kpos0 - 4 * hi;
        unsigned vmask = 0xffffu;
        if (diag) { vmask = 0u;
#pragma unroll
            for (int r = 0; r < 16; ++r) vmask |= (((r & 3) + 8 * (r >> 2)) < base ? 1u : 0u) << r; }
        sb_update(p, vmask, Ccar, hi);
        pf[0] = pack8(p, 0); pf[1] = pack8(p, 8);
#pragma unroll
        for (int dt = 0; dt < DT; ++dt)
#pragma unroll
            for (int s = 0; s < 2; ++s) { const bf16x8 vf = v_frag(vb, VP, dt, s, lane); o[dt] = __builtin_amdgcn_mfma_f32_32x32x16_bf16(vf, pf[s], o[dt], 0, 0, 0); }
    };
#pragma unroll 1
    for (int rnd = 0; rnd < 16; ++rnd) {
#pragma unroll
        for (int dt = 0; dt < DT; ++dt)
#pragma unroll
            for (int r = 0; r < 16; ++r) o[dt][r] = 0.f;
        Ccar = 0.f;
        const int s = 128 - 8 * (rnd + 1) + wave;
        const float* kc = (const float*)S.kc + (size_t)(32 * s + krow) * S.kcp + kcc * 8; const float* vc = (const float*)S.vc + (size_t)(32 * s + vrow) * S.vcp + vcc * 8;
        v4u kr[8], vr[8];
#pragma unroll
        for (int i = 0; i < 8; ++i) kr[i] = __builtin_nontemporal_load((const v4u*)kc + i);
#pragma unroll
        for (int hf = 0; hf < 2; ++hf)
#pragma unroll
            for (int i = 0; i < 4; ++i) vr[4 * hf + i] = __builtin_nontemporal_load((const v4u*)(vc + (size_t)16 * hf * S.vcp) + i);
        if (rnd == 0 && wave == 7) {
#pragma unroll
            for (int i = 0; i < 4; ++i) *(LAS v4u*)(kb + krow * KP + (kcc + i) * 16) = *(const v4u*)(S.kn + (size_t)krow * S.knp + (kcc + i) * 8);
#pragma unroll
            for (int hf = 0; hf < 2; ++hf)
#pragma unroll
                for (int i = 0; i < 2; ++i) *(LAS v4u*)(vb + (16 * hf + vrow) * VP + (vcc + i) * 16) = *(const v4u*)(S.vn + (size_t)(16 * hf + vrow) * S.vnp + (vcc + i) * 8);
            compute(PASTL, true);
        }
        auto cvt8 = [&](const v4u& x, const v4u& y) { v4u w; w.x = cvtpk(__uint_as_float(x.x), __uint_as_float(x.y)); w.y = cvtpk(__uint_as_float(x.z), __uint_as_float(x.w));
            w.z = cvtpk(__uint_as_float(y.x), __uint_as_float(y.y)); w.w = cvtpk(__uint_as_float(y.z), __uint_as_float(y.w)); return w; };
#pragma unroll
        for (int i = 0; i < 4; ++i) *(LAS v4u*)(kb + krow * KP + (kcc + i) * 16) = cvt8(kr[2 * i], kr[2 * i + 1]);
#pragma unroll
        for (int hf = 0; hf < 2; ++hf)
#pragma unroll
            for (int i = 0; i < 2; ++i) *(LAS v4u*)(vb + (16 * hf + vrow) * VP + (vcc + i) * 16) = cvt8(vr[4 * hf + 2 * i], vr[4 * hf + 2 * i + 1]);
        compute(32 * s, false);
#pragma unroll
        for (int dt = 0; dt < DT; ++dt)
#pragma unroll
            for (int r = 0; r < 16; ++r) part[(32 * dt + 8 * (r >> 2) + 4 * hi + (r & 3)) * 32 + r32] = o[dt][r];
        if (hi == 0) st[wave * 32 + r32] = Ccar;
        __syncthreads();
        {
            const int q = tid & 31, dg = tid >> 5;
            float car = st[256 + q]; float sc[8];
#pragma unroll
            for (int w = 7; w >= 0; --w) { sc[w] = ex2(car); car += st[w * 32 + q]; }
#pragma unroll
            for (int j = 0; j < 4; ++j) { const int d = dg * 4 + j; float v = accum[d * 32 + q];
#pragma unroll
                for (int w = 0; w < 8; ++w) v += sc[w] * ((LAS const float*)(lds + w * WB))[d * 32 + q];
                accum[d * 32 + q] = v; }
            __syncthreads();
            if (tid < 64) { const bool dd = (tid < 32) ? (car < -160.0f) : true; const bool alld = __all(dd); if (tid < 32) st[256 + q] = car; if (tid == 0) st[320] = alld ? 1.f : 0.f; }
            __syncthreads();
        }
        if (st[320] != 0.f) break;
    }
    {
        const int q = tid & 31, dg = tid >> 5;
        v2u w; w.x = cvtpk(accum[(dg * 4 + 0) * 32 + q], accum[(dg * 4 + 1) * 32 + q]); w.y = cvtpk(accum[(dg * 4 + 2) * 32 + q], accum[(dg * 4 + 3) * 32 + q]);
        *(v2u*)(Ob + (size_t)q * op + dg * 4) = w;
    }
    __syncthreads();
}
}

#ifndef ATT_MASK
#define ATT_MASK 63
#endif
#define ATT_LAMBDA() const float* lv = a->in[IN_LAMBDA] + l * 256; const float p1 = wave_sum(lv[lane] * lv[64 + lane]), p2 = wave_sum(lv[128 + lane] * lv[192 + lane]); \
    const float lam_init = 0.8f - 0.6f * expf(-0.3f * (float)l); const float lam = expf(p1) - expf(p2) + lam_init, oml = 1.0f - lam_init; const float* subg = a->in[IN_SUBLN_G] + l * 128;
#define ATT_SITE() const int wave = wave_in; const int lane = hw_lane(); const int tid = wave * 64 + lane;
#define ATT_POP(qi) if (tid == 0) *slot = __hip_atomic_fetch_add(wq + (qi), 1u, __ATOMIC_RELAXED, __HIP_MEMORY_SCOPE_AGENT); __syncthreads(); const int u = (int)*slot; __syncthreads();
template <int AMASK = ATT_MASK> __device__ __forceinline__ void attn_phase(CArgsP a, int l, LAS unsigned char* lds, unsigned* wq  , int wave_in  ) {
    unsigned char* ws = a->ws;
    const bf16* Z = (const bf16*)(ws + WS_Z); const bf16* Qm = (const bf16*)(ws + WS_Q); const bf16* Km = (const bf16*)(ws + WS_KMLA); const bf16* KNMV = (const bf16*)(ws + WS_KNMV);
    const bf16* KMC = (const bf16*)(ws + WS_KMLAC) + (size_t)l * NCACHE * 768; const bf16* KNMVC = (const bf16*)(ws + WS_KNMVC);
    bf16* Omla = (bf16*)(ws + WS_O); bf16* Osb = Omla + (size_t)kR * 512; bf16* Odiff = Osb + (size_t)kR * 512;
    LAS unsigned char* xch = lds + RING_BYTES;
    LAS volatile unsigned* slot = (LAS volatile unsigned*)(xch + 4096);
    if constexpr (AMASK & 1) { ATT_SITE() ATT_LAMBDA() for (;;) { ATT_POP(0) if (u >= 64) break;
        const int b = u >> 2, h = u & 3, gm = wave >> 2;
        att::SampleSrc S;
        S.kc = a->in[IN_CDK] + ((size_t)l * NCACHE + (size_t)b * PASTL) * 512 + (2 * h + gm) * 64; S.kcp = 512;
        S.vc = a->in[IN_CDV] + ((size_t)l * NCACHE + (size_t)b * PASTL) * 512 + h * 128; S.vcp = 512;
        const bf16* zr = Z + (size_t)(kRP + b * 32) * kZW;
        S.kn = zr + ZC_DK + (2 * h + gm) * 64; S.knp = kZW; S.vn = zr + ZC_DV + h * 128; S.vnp = kZW; S.q = zr + ZC_DQ + (2 * h + gm) * 64; S.qp = kZW;
        const float slope2 = exp2f(-2.0f * (float)(h + 1)) * LOG2E;
        att::sample_unit<att::DIFF>(lds, xch, S, Odiff + (size_t)(kRP + b * 32) * 512 + h * 128, 512, tid, lane, wave, slope2, lam, oml, subg); } }
    if constexpr (AMASK & 4) { ATT_SITE() for (;;) { ATT_POP(5) if (u >= 128) break;
        const int b = u >> 3, h = u & 7;
        att::SampleSrc S;
        S.kc = KMC + (size_t)b * PASTL * 768 + h * 96; S.kcp = 768; S.vc = (const bf16*)(ws + WS_CKVB) + ((size_t)l * NCACHE + (size_t)b * PASTL) * 128; S.vcp = 128;
        S.kn = Km + (size_t)(kRP + b * 32) * 768 + h * 96; S.knp = 768; S.vn = Z + (size_t)(kRP + b * 32) * kZW + ZC_CKV; S.vnp = kZW;
        S.q = Qm + (size_t)(kRP + b * 32) * 768 + h * 96; S.qp = 768;
        att::sample_unit<att::MLA>(lds, xch, S, Omla + (size_t)(kRP + b * 32) * 512 + h * 64, 512, tid, lane, wave, 0.f, 0.f, 0.f, nullptr, a->in[IN_WUV] + (size_t)l * 128 * 512 + h * 64); } }
    if constexpr (AMASK & 2) { ATT_SITE() for (;;) { ATT_POP(4) if (u >= 128) break;
        const int b = u >> 3, h = u & 7;
        att::SampleSrc S;
        S.kc = a->in[IN_CSBK] + ((size_t)l * NCACHE + (size_t)b * PASTL) * 512 + h * 64; S.kcp = 512;
        S.vc = a->in[IN_CSBV] + ((size_t)l * NCACHE + (size_t)b * PASTL) * 512 + h * 64; S.vcp = 512;
        const bf16* zr = Z + (size_t)(kRP + b * 32) * kZW;
        S.kn = zr + ZC_SK + h * 64; S.knp = kZW; S.vn = zr + ZC_SV + h * 64; S.vnp = kZW; S.q = zr + ZC_SQ + h * 64; S.qp = kZW;
        att::sample_unit_sb(lds, xch, S, Osb + (size_t)(kRP + b * 32) * 512 + h * 64, 512, tid, lane, wave); } }
    if constexpr (AMASK & 8) { ATT_SITE() ATT_LAMBDA() for (;;) { ATT_POP(1) if (u >= 512) break;
        const int qb = 15 - (u >> 5), w = u & 31, b = w >> 2, h = w & 3; const bf16* zr = Z + (size_t)(b * 2048) * kZW;
        const float slope2 = exp2f(-2.0f * (float)(h + 1)) * LOG2E;
        att::prompt_unit<att::DIFF>(lds, zr + ZC_DQ + h * 128, kZW, zr + ZC_DK + h * 128, kZW, zr + ZC_DV + h * 128, kZW, Odiff + (size_t)(b * 2048) * 512 + h * 128, 512, qb * 128, tid, lane, wave, slope2, lam, oml, subg); } }
    if constexpr (AMASK & 16) { ATT_SITE() for (;;) { ATT_POP(2) if (u >= 512) break;
        const int qb = 7 - (u >> 6), w = u & 63, b = w >> 3, h = w & 7; const bf16* zr = Z + (size_t)(b * 2048) * kZW;
        att::prompt_unit<att::SBK>(lds, zr + ZC_SQ + h * 64, kZW, zr + ZC_SK + h * 64, kZW, zr + ZC_SV + h * 64, kZW, Osb + (size_t)(b * 2048) * 512 + h * 64, 512, qb * 256, tid, lane, wave, 0.f, 0.f, 0.f, nullptr); } }
    if constexpr (AMASK & 32) { ATT_SITE() for (;;) { ATT_POP(3) if (u >= 512) break;
        const int qb = 7 - (u >> 6), w = u & 63, b = w >> 3, h = w & 7;
        att::prompt_unit<att::MLA>(lds, Qm + (size_t)(b * 2048) * 768 + h * 96, 768, Km + (size_t)(b * 2048) * 768 + h * 96, 768, KNMV + (size_t)(b * 2048) * 1024 + 512 + h * 64, 1024,
                                   Omla + (size_t)(b * 2048) * 512 + h * 64, 512, qb * 256, tid, lane, wave, 0.f, 0.f, 0.f, nullptr); } }
    if (l == 0) { ATT_SITE() LAS float* scr = (LAS float*)(lds + wave * 16384);
        for (;;) { ATT_POP(6) if (u >= p0w::NCHUNK) break;
#pragma unroll 1
            for (int k = 0; k < 8; ++k) { const int it = p0w::CL + u * p0w::CHUNK + k * 8 + wave; if (it < 2 * p0w::CL) p0_weight_item(a, it, scr, lane); } } }
}
namespace sm {
typedef short bf16x8 __attribute__((ext_vector_type(8)));
typedef float f32x16 __attribute__((ext_vector_type(16)));
constexpr int ROW0 = 16384, MROWS = 512, NCOLS = 1024, NTILES = (MROWS / 32) * (NCOLS / 32);
template <int KSTEPS  , class Epi>
__device__ __forceinline__ void small_gemm(LAS unsigned char* lds, const bf16* A, int lda, const bf16* Bt, int K, const Epi& E, int blk, int nblk, int wave, int lane) {
    constexpr int CH = KSTEPS <= 11 ? KSTEPS : KSTEPS / 2; static_assert(KSTEPS <= 11 || KSTEPS % 2 == 0, "k split");
    const int c = lane & 31, hi = lane >> 5;
    LAS float* part = (LAS float*)lds;
    for (int t0 = blk; t0 < NTILES; t0 += 2 * nblk) {
        const int t1 = t0 + nblk; const bool two = t1 < NTILES;
        const int ta = t0, tb = two ? t1 : t0;
        const int m0a = ROW0 + 32 * (ta >> 5), n0a = 32 * (ta & 31), m0b = ROW0 + 32 * (tb >> 5), n0b = 32 * (tb & 31);
        const bf16* apa = A + (size_t)(m0a + c) * lda + wave * (KSTEPS * 16) + hi * 8; const bf16* bpa = Bt + (size_t)(n0a + c) * K + wave * (KSTEPS * 16) + hi * 8;
        const bf16* apb = A + (size_t)(m0b + c) * lda + wave * (KSTEPS * 16) + hi * 8; const bf16* bpb = Bt + (size_t)(n0b + c) * K + wave * (KSTEPS * 16) + hi * 8;
        f32x16 acca = {0.f, 0.f, 0.f, 0.f, 0.f, 0.f, 0.f, 0.f, 0.f, 0.f, 0.f, 0.f, 0.f, 0.f, 0.f, 0.f}, accb = acca;
#pragma unroll
        for (int k0 = 0; k0 < KSTEPS; k0 += CH) {
            bf16x8 afa[CH], bfa[CH], afb[CH], bfb[CH];
#pragma unroll
            for (int j = 0; j < CH; ++j) { afa[j] = *(const bf16x8*)(apa + (k0 + j) * 16); bfa[j] = *(const bf16x8*)(bpa + (k0 + j) * 16);
                                           afb[j] = *(const bf16x8*)(apb + (k0 + j) * 16); bfb[j] = *(const bf16x8*)(bpb + (k0 + j) * 16); }
#pragma unroll
            for (int j = 0; j < CH; ++j) { acca = __builtin_amdgcn_mfma_f32_32x32x16_bf16(bfa[j], afa[j], acca, 0, 0, 0); accb = __builtin_amdgcn_mfma_f32_32x32x16_bf16(bfb[j], afb[j], accb, 0, 0, 0); }
        }
#pragma unroll
        for (int r = 0; r < 16; ++r) { part[(wave * 16 + r) * 64 + lane] = acca[r]; part[8192 + (wave * 16 + r) * 64 + lane] = accb[r]; }
        __syncthreads();
        {
            const int g = wave & 3; const bool second = wave >= 4;
            if (!second || two) {
                LAS const float* pp = part + (second ? 8192 : 0);
                f32x4 v = {0.f, 0.f, 0.f, 0.f};
#pragma unroll
                for (int w = 0; w < 8; ++w)
#pragma unroll
                    for (int i = 0; i < 4; ++i) v[i] += pp[(w * 16 + 4 * g + i) * 64 + lane];
                E(v, (second ? m0b : m0a) + c, (second ? n0b : n0a) + 4 * hi + 8 * g, lane);
            }
        }
        __syncthreads();
    }
}
template <int J> struct EpiBranchS {
    const bf16* Z; bf16* P; bf16* Mb;
    __device__ __forceinline__ void operator()(f32x4 v, int row, int col, int lane) const {
        const v2u gw_ = *(const v2u*)(Z + (size_t)row * pg8::kZW + pg8::ZC_G + J * 1024 + col);
        v[0] *= pg8::fast_sigmoid(bflo(gw_.x)); v[1] *= pg8::fast_sigmoid(bfhi(gw_.x)); v[2] *= pg8::fast_sigmoid(bflo(gw_.y)); v[3] *= pg8::fast_sigmoid(bfhi(gw_.y));
        bf16* pp = P + (size_t)row * 1024 + col;
        if (J >= 1) { const v2u q = *(const v2u*)pp; v[0] += bflo(q.x); v[1] += bfhi(q.x); v[2] += bflo(q.y); v[3] += bfhi(q.y); }
        v2u w; w.x = pk2(v[0], v[1]); w.y = pk2(v[2], v[3]);
        *(v2u*)((J <= 1 ? pp : Mb + (size_t)row * 1024 + col)) = w;
    }
};
struct EpiResS {
    const float* Xr; float* X; bf16* Xb; float* ssq_next;
    __device__ __forceinline__ void operator()(f32x4 v, int row, int col, int lane) const {
        float* xp = X + (size_t)row * 1024 + col;
        v += *(const f32x4*)(Xr + (size_t)row * 1024 + col); *(f32x4*)xp = v;
        if (Xb) { v2u w; w.x = pk2(v[0], v[1]); w.y = pk2(v[2], v[3]); *(v2u*)(Xb + (size_t)row * 1024 + col) = w; }
        if (ssq_next) { float s = (v[0] * v[0] + v[1] * v[1]) + (v[2] * v[2] + v[3] * v[3]); s = half_sum(s); if (lane < 32) __hip_atomic_fetch_add(ssq_next + row, s, __ATOMIC_RELAXED, __HIP_MEMORY_SCOPE_AGENT); }
    }
};
}

#ifndef GEMM_ALIGN
#define GEMM_ALIGN true
#endif
#define GRID_BAR() do { CArgsP ab_ = (CArgsP)__builtin_amdgcn_kernarg_segment_ptr(); asm volatile("" : "+s"(ab_)); unsigned char* wsb_ = ab_->ws; XcdBarrier bar_; bar_.bar = (unsigned*)(wsb_ + WS_CTL) + CW_BAR; bar_.x = xb_xcc_id(); \
    bar_.st = (volatile LAS unsigned*)(lds + MISC_OFF) + 8; xcd_barrier(bar_, wave0 == 0 && hw_lane() == 0); } while (0)
#define FRESH() CArgsP a = (CArgsP)__builtin_amdgcn_kernarg_segment_ptr(); asm volatile("" : "+s"(a)); const int wave = wave0; const int lane = hw_lane(); const int tid = wave * 64 + lane; \
    const int gw = blockIdx.x * NWAVES + wave, NGW = gridDim.x * NWAVES, G = gridDim.x; \
    unsigned char* ws = a->ws; float* ssq = (float*)(ws + WS_CTL) + CW_SSQ; (void)lane; (void)gw; (void)NGW; (void)G; (void)ssq


template <int l> __device__ __forceinline__ void layer_phases(LAS unsigned char* lds, const int wave0) {
        {
            FRESH(); bf16* wl = (bf16*)(ws + WS_W + (size_t)l * WL_SIZE);
            pg8::Gemm g{(const bf16*)(ws + WS_XB), (const bf16*)((unsigned char*)wl + WL_IN), kR, kZW, 1024, 1024}; pg8::StaticOrder S; S.init(kR, kZW, G, (int)blockIdx.x);
            pg8::EpiIn E{(const void __attribute__((address_space(4)))*)a, l, (PG8_LAS float*)(lds + RING_BYTES),
                         WS_Z, WS_CTL + (size_t)(CW_SSQ + 2 * l * kR) * 4, WS_ROPE, WS_KMLA, OUT_PCKV, OUT_SCKV, OUT_PKR, OUT_SKR, OUT_PSBK, OUT_SSBK,
                         N_INPUTS, N_INPUTS + 1, IN_QNG, IN_KVNG, IN_KR_G, IN_DQN_G, IN_DKN_G};
            pg8::gemm_phase<pg8::EpiIn, pg8::StaticOrder, true, true>(lds, g, S, E, tid);
        }
        { FRESH(); bf16* wl = (bf16*)(ws + WS_W + (size_t)l * WL_SIZE);
          pg8::Gemm g{(const bf16*)(ws + WS_CKVB) + (size_t)l * NCACHE * 128, (const bf16*)((unsigned char*)wl + WL_UKV), NCACHE, 512, 128, 128}; typedef pg8::TailOrder<2, (NCACHE / 256) * 2, (kR / 256) * (kZW / 256), 3> KcOrder;   KcOrder S; S.init(G, (int)blockIdx.x);
          pg8::EpiKV E{(bf16*)(ws + WS_KMLAC) + (size_t)l * NCACHE * 768, (bf16*)(ws + WS_KNMVC), a->in[IN_KN_G] + l * 64}; pg8::gemm_phase<pg8::EpiKV, KcOrder, GEMM_ALIGN, true>(lds, g, S, E, tid); }
        GRID_BAR();
        {
            { FRESH(); bf16* wl = (bf16*)(ws + WS_W + (size_t)l * WL_SIZE);
              pg8::Gemm g{(const bf16*)(ws + WS_Z) + ZC_CQ, (const bf16*)((unsigned char*)wl + WL_UQ), kR, 768, 256, kZW}; pg8::StaticOrder S; S.init(kR, 768, G, (int)blockIdx.x);
              pg8::EpiQ E{(bf16*)(ws + WS_Q), a->in[IN_QN_G] + l * 64, a->in[IN_QR_G] + l * 32, (const float*)(ws + WS_ROPE)}; pg8::gemm_phase<pg8::EpiQ, pg8::StaticOrder, GEMM_ALIGN, true>(lds, g, S, E, tid); }
            { FRESH(); bf16* wl = (bf16*)(ws + WS_W + (size_t)l * WL_SIZE);
              pg8::Gemm g{(const bf16*)(ws + WS_Z) + ZC_CKV, (const bf16*)((unsigned char*)wl + WL_UKV), kR, 1024, 128, kZW}; pg8::StaticOrder S; S.init(kR, 1024, G, (int)blockIdx.x);
              pg8::EpiKV E{(bf16*)(ws + WS_KMLA), (bf16*)(ws + WS_KNMV), a->in[IN_KN_G] + l * 64}; pg8::gemm_phase<pg8::EpiKV, pg8::StaticOrder, GEMM_ALIGN, true>(lds, g, S, E, tid); }
        }
        GRID_BAR();
        { FRESH(); attn_phase(a, l, lds, (unsigned*)(ws + WS_CTL) + CW_WQ + 8 * l, wave0); }
        GRID_BAR();
        {
            { FRESH(); bf16* wl = (bf16*)(ws + WS_W + (size_t)l * WL_SIZE);
              pg8::Gemm g{(const bf16*)(ws + WS_O), (const bf16*)((unsigned char*)wl + WL_BR), 3 * kR, 3 * 1024, 512, 512}; pg8::BranchOrder S; S.init(kRP, G, (int)blockIdx.x);
              pg8::EpiBranchAll E{(const bf16*)(ws + WS_Z), (bf16*)(ws + WS_MP), (bf16*)(ws + WS_MB)}; pg8::gemm_phase<pg8::EpiBranchAll, pg8::BranchOrder, GEMM_ALIGN, true>(lds, g, S, E, tid);
              { sm::EpiBranchS<0> Es{(const bf16*)(ws + WS_Z), (bf16*)(ws + WS_MP), (bf16*)(ws + WS_MB)}; sm::small_gemm<4>(lds, g.A, 512, g.Bt, 512, Es, (int)blockIdx.x, G, wave, lane); }
              { sm::EpiBranchS<1> Es{(const bf16*)(ws + WS_Z), (bf16*)(ws + WS_MP), (bf16*)(ws + WS_MB)}; sm::small_gemm<4>(lds, g.A + (size_t)kR * 512, 512, g.Bt + (size_t)1024 * 512, 512, Es, (int)blockIdx.x, G, wave, lane); }
              { sm::EpiBranchS<2> Es{(const bf16*)(ws + WS_Z), (bf16*)(ws + WS_MP), (bf16*)(ws + WS_MB)}; sm::small_gemm<4>(lds, g.A + (size_t)2 * kR * 512, 512, g.Bt + (size_t)2 * 1024 * 512, 512, Es, (int)blockIdx.x, G, wave, lane); } }
        }
        GRID_BAR();
        {
            FRESH(); bf16* wl = (bf16*)(ws + WS_W + (size_t)l * WL_SIZE);
            pg8::Gemm g{(const bf16*)(ws + WS_MB), (const bf16*)((unsigned char*)wl + WL_OUT), kRP, 1024, 1024, 1024}; pg8::StaticOrder S; S.init(kRP, 1024, G, (int)blockIdx.x);
            pg8::EpiRes E{l == 0 ? a->in[IN_XP] : (const float*)a->out, a->out, (bf16*)(ws + WS_XB), ssq + (2 * l + 1) * kR};
            pg8::gemm_phase<pg8::EpiRes, pg8::StaticOrder, GEMM_ALIGN, true>(lds, g, S, E, tid);
            sm::EpiResS Es{l == 0 ? a->in[IN_XS] - (size_t)kRP * 1024 : (const float*)a->out, a->out, (bf16*)(ws + WS_XB), ssq + (2 * l + 1) * kR}; sm::small_gemm<8>(lds, g.A, 1024, g.Bt, 1024, Es, (int)blockIdx.x, G, wave, lane);
        }
        GRID_BAR();
        {
            FRESH(); bf16* wl = (bf16*)(ws + WS_W + (size_t)l * WL_SIZE);
            pg8::Gemm g{(const bf16*)(ws + WS_XB) - 2 * 1024, (const bf16*)((unsigned char*)wl + WL_UP), 67 * 256, 5632, 1024, 1024, 254}; pg8::StaticOrder S; S.init(67 * 256, 5632, G, (int)blockIdx.x);
            pg8::EpiUpConv E{(bf16*)(ws + WS_ACT), ssq + (2 * l + 1) * kR, a->in[IN_CONVW] + (size_t)l * 3 * DFF, a->in[IN_CONVB] + (size_t)l * DFF, a->in[IN_CONV] + (size_t)l * 16 * 2 * DFF, a->out,
                             OUT_PCONV + (size_t)l * 8 * 2 * DFF, OUT_SCONV + (size_t)l * 16 * 2 * DFF, (PG8_LAS float*)(lds + RING_BYTES)};
            pg8::gemm_phase<pg8::EpiUpConv, pg8::StaticOrder, true, true>(lds, g, S, E, tid);
        }
        GRID_BAR();
        {
            FRESH(); bf16* wl = (bf16*)(ws + WS_W + (size_t)l * WL_SIZE);
            pg8::Gemm g{(const bf16*)(ws + WS_ACT), (const bf16*)((unsigned char*)wl + WL_DOWN), kRP, 1024, DFF, DFF}; pg8::StaticOrder S; S.init(kRP, 1024, G, (int)blockIdx.x);
            pg8::EpiRes E{a->out, a->out, l == 0 ? (bf16*)(ws + WS_XB) : nullptr, l == 0 ? ssq + 2 * kR : nullptr};
            pg8::gemm_phase<pg8::EpiRes, pg8::StaticOrder, GEMM_ALIGN, true>(lds, g, S, E, tid);
            sm::EpiResS Es{a->out, a->out, l == 0 ? (bf16*)(ws + WS_XB) : nullptr, l == 0 ? ssq + 2 * kR : nullptr}; sm::small_gemm<22>(lds, g.A, DFF, g.Bt, DFF, Es, (int)blockIdx.x, G, wave, lane);
        }
}

__global__ void __launch_bounds__(512, 2) k_mega(Args a_) {
    extern __shared__ __attribute__((aligned(16))) unsigned char lds_[];
    LAS unsigned char* lds = (LAS unsigned char*)lds_;
    const int wave0 = __builtin_amdgcn_readfirstlane((int)threadIdx.x >> 6);
    {
        volatile LAS unsigned* MISC0 = (volatile LAS unsigned*)(lds + MISC_OFF);
        if (wave0 == 0) { const int l0 = hw_lane(); if (l0 < 32) MISC0[l0] = 0u; }
        __syncthreads();
    }
    (void)xcd_barrier_post((unsigned*)(a_.ws + WS_CTL) + CW_BAR, (volatile LAS unsigned*)(lds + MISC_OFF) + 8, wave0 == 0 && hw_lane() == 0);
    { FRESH(); p0_phase(a, lds, gw, NGW, wave, lane); }
    GRID_BAR();
    layer_phases<0>(lds, wave0);
    GRID_BAR();
    layer_phases<1>(lds, wave0);
}

extern "C" void kernel_launch(void* const* d_in, const int* in_sizes, int n_in, void* d_out, int out_size, void* d_ws, size_t ws_size, hipStream_t stream) {
    static int grid = 0;
    if (grid == 0) {
        int dev = 0, cus = 0, per_cu = 0;
        if (hipGetDevice(&dev) != hipSuccess || hipDeviceGetAttribute(&cus, hipDeviceAttributeMultiprocessorCount, dev) != hipSuccess) { fprintf(stderr, "kernel_launch: device query failed\n"); grid = -1; return; }
        if (hipFuncSetAttribute((const void*)k_mega, hipFuncAttributeMaxDynamicSharedMemorySize, LDS_BYTES) != hipSuccess) { fprintf(stderr, "kernel_launch: hipFuncSetAttribute failed\n"); grid = -1; return; }
        if (hipOccupancyMaxActiveBlocksPerMultiprocessor(&per_cu, (const void*)k_mega, 512, LDS_BYTES) != hipSuccess || per_cu < 1) { fprintf(stderr, "kernel_launch: occupancy query reports %d blocks per CU\n", per_cu); per_cu = 1; }
        (void)hipGetLastError();
        grid = cus;
    }
    if (grid < 0) return;
    static_assert(WS_FAST_END <= (size_t)1374208512, "workspace");
    if (hipMemsetAsync((char*)d_ws + WS_CTL, 0, CTL_ZERO_BYTES, stream) != hipSuccess) return;
    Args a{};
    for (int i = 0; i < N_INPUTS; ++i) a.in[i] = (const float*)d_in[i];
    a.out = (float*)d_out; a.ws = (unsigned char*)d_ws; a.layer = 0; a.pad = 0;
    hipLaunchKernelGGL(k_mega, dim3(grid), dim3(512), LDS_BYTES, stream, a);
}
```

```cpp
#include <hip/hip_runtime.h>
#include <math.h>
#include <cstdio>
#include <cstdint>
__device__ __forceinline__ int hw_lane() { int l; asm volatile("v_mbcnt_lo_u32_b32 %0, -1, 0\n\tv_mbcnt_hi_u32_b32 %0, -1, %0" : "=v"(l)); return l; }
template <int M> __device__ __forceinline__ float sw_xor(float v) { return __builtin_bit_cast(float, __builtin_amdgcn_ds_swizzle(__builtin_bit_cast(int, v), 0x1f | (M << 10))); }
__device__ __forceinline__ float half_sum(float v) { const unsigned u = __builtin_bit_cast(unsigned, v); auto rr = __builtin_amdgcn_permlane32_swap(u, u, false, false); return __builtin_bit_cast(float, (unsigned)rr[0]) + __builtin_bit_cast(float, (unsigned)rr[1]); }
__device__ __forceinline__ float half_max(float v) { const unsigned u = __builtin_bit_cast(unsigned, v); auto rr = __builtin_amdgcn_permlane32_swap(u, u, false, false); return fmaxf(__builtin_bit_cast(float, (unsigned)rr[0]), __builtin_bit_cast(float, (unsigned)rr[1])); }
__device__ __forceinline__ float half_other(float v, int hi) { const unsigned u = __builtin_bit_cast(unsigned, v); auto rr = __builtin_amdgcn_permlane32_swap(u, u, false, false); return __builtin_bit_cast(float, (unsigned)(hi ? rr[0] : rr[1])); }
namespace pg8 {
#define PG8_LAS __attribute__((address_space(3)))
typedef unsigned short bf16_t;
typedef short bf16x8 __attribute__((ext_vector_type(8)));
typedef float f32x4 __attribute__((ext_vector_type(4)));
typedef unsigned u32x4 __attribute__((ext_vector_type(4)));
constexpr int BM = 256, BK = 64, HALF = 128, HTB = HALF * BK * 2  , STAGE_BYTES = 8 * HTB, NXCD = 8, WGM = 8;

__host__ __device__ __forceinline__ int lds_byte(int r, int c) { const int st = (r >> 4) * 2 + (c >> 5), rr = r & 15, cc = c & 31, ob = rr * 64 + cc * 2; return st * 1024 + (ob ^ (((ob >> 9) & 1) << 5)); }
__host__ __device__ __forceinline__ void stage_rc(int b, int& R, int& C) { const int st = b / 1024, sb = b % 1024, swz = sb ^ (((sb >> 9) & 1) << 5); R = (st >> 1) * 16 + swz / 64; C = (st & 1) * 32 + (swz % 64) / 2; }
__host__ __device__ __forceinline__ int perm32(int rho) { const int n = rho >> 4, i = rho & 15; return 8 * (i >> 2) + 4 * n + (i & 3); }

struct Unit { int pm, pn; };
struct Gemm { const bf16_t* A; const bf16_t* Bt; int M, N, K, lda; int prows = 256; };

struct StaticOrder {
    int nM, nN, nwg, G, c;
    __host__ __device__ void init(int M, int N, int G_, int c_) { nM = M / BM; nN = N / BM; nwg = nM * nN; G = G_; c = c_; }
    __host__ __device__ bool next(int i, Unit& u) const {
        const long L = (long)i * G + c; if (L >= nwg) return false;
        int wgid = (int)L; { const int q = nwg / NXCD, r = nwg % NXCD, xcd = wgid % NXCD, off = wgid / NXCD; wgid = (xcd < r ? xcd * (q + 1) : r * (q + 1) + (xcd - r) * q) + off; }
        const int nig = WGM * nN, gid = wgid / nig, fm = gid * WGM, gsz = (nM - fm) < WGM ? (nM - fm) : WGM;
        u.pm = fm + ((wgid % nig) % gsz); u.pn = (wgid % nig) / gsz; return true;
    }
    __device__ __forceinline__ void a_ready(const Unit&) const {}
    __device__ __forceinline__ void done(const Unit&) const {}
};

struct BranchOrder {
    StaticOrder S;
    __host__ __device__ void init(int M, int G_, int c_) { S.init(M, 1024, G_, c_); }
    __host__ __device__ bool next(int i, Unit& u) const { Unit t; const int j = i % 3; if (!S.next(i / 3, t)) return false; u.pm = 66 * j + t.pm; u.pn = 4 * j + t.pn; return true; }
    __device__ __forceinline__ void a_ready(const Unit&) const {}
    __device__ __forceinline__ void done(const Unit&) const {}
};
template <int NN  , int NWG  , int FIRST  , int E> struct TailOrder {
    int G, c, rem, e;
    __host__ __device__ void init(int G_, int c_) { G = G_; c = c_; rem = FIRST % G_; e = rem ? E : 0; }
    __host__ __device__ bool next(int i, Unit& u) const {
        const int extra = (G - rem) * e; int L;
        if (c >= rem) L = i < e ? (c - rem) * e + i : extra + (i - e) * G + c; else L = extra + i * G + c;
        if (L >= NWG) return false; u.pm = L / NN; u.pn = L % NN; return true; }
    __device__ __forceinline__ void a_ready(const Unit&) const {}
    __device__ __forceinline__ void done(const Unit&) const {}
};
struct SubOrder {
    StaticOrder S; int pn0;
    __host__ __device__ void init(int M, int ntn, int pn0_, int G_, int c_) { S.init(M, ntn * BM, G_, c_); pn0 = pn0_; }
    __host__ __device__ bool next(int i, Unit& u) const { const bool ok = S.next(i, u); u.pn += pn0; return ok; }
    __device__ __forceinline__ void a_ready(const Unit&) const {}
    __device__ __forceinline__ void done(const Unit&) const {}
};

__device__ __forceinline__ unsigned cvt_pk_bf16(float lo, float hi) { unsigned r; asm volatile("v_cvt_pk_bf16_f32 %0, %1, %2" : "=v"(r) : "v"(lo), "v"(hi)); return r; }
constexpr int kR = 16896, kRP = 16384, kRS = 512, kZW = 6656;
constexpr int ZC_CQ = 0, ZC_CKV = 256, ZC_KR = 384, ZC_SQ = 512, ZC_SK = 1024, ZC_SV = 1536, ZC_DQ = 2048, ZC_DK = 2560, ZC_DV = 3072, ZC_G = 3584;
constexpr float kEPS = 1e-6f;
typedef float f32x2 __attribute__((ext_vector_type(2)));
__device__ __forceinline__ float bf_lo(unsigned w) { return __uint_as_float(w << 16); }
__device__ __forceinline__ float bf_hi(unsigned w) { return __uint_as_float(w & 0xffff0000u); }
__device__ __forceinline__ float fast_sigmoid(float x) { return __builtin_amdgcn_rcpf(1.0f + __expf(-x)); }

#ifndef EPI_SC1
#define EPI_SC1 0
#endif
template <class T> __device__ __forceinline__ void st16(const void __attribute__((address_space(1)))* p, T v) {
#if EPI_SC1
    asm volatile("global_store_dwordx4 %0, %1, off sc1" :: "v"(p), "v"(v));
#else
    *(T __attribute__((address_space(1)))*)p = v;
#endif
}
template <class T> __device__ __forceinline__ void st16(const void* p, T v) { st16((const void __attribute__((address_space(1)))*)p, v); }
__device__ __forceinline__ void epi_bar() { asm volatile("s_waitcnt lgkmcnt(0)" ::: "memory"); __builtin_amdgcn_s_barrier(); asm volatile("" ::: "memory"); }
__device__ __forceinline__ float sq8(const f32x4& a, const f32x4& b) { return (a[0] * a[0] + a[1] * a[1]) + (a[2] * a[2] + a[3] * a[3]) + (b[0] * b[0] + b[1] * b[1]) + (b[2] * b[2] + b[3] * b[3]); }
__device__ __forceinline__ u32x4 pack8f(const f32x4& a, const f32x4& b) { u32x4 w; w.x = cvt_pk_bf16(a[0], a[1]); w.y = cvt_pk_bf16(a[2], a[3]); w.z = cvt_pk_bf16(b[0], b[1]); w.w = cvt_pk_bf16(b[2], b[3]); return w; }
constexpr float kQS64 = 0.125f * 1.4426950408889634f, kQSMLA = 0.10206207261596577f * 1.4426950408889634f;

__device__ __forceinline__ void rope_cs4(int pos, int j0, f32x4& c, f32x4& s) {
#pragma unroll
    for (int i = 0; i < 4; ++i) { const float invrev = __builtin_amdgcn_exp2f(-(float)(j0 + i) * (13.287712379549449f / 16.0f)) * 0.15915494309189535f;
        const float ph = __builtin_amdgcn_fractf((float)pos * invrev); c[i] = __builtin_amdgcn_cosf(ph); s[i] = __builtin_amdgcn_sinf(ph); }
}
struct EpiIn {
    static constexpr bool PERM = true, AFTER_DRAIN = false;
    const void __attribute__((address_space(4)))* kargs; int layer; PG8_LAS float* xs;
    size_t ws_z, ws_ssq, ws_rope, ws_kmla;
    size_t off_p_ckv, off_s_ckv, off_p_kr, off_s_kr, off_p_sbk, off_s_sbk;
    int i_out, i_ws, i_qng, i_kvng, i_krg, i_dqg, i_dkg;
    __device__ __forceinline__ void operator()(const f32x4 (&acc)[2][2][4][2], const Unit& u, int wr, int wc, int fr_in, int fq_in) const {
        const int ln_ = hw_lane(); const int fr = ln_ & 15, fq = ln_ >> 4; (void)fr_in; (void)fq_in;
        const void __attribute__((address_space(4)))* ka = kargs; asm volatile("" : "+s"(ka));
        typedef const unsigned long long __attribute__((address_space(4)))* KP_;
#define EPI_G __attribute__((address_space(1)))
#define EPI_ARG(T, i) ((T EPI_G*)(((KP_)ka)[i]))
        unsigned char EPI_G* wsb = EPI_ARG(unsigned char, i_ws); float EPI_G* out = EPI_ARG(float, i_out);
        bf16_t EPI_G* Z = (bf16_t EPI_G*)(wsb + ws_z); const float EPI_G* ssq = (const float EPI_G*)(wsb + ws_ssq);
        const int pn = u.pn; const bool prompt = u.pm < 64;
        const int row0 = u.pm * BM + wr * 64 + fr, col0 = pn * BM + wc * 64 + 8 * fq;
        const size_t nrows = prompt ? (size_t)kRP : (size_t)kRS;
        float rs[2][4];
#pragma unroll
        for (int ai = 0; ai < 2; ++ai)
#pragma unroll
            for (int m = 0; m < 4; ++m) rs[ai][m] = __hip_atomic_load(ssq + row0 + ai * HALF + m * 16, __ATOMIC_RELAXED, __HIP_MEMORY_SCOPE_AGENT);
#pragma unroll
        for (int ai = 0; ai < 2; ++ai)
#pragma unroll
            for (int m = 0; m < 4; ++m) rs[ai][m] = rsqrtf(rs[ai][m] * (1.0f / 1024.0f) + kEPS);
        if (pn >= 14 || pn == 2 || pn == 3) {
            const float sc = pn < 14 ? kQS64 : 1.0f;
#pragma unroll
            for (int ai = 0; ai < 2; ++ai)
#pragma unroll
                for (int m = 0; m < 4; ++m) { const int row = row0 + ai * HALF + m * 16; const float r_ = rs[ai][m] * sc;
#pragma unroll
                    for (int bj = 0; bj < 2; ++bj) st16((Z + (size_t)row * kZW + col0 + 32 * bj), pack8f(acc[ai][bj][m][0] * r_, acc[ai][bj][m][1] * r_)); }
        } else if ((pn >= 4 && pn < 8) || pn == 12 || pn == 13) {
            const int sel = pn < 6 ? 0 : (pn < 8 ? 1 : 3);
            float EPI_G* fdst = out + (prompt ? off_p_sbk : off_s_sbk) + ((size_t)sel * 2 + layer) * nrows * 512 + (pn & 1) * 256 + wc * 64 + 8 * fq;
#pragma unroll
            for (int ai = 0; ai < 2; ++ai)
#pragma unroll
                for (int m = 0; m < 4; ++m) { const int row = row0 + ai * HALF + m * 16; const int orow = prompt ? row : row - kRP; const float r_ = rs[ai][m];
#pragma unroll
                    for (int bj = 0; bj < 2; ++bj) { const f32x4 v0 = acc[ai][bj][m][0] * r_, v1 = acc[ai][bj][m][1] * r_;
                        st16((Z + (size_t)row * kZW + col0 + 32 * bj), pack8f(v0, v1));
                        float EPI_G* fp = fdst + (size_t)orow * 512 + 32 * bj; st16(fp, v0); st16((fp + 4), v1); } }
        } else if (pn >= 8 && pn < 12) {
            const bool isq = pn < 10; const float EPI_G* g = (isq ? EPI_ARG(const float, i_dqg) + layer * 64 : EPI_ARG(const float, i_dkg) + layer * 64); const float sc = isq ? kQS64 : 1.0f;
            f32x4 g0[2][2];
#pragma unroll
            for (int bj = 0; bj < 2; ++bj) { g0[bj][0] = *(const f32x4 EPI_G*)(g + 32 * bj + 8 * fq); g0[bj][1] = *(const f32x4 EPI_G*)(g + 32 * bj + 8 * fq + 4); }
            float EPI_G* fdst = out + (prompt ? off_p_sbk : off_s_sbk) + ((size_t)2 * 2 + layer) * nrows * 512 + (pn & 1) * 256 + wc * 64 + 8 * fq;
#pragma unroll
            for (int ai = 0; ai < 2; ++ai)
#pragma unroll
                for (int m = 0; m < 4; ++m) { const int row = row0 + ai * HALF + m * 16; const int orow = prompt ? row : row - kRP; const float r_ = rs[ai][m];
                    f32x4 v[2][2]; float s = 0.f;
#pragma unroll
                    for (int bj = 0; bj < 2; ++bj) { v[bj][0] = acc[ai][bj][m][0] * r_; v[bj][1] = acc[ai][bj][m][1] * r_; s += sq8(v[bj][0], v[bj][1]); }
                    s += sw_xor<16>(s); s = half_sum(s);
                    const float rn = rsqrtf(s * (1.0f / 64.0f) + kEPS) * sc;
#pragma unroll
                    for (int bj = 0; bj < 2; ++bj) { const f32x4 w0 = v[bj][0] * rn * g0[bj][0], w1 = v[bj][1] * rn * g0[bj][1];
                        st16((Z + (size_t)row * kZW + col0 + 32 * bj), pack8f(w0, w1));
                        if (!isq) { float EPI_G* fp = fdst + (size_t)orow * 512 + 32 * bj; st16(fp, w0); st16((fp + 4), w1); } } }
        } else {
            PG8_LAS unsigned char* xsb = (PG8_LAS unsigned char*)xs + (wr * 64 + fr) * 16;
            float sown[2][4];
#pragma unroll
            for (int ai = 0; ai < 2; ++ai)
#pragma unroll
                for (int m = 0; m < 4; ++m) { const float r_ = rs[ai][m]; float s = 0.f;
#pragma unroll
                    for (int bj = 0; bj < 2; ++bj) s += sq8(acc[ai][bj][m][0] * r_, acc[ai][bj][m][1] * r_);
                    s += sw_xor<16>(s); s = half_sum(s); sown[ai][m] = s;
                    if (fq == 0) *(PG8_LAS float*)(xsb + (ai * HALF + m * 16) * 16 + wc * 4) = s; }
            epi_bar();
            if (pn == 0) {
                const float EPI_G* qng = EPI_ARG(const float, i_qng) + layer * 256;
                f32x4 g0[2][2];
#pragma unroll
                for (int bj = 0; bj < 2; ++bj) { g0[bj][0] = *(const f32x4 EPI_G*)(qng + wc * 64 + 32 * bj + 8 * fq); g0[bj][1] = *(const f32x4 EPI_G*)(qng + wc * 64 + 32 * bj + 8 * fq + 4); }
#pragma unroll
                for (int ai = 0; ai < 2; ++ai)
#pragma unroll
                    for (int m = 0; m < 4; ++m) { const int rl = ai * HALF + wr * 64 + m * 16 + fr; const int row = u.pm * BM + rl;
                        const f32x4 pp = *(const PG8_LAS f32x4*)(xsb + (ai * HALF + m * 16) * 16); const float rn = rsqrtf(((pp[0] + pp[1]) + (pp[2] + pp[3])) * (1.0f / 256.0f) + kEPS) * rs[ai][m];
#pragma unroll
                        for (int bj = 0; bj < 2; ++bj) st16((Z + (size_t)row * kZW + col0 + 32 * bj), pack8f(acc[ai][bj][m][0] * rn * g0[bj][0], acc[ai][bj][m][1] * rn * g0[bj][1])); }
            } else if (wc < 2) {
                const float EPI_G* kvng = EPI_ARG(const float, i_kvng) + layer * 128;
                f32x4 g0[2][2];
#pragma unroll
                for (int bj = 0; bj < 2; ++bj) { g0[bj][0] = *(const f32x4 EPI_G*)(kvng + wc * 64 + 32 * bj + 8 * fq); g0[bj][1] = *(const f32x4 EPI_G*)(kvng + wc * 64 + 32 * bj + 8 * fq + 4); }
                float EPI_G* fdst = out + (prompt ? off_p_ckv : off_s_ckv) + (size_t)layer * nrows * 128 + wc * 64 + 8 * fq;
#pragma unroll
                for (int ai = 0; ai < 2; ++ai)
#pragma unroll
                    for (int m = 0; m < 4; ++m) { const int rl = ai * HALF + wr * 64 + m * 16 + fr; const int row = u.pm * BM + rl; const int orow = prompt ? row : row - kRP;
                        const f32x2 pq = *(const PG8_LAS f32x2*)(xsb + (ai * HALF + m * 16) * 16); const float rn = rsqrtf((pq[0] + pq[1]) * (1.0f / 128.0f) + kEPS) * rs[ai][m];
#pragma unroll
                        for (int bj = 0; bj < 2; ++bj) { const f32x4 w0 = acc[ai][bj][m][0] * rn * g0[bj][0], w1 = acc[ai][bj][m][1] * rn * g0[bj][1];
                            st16((Z + (size_t)row * kZW + col0 + 32 * bj), pack8f(w0, w1));
                            float EPI_G* fp = fdst + (size_t)orow * 128 + 32 * bj; st16(fp, w0); st16((fp + 4), w1); } }
            } else if (wc == 2) {
                const float EPI_G* krg = EPI_ARG(const float, i_krg) + layer * 32; const float EPI_G* rope = (const float EPI_G*)(wsb + ws_rope); bf16_t EPI_G* Kmla = (bf16_t EPI_G*)(wsb + ws_kmla);
                const f32x4 g0 = *(const f32x4 EPI_G*)(krg + 8 * fq), g1 = *(const f32x4 EPI_G*)(krg + 8 * fq + 4);
                float EPI_G* fdst = out + (prompt ? off_p_kr : off_s_kr) + (size_t)layer * nrows * 32 + 8 * fq;
                const bool up = fq >= 2;
#pragma unroll
                for (int ai = 0; ai < 2; ++ai)
#pragma unroll
                    for (int m = 0; m < 4; ++m) { const int row = row0 + ai * HALF + m * 16; const int orow = prompt ? row : row - kRP; const float r_ = rs[ai][m];
                        float s = sq8(acc[ai][0][m][0], acc[ai][0][m][1]) * (r_ * r_); s += sw_xor<16>(s); s = half_sum(s);
                        const float rn = rsqrtf(s * (1.0f / 32.0f) + kEPS) * r_;
                        const int pos = prompt ? (row & 2047) : 4096 + ((row - kRP) & 31);
                        float EPI_G* fp = fdst + (size_t)orow * 32;
                        f32x4 oo[2];
#pragma unroll
                        for (int n = 0; n < 2; ++n) {
                            const f32x4 v = acc[ai][0][m][n] * rn * (n == 0 ? g0 : g1);
                            f32x4 cc, ss; rope_cs4(pos, 8 * (fq & 1) + 4 * n, cc, ss);
#pragma unroll
                            for (int i = 0; i < 4; ++i) { const float pp = half_other(v[i], up ? 1 : 0);
                                oo[n][i] = up ? (pp * ss[i] + v[i] * cc[i]) : (v[i] * cc[i] - pp * ss[i]); }
                            st16((fp + 4 * n), oo[n]);
                        }
                        const u32x4 w = pack8f(oo[0], oo[1]);
                        st16((Z + (size_t)row * kZW + ZC_KR + 8 * fq), w);
#pragma unroll
                        for (int h = 0; h < 8; ++h) st16((Kmla + (size_t)row * 768 + h * 96 + 64 + 8 * fq), w);
                        asm volatile("" ::: "memory"); }
            }
            epi_bar();
        }
#undef EPI_ARG
#undef EPI_G
    }
};

struct EpiQ {
    static constexpr bool PERM = true, AFTER_DRAIN = false;
    bf16_t* Q; const float *qng, *qrg; const float* rope;
    __device__ __forceinline__ void operator()(const f32x4 (&acc)[2][2][4][2], const Unit& u, int wr, int wc, int fr_in, int fq_in) const {
        const int ln_ = hw_lane(); const int fr = ln_ & 15, fq = ln_ >> 4; (void)fr_in; (void)fq_in;
        const int row0 = u.pm * BM + wr * 64 + fr;
        if (u.pn < 2) {
            const int head = 4 * u.pn + wc;
            f32x4 g0[2][2];
#pragma unroll
            for (int bj = 0; bj < 2; ++bj) { g0[bj][0] = *(const f32x4*)(qng + 32 * bj + 8 * fq); g0[bj][1] = *(const f32x4*)(qng + 32 * bj + 8 * fq + 4); }
#pragma unroll
            for (int ai = 0; ai < 2; ++ai)
#pragma unroll
                for (int m = 0; m < 4; ++m) { const int row = row0 + ai * HALF + m * 16;
                    float s = sq8(acc[ai][0][m][0], acc[ai][0][m][1]) + sq8(acc[ai][1][m][0], acc[ai][1][m][1]); s += sw_xor<16>(s); s = half_sum(s);
                    const float rn = rsqrtf(s * (1.0f / 64.0f) + kEPS) * kQSMLA;
#pragma unroll
                    for (int bj = 0; bj < 2; ++bj) st16((Q + (size_t)row * 768 + head * 96 + 32 * bj + 8 * fq), pack8f(acc[ai][bj][m][0] * rn * g0[bj][0], acc[ai][bj][m][1] * rn * g0[bj][1])); }
        } else {
            const f32x4 g0 = *(const f32x4*)(qrg + 8 * fq), g1 = *(const f32x4*)(qrg + 8 * fq + 4);
            const bool up = fq >= 2;
#pragma unroll
            for (int ai = 0; ai < 2; ++ai)
#pragma unroll
                for (int m = 0; m < 4; ++m) { const int row = row0 + ai * HALF + m * 16;
                    const int pos = row < kRP ? (row & 2047) : 4096 + ((row - kRP) & 31);
                    f32x4 c0, c1, s0, s1; rope_cs4(pos, 8 * (fq & 1), c0, s0); rope_cs4(pos, 8 * (fq & 1) + 4, c1, s1);
#pragma unroll
                    for (int bj = 0; bj < 2; ++bj) { const int head = 2 * wc + bj;
                        f32x4 v0 = acc[ai][bj][m][0], v1 = acc[ai][bj][m][1];
                        float s = sq8(v0, v1); s += sw_xor<16>(s); s = half_sum(s);
                        const float rn = rsqrtf(s * (1.0f / 32.0f) + kEPS); v0 = v0 * rn * g0; v1 = v1 * rn * g1;
                        f32x4 o0, o1;
#pragma unroll
                        for (int i = 0; i < 4; ++i) { const float p0 = half_other(v0[i], up ? 1 : 0), p1 = half_other(v1[i], up ? 1 : 0);
                            o0[i] = (up ? (p0 * s0[i] + v0[i] * c0[i]) : (v0[i] * c0[i] - p0 * s0[i])) * kQSMLA;
                            o1[i] = (up ? (p1 * s1[i] + v1[i] * c1[i]) : (v1[i] * c1[i] - p1 * s1[i])) * kQSMLA; }
                        st16((Q + (size_t)row * 768 + head * 96 + 64 + 8 * fq), pack8f(o0, o1)); } }
        }
    }
};

struct EpiKV {
    static constexpr bool PERM = true, AFTER_DRAIN = false;
    bf16_t* Kmla; bf16_t* V; const float* kng;
    __device__ __forceinline__ void operator()(const f32x4 (&acc)[2][2][4][2], const Unit& u, int wr, int wc, int fr_in, int fq_in) const {
        const int ln_ = hw_lane(); const int fr = ln_ & 15, fq = ln_ >> 4; (void)fr_in; (void)fq_in;
        const int row0 = u.pm * BM + wr * 64 + fr;
        if (u.pn < 2) {
            const int head = 4 * u.pn + wc;
            f32x4 g0[2][2];
#pragma unroll
            for (int bj = 0; bj < 2; ++bj) { g0[bj][0] = *(const f32x4*)(kng + 32 * bj + 8 * fq); g0[bj][1] = *(const f32x4*)(kng + 32 * bj + 8 * fq + 4); }
#pragma unroll
            for (int ai = 0; ai < 2; ++ai)
#pragma unroll
                for (int m = 0; m < 4; ++m) { const int row = row0 + ai * HALF + m * 16;
                    float s = sq8(acc[ai][0][m][0], acc[ai][0][m][1]) + sq8(acc[ai][1][m][0], acc[ai][1][m][1]); s += sw_xor<16>(s); s = half_sum(s);
                    const float rn = rsqrtf(s * (1.0f / 64.0f) + kEPS);
#pragma unroll
                    for (int bj = 0; bj < 2; ++bj) st16((Kmla + (size_t)row * 768 + head * 96 + 32 * bj + 8 * fq), pack8f(acc[ai][bj][m][0] * rn * g0[bj][0], acc[ai][bj][m][1] * rn * g0[bj][1])); }
        } else {
#pragma unroll
            for (int ai = 0; ai < 2; ++ai)
#pragma unroll
                for (int m = 0; m < 4; ++m) { const int row = row0 + ai * HALF + m * 16;
#pragma unroll
                    for (int bj = 0; bj < 2; ++bj) st16((V + (size_t)row * 1024 + u.pn * BM + wc * 64 + 32 * bj + 8 * fq), pack8f(acc[ai][bj][m][0], acc[ai][bj][m][1])); }
        }
    }
};

struct EpiPlain {
    static constexpr bool PERM = true, AFTER_DRAIN = false;
    bf16_t* O; int ldc; const float* ssq;
    __device__ __forceinline__ void operator()(const f32x4 (&acc)[2][2][4][2], const Unit& u, int wr, int wc, int fr_in, int fq_in) const {
        const int ln_ = hw_lane(); const int fr = ln_ & 15, fq = ln_ >> 4; (void)fr_in; (void)fq_in;
        const int row0 = u.pm * BM + wr * 64 + fr, col0 = u.pn * BM + wc * 32 + 8 * fq;
#pragma unroll
        for (int ai = 0; ai < 2; ++ai)
#pragma unroll
            for (int m = 0; m < 4; ++m) {
                const int row = row0 + ai * HALF + m * 16;
                const float rs = ssq ? rsqrtf(__hip_atomic_load(ssq + row, __ATOMIC_RELAXED, __HIP_MEMORY_SCOPE_AGENT) * (1.0f / 1024.0f) + kEPS) : 1.0f;
                bf16_t* op = O + (size_t)row * ldc + col0;
#pragma unroll
                for (int bj = 0; bj < 2; ++bj) {
                    const f32x4 v0 = acc[ai][bj][m][0] * rs, v1 = acc[ai][bj][m][1] * rs;
                    u32x4 w; w.x = cvt_pk_bf16(v0[0], v0[1]); w.y = cvt_pk_bf16(v0[2], v0[3]); w.z = cvt_pk_bf16(v1[0], v1[1]); w.w = cvt_pk_bf16(v1[2], v1[3]);
                    st16((op + bj * HALF), w);
                }
            }
    }
};

template <int J> struct EpiBranch {
    static constexpr bool PERM = true, AFTER_DRAIN = false;
    const bf16_t* Z; bf16_t* P; bf16_t* Mb;
    __device__ __forceinline__ void operator()(const f32x4 (&acc)[2][2][4][2], const Unit& u, int wr, int wc, int fr_in, int fq_in) const {
        const int ln_ = hw_lane(); const int fr = ln_ & 15, fq = ln_ >> 4; (void)fr_in; (void)fq_in;
        const int row0 = u.pm * BM + wr * 64 + fr, col0 = u.pn * BM + wc * 32 + 8 * fq;
        const bf16_t* zg = Z + (size_t)row0 * kZW + ZC_G + J * 1024 + col0; bf16_t* pp0 = P + (size_t)row0 * 1024 + col0; bf16_t* mb0 = Mb + (size_t)row0 * 1024 + col0;
        u32x4 gq[2][4], pq[2][4];
        auto load = [&](int slot, int b) {
            const int ai = b >> 1, mh = b & 1;
#pragma unroll
            for (int k = 0; k < 4; ++k) { const int m = 2 * mh + (k >> 1), bj = k & 1; const size_t ro = (size_t)(ai * HALF + m * 16);
                gq[slot][k] = *(const u32x4*)(zg + ro * kZW + bj * HALF);
                if (J >= 1) pq[slot][k] = *(const u32x4*)(pp0 + ro * 1024 + bj * HALF); }
        };
        load(0, 0);
#pragma unroll
        for (int b = 0; b < 4; ++b) {
            const int slot = b & 1, ai = b >> 1, mh = b & 1;
            if (b < 3) load(slot ^ 1, b + 1);
#pragma unroll
            for (int k = 0; k < 4; ++k) { const int m = 2 * mh + (k >> 1), bj = k & 1; const size_t ro = (size_t)(ai * HALF + m * 16);
                const u32x4 g = gq[slot][k];
                f32x4 v0 = acc[ai][bj][m][0], v1 = acc[ai][bj][m][1];
                v0[0] *= fast_sigmoid(bf_lo(g.x)); v0[1] *= fast_sigmoid(bf_hi(g.x)); v0[2] *= fast_sigmoid(bf_lo(g.y)); v0[3] *= fast_sigmoid(bf_hi(g.y));
                v1[0] *= fast_sigmoid(bf_lo(g.z)); v1[1] *= fast_sigmoid(bf_hi(g.z)); v1[2] *= fast_sigmoid(bf_lo(g.w)); v1[3] *= fast_sigmoid(bf_hi(g.w));
                if (J >= 1) { const u32x4 q = pq[slot][k];
                    v0[0] += bf_lo(q.x); v0[1] += bf_hi(q.x); v0[2] += bf_lo(q.y); v0[3] += bf_hi(q.y); v1[0] += bf_lo(q.z); v1[1] += bf_hi(q.z); v1[2] += bf_lo(q.w); v1[3] += bf_hi(q.w); }
                *(u32x4*)((J <= 1 ? pp0 : mb0) + ro * 1024 + bj * HALF) = pack8f(v0, v1); }
        }
    }
};


__device__ __forceinline__ float dpp_ror1(float v) { return __builtin_bit_cast(float, __builtin_amdgcn_update_dpp(0, __builtin_bit_cast(int, v), 0x121, 0xf, 0xf, false)); }
__device__ __forceinline__ float dpp_ror2(float v) { return __builtin_bit_cast(float, __builtin_amdgcn_update_dpp(0, __builtin_bit_cast(int, v), 0x122, 0xf, 0xf, false)); }
struct EpiUpConv {
    static constexpr bool PERM = true, AFTER_DRAIN = false;
    bf16_t* ACT; const float* ssq; const float* cw; const float* cb; const float* cpast; float* out; size_t off_p_conv, off_s_conv; PG8_LAS float* hx;
    __device__ __forceinline__ void operator()(const f32x4 (&acc)[2][2][4][2], const Unit& u, int wr, int wc, int fr_in, int fq_in) const {
        const int ln_ = hw_lane(); const int fr = ln_ & 15, fq = ln_ >> 4; (void)fr_in; (void)fq_in;
        const int cj = wc * 32 + 8 * fq;
        const int gc = u.pn * 128 + cj;
        const int tok0 = 254 * u.pm - 2 + wr * 64 + fr;
        f32x4 w0[2], w1[2], w2[2], bb[2];
#pragma unroll
        for (int n = 0; n < 2; ++n) { w0[n] = *(const f32x4*)(cw + gc + 4 * n); w1[n] = *(const f32x4*)(cw + 2816 + gc + 4 * n); w2[n] = *(const f32x4*)(cw + 2 * 2816 + gc + 4 * n); bb[n] = *(const f32x4*)(cb + gc + 4 * n); }
        float rs[2][4];
#pragma unroll
        for (int ai = 0; ai < 2; ++ai)
#pragma unroll
            for (int m = 0; m < 4; ++m) { const int tok = tok0 + ai * HALF + m * 16;
                rs[ai][m] = (tok >= 0 && tok < kR) ? __hip_atomic_load(ssq + tok, __ATOMIC_RELAXED, __HIP_MEMORY_SCOPE_AGENT) : -1.0f; }
#pragma unroll
        for (int ai = 0; ai < 2; ++ai)
#pragma unroll
            for (int m = 0; m < 4; ++m) rs[ai][m] = rs[ai][m] >= 0.f ? rsqrtf(rs[ai][m] * (1.0f / 1024.0f) + kEPS) : 0.f;
        if (fr >= 14) {
#pragma unroll
            for (int ai = 0; ai < 2; ++ai)
#pragma unroll
                for (int n = 0; n < 2; ++n) *(PG8_LAS f32x4*)(hx + (((2 * ai + wr) * 2 + (fr - 14)) * 128 + cj + 4 * n)) = acc[ai][0][3][n] * rs[ai][3];
        }
        epi_bar();
#pragma unroll
        for (int ai = 0; ai < 2; ++ai) {
            const int slab = 2 * ai + wr;
            f32x4 H1[2], H2[2];
#pragma unroll
            for (int n = 0; n < 2; ++n) { H1[n] = (f32x4){0.f, 0.f, 0.f, 0.f}; H2[n] = H1[n];
                if (slab > 0 && fr < 2) { H1[n] = *(const PG8_LAS f32x4*)(hx + (((slab - 1) * 2 + 1) * 128 + cj + 4 * n)); H2[n] = *(const PG8_LAS f32x4*)(hx + (((slab - 1) * 2 + 0) * 128 + cj + 4 * n)); } }
            f32x4 pr1[2], pr2[2];
#pragma unroll
            for (int m = 0; m < 4; ++m) {
                const int tok = tok0 + ai * HALF + m * 16;
                const bool owned = !(ai == 0 && wr == 0 && m == 0 && fr < 2) && tok < kR;
                const bool prompt = tok < kRP; const int t = prompt ? (tok & 2047) : ((tok - kRP) & 31); const int b = prompt ? (tok >> 11) : ((tok - kRP) >> 5); const int S = prompt ? 2048 : 32;
                unsigned pk[4];
#pragma unroll
                for (int n = 0; n < 2; ++n) {
                    const f32x4 cur = acc[ai][0][m][n] * rs[ai][m];
                    f32x4 r1, r2;
#pragma unroll
                    for (int i = 0; i < 4; ++i) { r1[i] = dpp_ror1(cur[i]); r2[i] = dpp_ror2(cur[i]); }
                    f32x4 p1, p2;
                    if (m == 0) {
#pragma unroll
                        for (int i = 0; i < 4; ++i) { p1[i] = fr == 0 ? H1[n][i] : r1[i]; p2[i] = fr == 0 ? H2[n][i] : (fr == 1 ? H1[n][i] : r2[i]); }
                    } else {
#pragma unroll
                        for (int i = 0; i < 4; ++i) { p1[i] = fr == 0 ? pr1[n][i] : r1[i]; p2[i] = fr < 2 ? pr2[n][i] : r2[i]; }
                    }
                    pr1[n] = r1; pr2[n] = r2;
                    if (owned && t < 2) {
                        const f32x4 z4 = {0.f, 0.f, 0.f, 0.f};
                        const f32x4 q1 = prompt ? z4 : *(const f32x4*)(cpast + ((size_t)b * 2 + 1) * 2816 + gc + 4 * n);
                        const f32x4 q0 = prompt ? z4 : *(const f32x4*)(cpast + ((size_t)b * 2 + 0) * 2816 + gc + 4 * n);
                        if (t == 0) { p1 = q1; p2 = q0; } else p2 = q1;
                    }
                    const f32x4 uu = acc[ai][1][m][n] * rs[ai][m];
                    f32x4 o;
#pragma unroll
                    for (int i = 0; i < 4; ++i) { const float cv = p2[i] * w0[n][i] + p1[i] * w1[n][i] + cur[i] * w2[n][i] + bb[n][i];
                        o[i] = cv * __builtin_amdgcn_rcpf(1.0f + __expf(-cv)) * uu[i]; }
                    pk[2 * n] = cvt_pk_bf16(o[0], o[1]); pk[2 * n + 1] = cvt_pk_bf16(o[2], o[3]);
                    if (owned && t >= S - 2) { float* od = out + (prompt ? off_p_conv + (size_t)b * 2 * 2816 : off_s_conv + (size_t)b * 2 * 2816) + (size_t)(t - (S - 2)) * 2816 + gc + 4 * n; *(f32x4*)od = cur; }
                }
                if (owned) *(u32x4*)(ACT + (size_t)tok * 2816 + gc) = (u32x4){pk[0], pk[1], pk[2], pk[3]};
            }
        }
        epi_bar();
    }
};

struct EpiBranchAll {
    static constexpr bool PERM = true, AFTER_DRAIN = false;
    const bf16_t* Z; bf16_t* P; bf16_t* Mb;
    __device__ __forceinline__ void operator()(const f32x4 (&acc)[2][2][4][2], const Unit& u, int wr, int wc, int fr, int fq) const {
        const int j = u.pn >> 2; Unit t; t.pm = u.pm - 66 * j; t.pn = u.pn - 4 * j;
        if (j == 0) EpiBranch<0>{Z, P, Mb}(acc, t, wr, wc, fr, fq); else if (j == 1) EpiBranch<1>{Z, P, Mb}(acc, t, wr, wc, fr, fq); else EpiBranch<2>{Z, P, Mb}(acc, t, wr, wc, fr, fq);
    }
};

struct EpiRes {
    static constexpr bool PERM = true, AFTER_DRAIN = false;
    const float* Xr; float* X; bf16_t* Xb; float* ssq_next;
    __device__ __forceinline__ void operator()(const f32x4 (&acc)[2][2][4][2], const Unit& u, int wr, int wc, int fr_in, int fq_in) const {
        const int ln_ = hw_lane(); const int fr = ln_ & 15, fq = ln_ >> 4; (void)fr_in; (void)fq_in;
        const int row0 = u.pm * BM + wr * 64 + fr, col0 = u.pn * BM + wc * 32 + 8 * fq;
        const float* xr0 = Xr + (size_t)row0 * 1024 + col0;
        float* x0 = X + (size_t)row0 * 1024 + col0; bf16_t* xb0 = Xb ? Xb + (size_t)row0 * 1024 + col0 : nullptr;
        f32x4 xq[2][4][2];
        auto load = [&](int slot, int b) {
            const int ai = b >> 1, mh = b & 1;
#pragma unroll
            for (int k = 0; k < 4; ++k) { const int m = 2 * mh + (k >> 1), bj = k & 1; const float* xp = xr0 + (size_t)(ai * HALF + m * 16) * 1024 + bj * HALF;
                xq[slot][k][0] = *(const f32x4*)xp; xq[slot][k][1] = *(const f32x4*)(xp + 4); }
        };
        load(0, 0);
#pragma unroll
        for (int b = 0; b < 4; ++b) {
            const int slot = b & 1, ai = b >> 1, mh = b & 1;
            if (b < 3) load(slot ^ 1, b + 1);
#pragma unroll
            for (int mm = 0; mm < 2; ++mm) { const int m = 2 * mh + mm; const size_t ro = (size_t)(ai * HALF + m * 16);
                float s = 0.f;
#pragma unroll
                for (int bj = 0; bj < 2; ++bj) { const int k = 2 * mm + bj;
                    const f32x4 v0 = acc[ai][bj][m][0] + xq[slot][k][0], v1 = acc[ai][bj][m][1] + xq[slot][k][1];
                    float* xp = x0 + ro * 1024 + bj * HALF; st16(xp, v0); st16((xp + 4), v1);
                    s += sq8(v0, v1);
                    if (Xb) st16((xb0 + ro * 1024 + bj * HALF), pack8f(v0, v1)); }
                if (ssq_next) { s += sw_xor<16>(s); s = half_sum(s);
                    if (fq == 0) __hip_atomic_fetch_add(ssq_next + row0 + ai * HALF + m * 16, s, __ATOMIC_RELAXED, __HIP_MEMORY_SCOPE_AGENT); } }
        }
    }
};

template <class Epi, class Sched, bool ALIGN_EPI = false, bool SP2 = false>
__device__ __forceinline__ void gemm_phase(PG8_LAS unsigned char* lds, const Gemm g, const Sched& S, const Epi& E, int tid_in  ) {
    int tid_ = tid_in; asm volatile("" : "+v"(tid_));
    const int tid = tid_, wid = __builtin_amdgcn_readfirstlane(tid >> 6), lane = tid & 63, wr = wid >> 2, wc = wid & 3, fr = lane & 15, fq = lane >> 4;
    const int K = g.K, nt = K / BK;
    unsigned voffA[2], voffB[2];
#pragma unroll
    for (int i = 0; i < 2; ++i) { int R, C; stage_rc(tid * 16 + i * 8192, R, C); const int Rb = Epi::PERM ? ((R & ~31) + perm32(R & 31)) : R;
        voffA[i] = (unsigned)(R * g.lda + C) * 2u; voffB[i] = (unsigned)(Rb * K + C) * 2u; }
    const size_t kstep = (size_t)(BK * 2);
    const size_t hstep = (size_t)HALF * K * 2;
    const size_t tstep = 2 * hstep; const size_t hstepA = (size_t)HALF * g.lda * 2, tstepA = (size_t)g.prows * g.lda * 2;
    const unsigned ldsw = (unsigned)wid * 1024u;
    const int aoff = lds_byte(wr * 64 + fr, fq * 8), boff = lds_byte(wc * 32 + fr, fq * 8);
#define PG8_SA(b, h) (((b) * 2 + (h)) * HTB)
#define PG8_SB(b, h) ((4 + (b) * 2 + (h)) * HTB)
#define PG8_STAGE(bufoff, gbase, voff) do { _Pragma("unroll") for (int _i = 0; _i < 2; ++_i) \
        __builtin_amdgcn_global_load_lds((const unsigned*)((const char*)(gbase) + (voff)[_i]), (PG8_LAS unsigned*)(lds + (bufoff) + ldsw + _i * 8192), 16, 0, 0); } while (0)
#define PG8_LDA(dst, b, h) do { _Pragma("unroll") for (int m = 0; m < 4; ++m) _Pragma("unroll") for (int k = 0; k < 2; ++k) dst[m][k] = *(const PG8_LAS bf16x8*)(lds + PG8_SA(b, h) + aoff + m * 2048 + k * 1024); } while (0)
#define PG8_LDB(dst, b, h) do { _Pragma("unroll") for (int n = 0; n < 2; ++n) _Pragma("unroll") for (int k = 0; k < 2; ++k) dst[n][k] = *(const PG8_LAS bf16x8*)(lds + PG8_SB(b, h) + boff + n * 2048 + k * 1024); } while (0)
#define PG8_MMA(ai, bj, At, Bt) do { __builtin_amdgcn_s_setprio(1); _Pragma("unroll") for (int m = 0; m < 4; ++m) _Pragma("unroll") for (int n = 0; n < 2; ++n) _Pragma("unroll") for (int k = 0; k < 2; ++k) \
        acc[ai][bj][m][n] = __builtin_amdgcn_mfma_f32_16x16x32_bf16(Bt[n][k], At[m][k], acc[ai][bj][m][n], 0, 0, 0); __builtin_amdgcn_s_setprio(0); } while (0)
#define PG8_WAIT_V(n) asm volatile("s_waitcnt vmcnt(" #n ")" ::: "memory")
#define PG8_WAIT_L(n) asm volatile("s_waitcnt lgkmcnt(" #n ")" ::: "memory")
#define PG8_BAR __builtin_amdgcn_s_barrier()
#define PG8_SCHED __builtin_amdgcn_sched_barrier(0)
    Unit cur, nxt; int ui = 0;
    if (!S.next(0, cur)) return;
    f32x4 acc[2][2][4][2];
#pragma unroll
    for (int a = 0; a < 2; ++a)
#pragma unroll
        for (int b = 0; b < 2; ++b)
#pragma unroll
            for (int m = 0; m < 4; ++m)
#pragma unroll
                for (int n = 0; n < 2; ++n) acc[a][b][m][n] = (f32x4){0.f, 0.f, 0.f, 0.f};
    bf16x8 At[4][2], B0[2][2], B1[2][2];
    const char* cA = (const char*)g.A + (size_t)cur.pm * tstepA; const char* cB = (const char*)g.Bt + (size_t)cur.pn * tstep;
    S.a_ready(cur);
    if constexpr (SP2) {
        PG8_STAGE(PG8_SB(0, 0), cB, voffB); PG8_STAGE(PG8_SB(0, 1), cB + hstep, voffB); PG8_STAGE(PG8_SA(0, 0), cA, voffA); PG8_STAGE(PG8_SA(0, 1), cA + hstepA, voffA);
        if (wr == 1) PG8_BAR;
        PG8_WAIT_V(2); PG8_BAR;
        PG8_STAGE(PG8_SB(1, 0), cB + kstep, voffB); PG8_STAGE(PG8_SA(1, 0), cA + kstep, voffA); PG8_STAGE(PG8_SB(1, 1), cB + hstep + kstep, voffB);
        PG8_WAIT_V(6); PG8_BAR;
    } else {
        PG8_STAGE(PG8_SB(0, 0), cB, voffB); PG8_STAGE(PG8_SA(0, 0), cA, voffA); PG8_STAGE(PG8_SB(0, 1), cB + hstep, voffB); PG8_STAGE(PG8_SA(0, 1), cA + hstepA, voffA);
        if (wr == 1) PG8_BAR;
        PG8_WAIT_V(4); PG8_BAR;
        PG8_STAGE(PG8_SB(1, 0), cB + kstep, voffB); PG8_STAGE(PG8_SA(1, 0), cA + kstep, voffA); PG8_STAGE(PG8_SB(1, 1), cB + hstep + kstep, voffB);
        PG8_WAIT_V(6); PG8_BAR;
    }
    for (;;) {
        const bool has_next = S.next(ui + 1, nxt);
        const char* nA = has_next ? (const char*)g.A + (size_t)nxt.pm * tstepA : cA; const char* nB = has_next ? (const char*)g.Bt + (size_t)nxt.pn * tstep : cB;
        for (int t = 0; t < nt; t += 2) {
            const bool last = (t == nt - 2);
            const char* a1 = cA + (size_t)(t + 1) * kstep;
            const char* a2 = last ? nA : cA + (size_t)(t + 2) * kstep; const char* b2 = last ? nB : cB + (size_t)(t + 2) * kstep;
            const char* a3 = a2 + kstep; const char* b3 = b2 + kstep;
            if (last && has_next) S.a_ready(nxt);
            if constexpr (SP2) {
            PG8_LDB(B0, 0, 0); PG8_LDB(B1, 0, 1); PG8_SCHED; PG8_LDA(At, 0, 0); PG8_STAGE(PG8_SA(1, 1), a1 + hstepA, voffA);
            PG8_WAIT_V(8); PG8_WAIT_L(0); PG8_BAR; PG8_MMA(0, 0, At, B0); PG8_MMA(0, 1, At, B1); PG8_BAR; PG8_SCHED;
            PG8_LDA(At, 0, 1); PG8_STAGE(PG8_SB(0, 0), b2, voffB); PG8_STAGE(PG8_SB(0, 1), b2 + hstep, voffB); PG8_STAGE(PG8_SA(0, 0), a2, voffA);
            PG8_WAIT_V(8); PG8_WAIT_L(0); PG8_BAR; PG8_MMA(1, 0, At, B0); PG8_MMA(1, 1, At, B1); PG8_BAR; PG8_SCHED;
            PG8_LDB(B0, 1, 0); PG8_LDB(B1, 1, 1); PG8_SCHED; PG8_LDA(At, 1, 0); PG8_STAGE(PG8_SA(0, 1), a2 + hstepA, voffA);
            PG8_WAIT_V(8); PG8_WAIT_L(0); PG8_BAR; PG8_MMA(0, 0, At, B0); PG8_MMA(0, 1, At, B1); PG8_BAR; PG8_SCHED;
            PG8_LDA(At, 1, 1); PG8_STAGE(PG8_SB(1, 0), b3, voffB); PG8_STAGE(PG8_SB(1, 1), b3 + hstep, voffB); PG8_STAGE(PG8_SA(1, 0), a3, voffA);
            PG8_WAIT_V(8); PG8_WAIT_L(0); PG8_BAR; PG8_MMA(1, 0, At, B0); PG8_MMA(1, 1, At, B1); PG8_BAR; PG8_SCHED;
            } else {
            PG8_LDB(B0, 0, 0); PG8_SCHED; PG8_LDA(At, 0, 0); PG8_STAGE(PG8_SA(1, 1), a1 + hstepA, voffA);
            PG8_WAIT_L(8); PG8_BAR; PG8_WAIT_L(0); PG8_MMA(0, 0, At, B0); PG8_BAR; PG8_SCHED;
            PG8_LDB(B1, 0, 1); PG8_STAGE(PG8_SB(0, 0), b2, voffB);
            PG8_BAR; PG8_WAIT_L(0); PG8_MMA(0, 1, At, B1); PG8_BAR;
            PG8_LDA(At, 0, 1); PG8_STAGE(PG8_SA(0, 0), a2, voffA);
            PG8_BAR; PG8_WAIT_L(0); PG8_MMA(1, 0, At, B0); PG8_BAR; PG8_SCHED;
            PG8_STAGE(PG8_SB(0, 1), b2 + hstep, voffB);
            PG8_WAIT_V(6); PG8_BAR; PG8_MMA(1, 1, At, B1); PG8_BAR;
            PG8_LDB(B0, 1, 0); PG8_SCHED; PG8_LDA(At, 1, 0); PG8_STAGE(PG8_SA(0, 1), a2 + hstepA, voffA);
            PG8_WAIT_L(8); PG8_BAR; PG8_WAIT_L(0); PG8_MMA(0, 0, At, B0); PG8_BAR; PG8_SCHED;
            PG8_LDB(B1, 1, 1); PG8_STAGE(PG8_SB(1, 0), b3, voffB);
            PG8_BAR; PG8_WAIT_L(0); PG8_MMA(0, 1, At, B1); PG8_BAR;
            PG8_LDA(At, 1, 1); PG8_STAGE(PG8_SA(1, 0), a3, voffA);
            PG8_BAR; PG8_WAIT_L(0); PG8_MMA(1, 0, At, B0); PG8_BAR; PG8_SCHED;
            PG8_STAGE(PG8_SB(1, 1), b3 + hstep, voffB);
            PG8_WAIT_V(6); PG8_BAR; PG8_MMA(1, 1, At, B1); PG8_BAR;
            }
        }
        if constexpr (ALIGN_EPI) { if (wr == 0) PG8_BAR; }
        if constexpr (!Epi::AFTER_DRAIN) { E(acc, cur, wr, wc, fr, fq); S.done(cur); }
        if (!has_next) break;
#pragma unroll
        for (int a = 0; a < 2; ++a)
#pragma unroll
            for (int b = 0; b < 2; ++b)
#pragma unroll
                for (int m = 0; m < 4; ++m)
#pragma unroll
                    for (int n = 0; n < 2; ++n) acc[a][b][m][n] = (f32x4){0.f, 0.f, 0.f, 0.f};
        cur = nxt; cA = nA; cB = nB; ++ui;
        if constexpr (ALIGN_EPI) { if (wr == 1) PG8_BAR; }
    }
    PG8_WAIT_V(0);
    if constexpr (!ALIGN_EPI) { if (wr == 0) PG8_BAR; }
    PG8_BAR;
    if constexpr (Epi::AFTER_DRAIN) { E.fused(acc, cur, wr, wc, fr, fq, lds, wid, lane); S.done(cur); }
#undef PG8_SA
#undef PG8_SB
#undef PG8_STAGE
#undef PG8_LDA
#undef PG8_LDB
#undef PG8_MMA
#undef PG8_WAIT_V
#undef PG8_WAIT_L
#undef PG8_BAR
#undef PG8_SCHED
}
}
using pg8::kR; using pg8::kRP; using pg8::kRS; using pg8::kZW; using pg8::kEPS;
using pg8::ZC_CQ; using pg8::ZC_CKV; using pg8::ZC_KR; using pg8::ZC_SQ; using pg8::ZC_SK; using pg8::ZC_SV; using pg8::ZC_DQ; using pg8::ZC_DK; using pg8::ZC_DV; using pg8::ZC_G;
constexpr int NWAVES = 8;
constexpr int NIN0 = 6560, DFF = 2816, PASTL = 4096, NCACHE = 16 * 4096;
constexpr float LOG2E = 1.4426950408889634f;
constexpr float QS_MLA = 0.10206207261596577f * LOG2E;
constexpr float QS_64 = 0.125f * LOG2E;

constexpr size_t OUT_YP = 0;
constexpr size_t OUT_YS = OUT_YP + (size_t)kRP * 1024;
constexpr size_t OUT_PCKV = OUT_YS + (size_t)kRS * 1024;
constexpr size_t OUT_PKR = OUT_PCKV + (size_t)2 * kRP * 128;
constexpr size_t OUT_PSBK = OUT_PKR + (size_t)2 * kRP * 32;
constexpr size_t OUT_PSBV = OUT_PSBK + (size_t)2 * kRP * 512;
constexpr size_t OUT_PDK = OUT_PSBV + (size_t)2 * kRP * 512;
constexpr size_t OUT_PDV = OUT_PDK + (size_t)2 * kRP * 512;
constexpr size_t OUT_PCONV = OUT_PDV + (size_t)2 * kRP * 512;
constexpr size_t OUT_SCKV = OUT_PCONV + (size_t)2 * 8 * 2 * DFF;
constexpr size_t OUT_SKR = OUT_SCKV + (size_t)2 * kRS * 128;
constexpr size_t OUT_SSBK = OUT_SKR + (size_t)2 * kRS * 32;
constexpr size_t OUT_SSBV = OUT_SSBK + (size_t)2 * kRS * 512;
constexpr size_t OUT_SDK = OUT_SSBV + (size_t)2 * kRS * 512;
constexpr size_t OUT_SDV = OUT_SDK + (size_t)2 * kRS * 512;
constexpr size_t OUT_SCONV = OUT_SDV + (size_t)2 * kRS * 512;

enum { IN_XP = 0, IN_XS, IN_CCKV, IN_CKR, IN_CSBK, IN_CSBV, IN_CDK, IN_CDV, IN_CONV, IN_MIXG, IN_WIN, IN_QNG, IN_WUQ, IN_KVNG, IN_WUK, IN_WUV, IN_QN_G, IN_KN_G, IN_QR_G, IN_KR_G,
       IN_DQN_G, IN_DKN_G, IN_LAMBDA, IN_SUBLN_G, IN_WBR_MLA, IN_WBR_SB, IN_WBR_DIFF, IN_WOUT, IN_FFNG, IN_WUP, IN_CONVW, IN_CONVB, IN_WDOWN, N_INPUTS };

constexpr size_t MiB = 1u << 20;
constexpr size_t WS_CTL = 0, CTL_ZERO_BYTES = 2 * MiB;
constexpr int CW_BAR = 1024;
constexpr int CW_WQ = 8192;
constexpr int CW_SSQ = 16384;
static_assert((CW_SSQ + 4 * kR) * 4 <= (int)CTL_ZERO_BYTES, "ctl region");
constexpr size_t WL_IN = 0, WL_UQ = WL_IN + (size_t)kZW * 1024 * 2, WL_UKV = WL_UQ + (size_t)768 * 256 * 2, WL_BR = WL_UKV + (size_t)1024 * 128 * 2,
                 WL_OUT = WL_BR + (size_t)3 * 1024 * 512 * 2, WL_UP = WL_OUT + (size_t)1024 * 1024 * 2, WL_DOWN = WL_UP + (size_t)5632 * 1024 * 2, WL_SIZE = WL_DOWN + (size_t)1024 * 2816 * 2;
constexpr size_t WS_W = 2 * MiB;
constexpr size_t WS_XB = WS_W + 2 * WL_SIZE;
#ifndef WS_TRANS_BASE
#define WS_TRANS_BASE (WS_XB + (size_t)kR * 1024 * 2)
#endif
constexpr size_t WS_Z = WS_TRANS_BASE;
constexpr size_t WS_Q = WS_Z + (size_t)kR * kZW * 2;
constexpr size_t WS_KNMV = WS_Q + (size_t)kR * 768 * 2;
constexpr size_t WS_KMLA = WS_KNMV + (size_t)kR * 1024 * 2;
constexpr size_t WS_CKVB = WS_KMLA + (size_t)kR * 768 * 2;
constexpr size_t WS_KNMVC = WS_CKVB + (size_t)2 * NCACHE * 128 * 2;
constexpr size_t WS_KMLAC = WS_KNMVC + (size_t)NCACHE * 1024 * 2;
constexpr size_t WS_ROPE = WS_KMLAC + (size_t)2 * NCACHE * 768 * 2;
constexpr size_t WS_O = WS_ROPE + (size_t)2080 * 32 * 4;
constexpr size_t WS_MP = WS_O + (size_t)3 * kR * 512 * 2;
constexpr size_t WS_MB = WS_MP + (size_t)kR * 1024 * 4;
constexpr size_t WS_ACT = WS_MB + (size_t)kR * 1024 * 2;
constexpr size_t WS_FAST_END = WS_ACT + (size_t)kR * DFF * 2;
constexpr size_t WS_AU = WS_Z;

constexpr int RING_BYTES = 131072;
constexpr int MISC_OFF = RING_BYTES + 8192;
constexpr int LDS_BYTES = 147456;

#define GAS __attribute__((address_space(1)))
#define LAS __attribute__((address_space(3)))
typedef unsigned short bf16;
typedef unsigned v4u __attribute__((ext_vector_type(4)));
typedef unsigned v2u __attribute__((ext_vector_type(2)));
typedef float f32x4 __attribute__((ext_vector_type(4)));
typedef float f32x2 __attribute__((ext_vector_type(2)));
__device__ __forceinline__ unsigned f2bf(float f) { unsigned u = __builtin_bit_cast(unsigned, f); return (u + 0x7fffu + ((u >> 16) & 1u)) >> 16; }
__device__ __forceinline__ unsigned pk2(float lo, float hi) { return f2bf(lo) | (f2bf(hi) << 16); }
__device__ __forceinline__ float bflo(unsigned w) { return __uint_as_float(w << 16); }
__device__ __forceinline__ float bfhi(unsigned w) { return __uint_as_float(w & 0xffff0000u); }
__device__ __forceinline__ float bf1(bf16 h) { return __uint_as_float((unsigned)h << 16); }
__device__ __forceinline__ float wave_sum(float v) {
    v += sw_xor<1>(v); v += sw_xor<2>(v); v += sw_xor<4>(v); v += sw_xor<8>(v); v += sw_xor<16>(v);
    return half_sum(v);
}
#define LDS_WAIT() asm volatile("s_waitcnt lgkmcnt(0)" ::: "memory")

struct Args { const float* in[N_INPUTS]; float* out; unsigned char* ws; int layer; int pad; };
typedef const Args __attribute__((address_space(4)))* CArgsP;

__device__ __forceinline__ int row_pos(int row) { return row < kRP ? (row & 2047) : PASTL + ((row - kRP) & 31); }
__device__ __forceinline__ float rope_inv16(int i) { return exp2f(-(float)i * (13.287712379549449f / 16.0f)); }

__device__ __forceinline__ void transpose_item(const float* W, int ldw, int k0, int scol, bf16* WT, int K, int n0, const float* gk, LAS float* scr, int lane) {
    float tv[32];
#pragma unroll
    for (int i = 0; i < 32; ++i) { const int kk = 2 * i + (lane >> 5); tv[i] = scol >= 0 ? __builtin_nontemporal_load(W + (size_t)(k0 + kk) * ldw + scol + (lane & 31)) : 0.f; }
    if (gk) {
#pragma unroll
        for (int i = 0; i < 32; ++i) tv[i] *= gk[k0 + 2 * i + (lane >> 5)]; }
#pragma unroll
    for (int i = 0; i < 32; ++i) scr[(2 * i + (lane >> 5)) * 33 + (lane & 31)] = tv[i];
    LDS_WAIT(); asm volatile("" ::: "memory");
    const int c = lane & 7;
#pragma unroll
    for (int j = 0; j < 4; ++j) { const int n = (lane >> 3) + 8 * j; const LAS float* s = scr + (8 * c) * 33 + n;
        v4u o; o.x = pk2(s[0 * 33], s[1 * 33]); o.y = pk2(s[2 * 33], s[3 * 33]); o.z = pk2(s[4 * 33], s[5 * 33]); o.w = pk2(s[6 * 33], s[7 * 33]);
        *(v4u*)(WT + (size_t)(n0 + n) * K + k0 + 8 * c) = o; }
    LDS_WAIT(); asm volatile("" ::: "memory");
}
struct TMat { const float* W; int ldw; int K; int Ndst; bf16* WT; const float* gk; int kind; int perm; };
__device__ __forceinline__ int tmat_items(const TMat& m) { return (m.K / 64) * (m.Ndst / 32); }
__device__ __forceinline__ void tmat_do(const TMat& m, int item, LAS float* scr, int lane) {
    const int ng = m.Ndst / 32, kb = item / ng, g = item % ng;
    int L = g * 32;
    if (m.perm) { const int tile = g >> 3, g32 = g & 7; L = tile * 256 + 64 * (g32 & 3) + 32 * (g32 >> 2); }
    int scol = L;
    if (m.kind == 1) scol = L < 416 ? L : (L < 512 ? -1 : L - 96);
    if (m.kind == 2) scol = L < 512 ? (L >> 6) * 96 + (L & 63) : ((L - 512) >> 5) * 96 + 64;
    if (m.kind == 3) { const int tile = g >> 3, g32 = g & 7; scol = g32 < 4 ? 128 * tile + 32 * g32 : 2816 + 128 * tile + 32 * (g32 - 4); }
    transpose_item(m.W, m.ldw, kb * 64, scol, m.WT, m.K, g * 32, m.gk, scr, lane);
}

namespace p0w {
constexpr int NI0 = (1024 / 64) * (kZW / 32), NI1 = (256 / 64) * (768 / 32), NI2 = (128 / 64) * (512 / 32), NI4 = (512 / 64) * (1024 / 32), NI7 = (1024 / 64) * (1024 / 32),
              NI8 = (1024 / 64) * (5632 / 32), NI9 = (DFF / 64) * (1024 / 32);
constexpr int C1 = NI0, C2 = C1 + NI1, C3 = C2 + NI2, C4 = C3 + NI2, C5 = C4 + NI4, C6 = C5 + NI4, C7 = C6 + NI4, C8 = C7 + NI7, C9 = C8 + NI8, CL = C9 + NI9;
constexpr int CHUNK = 64, NCHUNK = (CL + CHUNK - 1) / CHUNK;
}
__device__ __forceinline__ void p0_weight_item(CArgsP a, int it  , LAS float* scr, int lane) {
    using namespace p0w;
    unsigned char* ws = a->ws;
    const int l = it >= CL ? 1 : 0, r = it - l * CL;
    bf16* wl = (bf16*)(ws + WS_W + (size_t)l * WL_SIZE);
    if (r < C1)      tmat_do(TMat{a->in[IN_WIN] + (size_t)l * 1024 * NIN0, NIN0, 1024, kZW, (bf16*)((unsigned char*)wl + WL_IN), a->in[IN_MIXG] + l * 1024, 1, 1}, r, scr, lane);
    else if (r < C2) tmat_do(TMat{a->in[IN_WUQ] + (size_t)l * 256 * 768, 768, 256, 768, (bf16*)((unsigned char*)wl + WL_UQ), nullptr, 2, 1}, r - C1, scr, lane);
    else if (r < C3) tmat_do(TMat{a->in[IN_WUK] + (size_t)l * 128 * 512, 512, 128, 512, (bf16*)((unsigned char*)wl + WL_UKV), nullptr, 0, 1}, r - C2, scr, lane);
    else if (r < C4) tmat_do(TMat{a->in[IN_WUV] + (size_t)l * 128 * 512, 512, 128, 512, (bf16*)((unsigned char*)wl + WL_UKV) + (size_t)512 * 128, nullptr, 0, 1}, r - C3, scr, lane);
    else if (r < C5) tmat_do(TMat{a->in[IN_WBR_MLA] + (size_t)l * 512 * 1024, 1024, 512, 1024, (bf16*)((unsigned char*)wl + WL_BR), nullptr, 0, 0}, r - C4, scr, lane);
    else if (r < C6) tmat_do(TMat{a->in[IN_WBR_SB] + (size_t)l * 512 * 1024, 1024, 512, 1024, (bf16*)((unsigned char*)wl + WL_BR) + (size_t)1024 * 512, nullptr, 0, 0}, r - C5, scr, lane);
    else if (r < C7) tmat_do(TMat{a->in[IN_WBR_DIFF] + (size_t)l * 512 * 1024, 1024, 512, 1024, (bf16*)((unsigned char*)wl + WL_BR) + (size_t)2 * 1024 * 512, nullptr, 0, 0}, r - C6, scr, lane);
    else if (r < C8) tmat_do(TMat{a->in[IN_WOUT] + (size_t)l * 1024 * 1024, 1024, 1024, 1024, (bf16*)((unsigned char*)wl + WL_OUT), nullptr, 0, 0}, r - C7, scr, lane);
    else if (r < C9) tmat_do(TMat{a->in[IN_WUP] + (size_t)l * 1024 * 5632, 5632, 1024, 5632, (bf16*)((unsigned char*)wl + WL_UP), a->in[IN_FFNG] + l * 1024, 3, 0}, r - C8, scr, lane);
    else             tmat_do(TMat{a->in[IN_WDOWN] + (size_t)l * DFF * 1024, 1024, DFF, 1024, (bf16*)((unsigned char*)wl + WL_DOWN), nullptr, 0, 0}, r - C9, scr, lane);
}
__device__ __forceinline__ void p0_phase(CArgsP a, LAS unsigned char* lds, int gw, int NGW, int wave, int lane) {
    LAS float* scr = (LAS float*)(lds + wave * 16384);
    unsigned char* ws = a->ws;
    for (int it = gw; it < p0w::CL; it += NGW) p0_weight_item(a, it, scr, lane);
    float* ssq0 = (float*)(ws + WS_CTL) + CW_SSQ;
    bf16* xb = (bf16*)(ws + WS_XB);
    for (int row0 = gw; row0 < kR; row0 += 2 * NGW) {
        f32x4 v[2][4]; int rows[2]; bool ok[2];
#pragma unroll
        for (int k = 0; k < 2; ++k) { const int row = row0 + k * NGW; ok[k] = row < kR; rows[k] = ok[k] ? row : row0;
            const float* src = rows[k] < kRP ? a->in[IN_XP] + (size_t)rows[k] * 1024 : a->in[IN_XS] + (size_t)(rows[k] - kRP) * 1024;
#pragma unroll
            for (int j = 0; j < 4; ++j) v[k][j] = *((const f32x4*)src + lane + 64 * j); }
#pragma unroll
        for (int k = 0; k < 2; ++k) { if (!ok[k]) continue;
            float s = 0.f;
#pragma unroll
            for (int j = 0; j < 4; ++j) { const f32x4 x = v[k][j];
                s += (x.x * x.x + x.y * x.y) + (x.z * x.z + x.w * x.w);
                v2u w; w.x = pk2(x.x, x.y); w.y = pk2(x.z, x.w); *((v2u*)(xb + (size_t)rows[k] * 1024) + lane + 64 * j) = w; }
            s = wave_sum(s); if (lane == 0) ssq0[rows[k]] = s; }
    }
    { const float* src = a->in[IN_CKR]; bf16* dst = (bf16*)(ws + WS_KMLAC); const size_t n4 = (size_t)2 * NCACHE * 4;
      const size_t st = (size_t)NGW * 64;
      for (size_t i0 = (size_t)gw * 64 + lane; i0 < n4; i0 += 4 * st) { f32x4 v0[4], v1[4];
#pragma unroll
          for (int k = 0; k < 4; ++k) { const size_t i = i0 + k * st < n4 ? i0 + k * st : i0; const size_t row = i >> 2; const int c8 = (int)(i & 3) * 8;
              v0[k] = __builtin_nontemporal_load((const f32x4*)(src + row * 32 + c8)); v1[k] = __builtin_nontemporal_load((const f32x4*)(src + row * 32 + c8 + 4)); }
#pragma unroll
          for (int k = 0; k < 4; ++k) { const size_t i = i0 + k * st; if (i >= n4) continue; const size_t row = i >> 2; const int c8 = (int)(i & 3) * 8;
              v4u w; w.x = pk2(v0[k].x, v0[k].y); w.y = pk2(v0[k].z, v0[k].w); w.z = pk2(v1[k].x, v1[k].y); w.w = pk2(v1[k].z, v1[k].w);
#pragma unroll
              for (int h = 0; h < 8; ++h) *(v4u*)(dst + row * 768 + h * 96 + 64 + c8) = w; } } }
    { constexpr size_t n8 = (size_t)2 * NCACHE * 128 / 8; const float* src = a->in[IN_CCKV]; bf16* dst = (bf16*)(ws + WS_CKVB); const size_t st = (size_t)NGW * 64;
      for (size_t i0 = (size_t)gw * 64 + lane; i0 < n8; i0 += 4 * st) { f32x4 v0[4], v1[4];
#pragma unroll
          for (int k = 0; k < 4; ++k) { const size_t i = i0 + k * st < n8 ? i0 + k * st : i0; v0[k] = __builtin_nontemporal_load((const f32x4*)src + 2 * i); v1[k] = __builtin_nontemporal_load((const f32x4*)src + 2 * i + 1); }
#pragma unroll
          for (int k = 0; k < 4; ++k) { const size_t i = i0 + k * st; if (i < n8) { v4u w; w.x = pk2(v0[k].x, v0[k].y); w.y = pk2(v0[k].z, v0[k].w); w.z = pk2(v1[k].x, v1[k].y); w.w = pk2(v1[k].z, v1[k].w); *((v4u*)dst + i) = w; } } } }
}

__device__ __forceinline__ void post_in_phase(CArgsP a, int l, int gw, int NGW, int lane) {
    bf16* Z = (bf16*)(a->ws + WS_Z);
    const float* qng = a->in[IN_QNG] + l * 256; const float* kvng = a->in[IN_KVNG] + l * 128; const float* krg = a->in[IN_KR_G] + l * 32;
    const float* dqg = a->in[IN_DQN_G] + l * 64; const float* dkg = a->in[IN_DKN_G] + l * 64;
    for (int row = gw; row < kR; row += NGW) {
        bf16* z = Z + (size_t)row * kZW;
        const bool prompt = row < kRP; const size_t crow = prompt ? (size_t)l * kRP + row : (size_t)l * kRS + (row - kRP);
        const int pos = row_pos(row);
        { const v2u w = *(const v2u*)(z + ZC_CQ + 4 * lane); float f0 = bflo(w.x), f1 = bfhi(w.x), f2 = bflo(w.y), f3 = bfhi(w.y);
          const float rs = rsqrtf(wave_sum((f0 * f0 + f1 * f1) + (f2 * f2 + f3 * f3)) * (1.f / 256.f) + kEPS); const f32x4 g = *(const f32x4*)(qng + 4 * lane);
          v2u o; o.x = pk2(f0 * rs * g.x, f1 * rs * g.y); o.y = pk2(f2 * rs * g.z, f3 * rs * g.w); *(v2u*)(z + ZC_CQ + 4 * lane) = o; }
        { const unsigned w = *(const unsigned*)(z + ZC_CKV + 2 * lane); float f0 = bflo(w), f1 = bfhi(w);
          const float rs = rsqrtf(wave_sum(f0 * f0 + f1 * f1) * (1.f / 128.f) + kEPS); const f32x2 g = *(const f32x2*)(kvng + 2 * lane);
          f0 = f0 * rs * g.x; f1 = f1 * rs * g.y; *(unsigned*)(z + ZC_CKV + 2 * lane) = pk2(f0, f1);
          float* o = a->out + (prompt ? OUT_PCKV : OUT_SCKV) + crow * 128 + 2 * lane; *(f32x2*)o = (f32x2){f0, f1}; }
        { float f = lane < 32 ? bf1(z[ZC_KR + lane]) : 0.f; const float rs = rsqrtf(wave_sum(f * f) * (1.f / 32.f) + kEPS);
          const float fn = lane < 32 ? f * rs * krg[lane & 31] : 0.f; const float other = sw_xor<16>(fn);
          const int i = lane & 15; float sn, cs; sincosf((float)pos * rope_inv16(i), &sn, &cs);
          const float o = (lane & 16) ? (other * sn + fn * cs) : (fn * cs - other * sn);
          if (lane < 32) { a->out[(prompt ? OUT_PKR : OUT_SKR) + crow * 32 + lane] = o; z[ZC_KR + lane] = (bf16)f2bf(o); } }
        { v4u w = *(const v4u*)(z + ZC_SQ + 8 * lane);
          w.x = pk2(bflo(w.x) * QS_64, bfhi(w.x) * QS_64); w.y = pk2(bflo(w.y) * QS_64, bfhi(w.y) * QS_64); w.z = pk2(bflo(w.z) * QS_64, bfhi(w.z) * QS_64); w.w = pk2(bflo(w.w) * QS_64, bfhi(w.w) * QS_64);
          *(v4u*)(z + ZC_SQ + 8 * lane) = w; }
        { const v4u w = *(const v4u*)(z + ZC_DQ + 8 * lane); float f[8] = {bflo(w.x), bfhi(w.x), bflo(w.y), bfhi(w.y), bflo(w.z), bfhi(w.z), bflo(w.w), bfhi(w.w)};
          float s = 0.f;
#pragma unroll
          for (int i = 0; i < 8; ++i) s += f[i] * f[i];
          s += sw_xor<1>(s); s += sw_xor<2>(s); s += sw_xor<4>(s);
          const float rs = rsqrtf(s * (1.f / 64.f) + kEPS) * QS_64; const float* g = dqg + 8 * (lane & 7);
          v4u o; o.x = pk2(f[0] * rs * g[0], f[1] * rs * g[1]); o.y = pk2(f[2] * rs * g[2], f[3] * rs * g[3]); o.z = pk2(f[4] * rs * g[4], f[5] * rs * g[5]); o.w = pk2(f[6] * rs * g[6], f[7] * rs * g[7]);
          *(v4u*)(z + ZC_DQ + 8 * lane) = o; }
        { const v4u w = *(const v4u*)(z + ZC_DK + 8 * lane); float f[8] = {bflo(w.x), bfhi(w.x), bflo(w.y), bfhi(w.y), bflo(w.z), bfhi(w.z), bflo(w.w), bfhi(w.w)};
          float s = 0.f;
#pragma unroll
          for (int i = 0; i < 8; ++i) s += f[i] * f[i];
          s += sw_xor<1>(s); s += sw_xor<2>(s); s += sw_xor<4>(s);
          const float rs = rsqrtf(s * (1.f / 64.f) + kEPS); const float* g = dkg + 8 * (lane & 7);
#pragma unroll
          for (int i = 0; i < 8; ++i) f[i] = f[i] * rs * g[i];
          v4u o; o.x = pk2(f[0], f[1]); o.y = pk2(f[2], f[3]); o.z = pk2(f[4], f[5]); o.w = pk2(f[6], f[7]);
          *(v4u*)(z + ZC_DK + 8 * lane) = o;
          float* od = a->out + (prompt ? OUT_PDK : OUT_SDK) + crow * 512 + 8 * lane; *(f32x4*)od = (f32x4){f[0], f[1], f[2], f[3]}; *(f32x4*)(od + 4) = (f32x4){f[4], f[5], f[6], f[7]}; }
    }
}

__device__ __forceinline__ void post_qk_phase(CArgsP a, int l, int gw, int NGW, int lane) {
    bf16* Q = (bf16*)(a->ws + WS_Q); const bf16* KNMV = (const bf16*)(a->ws + WS_KNMV); bf16* KM = (bf16*)(a->ws + WS_KMLA); const bf16* Z = (const bf16*)(a->ws + WS_Z);
    const float* qng = a->in[IN_QN_G] + l * 64; const float* qrg = a->in[IN_QR_G] + l * 32; const float* kng = a->in[IN_KN_G] + l * 64;
    for (int row = gw; row < kR; row += NGW) {
        const int pos = row_pos(row);
        const int i = lane & 15; float sn, cs; sincosf((float)pos * rope_inv16(i), &sn, &cs);
        const bf16 krv = lane < 32 ? Z[(size_t)row * kZW + ZC_KR + lane] : (bf16)0;
        for (int h = 0; h < 8; ++h) {
            bf16* q = Q + (size_t)row * 768 + h * 96;
            const float v = bf1(q[lane]); const float rs = rsqrtf(wave_sum(v * v) * (1.f / 64.f) + kEPS);
            const float w = lane < 32 ? bf1(q[64 + lane]) : 0.f; const float rs2 = rsqrtf(wave_sum(w * w) * (1.f / 32.f) + kEPS);
            const float wn = lane < 32 ? w * rs2 * qrg[lane & 31] : 0.f; const float other = sw_xor<16>(wn);
            const float o = (lane & 16) ? (other * sn + wn * cs) : (wn * cs - other * sn);
            q[lane] = (bf16)f2bf(v * rs * qng[lane] * QS_MLA);
            if (lane < 32) q[64 + lane] = (bf16)f2bf(o * QS_MLA);
            const float kv = bf1(KNMV[(size_t)row * 1024 + h * 64 + lane]); const float rk = rsqrtf(wave_sum(kv * kv) * (1.f / 64.f) + kEPS);
            bf16* km = KM + (size_t)row * 768 + h * 96;
            km[lane] = (bf16)f2bf(kv * rk * kng[lane]);
            if (lane < 32) km[64 + lane] = krv;
        }
    }
}
__device__ __forceinline__ void post_kc_phase(CArgsP a, int l, int gw, int NGW, int lane) {
    const bf16* KNMVC = (const bf16*)(a->ws + WS_KNMVC); bf16* KMC = (bf16*)(a->ws + WS_KMLAC);
    const float* kng = a->in[IN_KN_G] + l * 64; const float* ckr = a->in[IN_CKR] + (size_t)l * NCACHE * 32;
    for (int row = gw; row < NCACHE; row += NGW) {
        const bf16 krv = lane < 32 ? (bf16)f2bf(ckr[(size_t)row * 32 + lane]) : (bf16)0;
        for (int h = 0; h < 8; ++h) {
            const float kv = bf1(KNMVC[(size_t)row * 1024 + h * 64 + lane]); const float rk = rsqrtf(wave_sum(kv * kv) * (1.f / 64.f) + kEPS);
            bf16* km = KMC + (size_t)row * 768 + h * 96;
            km[lane] = (bf16)f2bf(kv * rk * kng[lane]);
            if (lane < 32) km[64 + lane] = krv;
        }
    }
}

__device__ __forceinline__ void conv_phase(CArgsP a, int l, int gw, int NGW, int lane) {
    const bf16* __restrict__ AU = (const bf16*)(a->ws + WS_AU); bf16* __restrict__ ACT = (bf16*)(a->ws + WS_ACT);
    const float* __restrict__ cw = a->in[IN_CONVW] + (size_t)l * 3 * DFF; const float* __restrict__ cb = a->in[IN_CONVB] + (size_t)l * DFF; const float* __restrict__ cpast = a->in[IN_CONV] + (size_t)l * 16 * 2 * DFF;
    float* __restrict__ outp = a->out;
    constexpr int CG = DFF / 8;
    constexpr int NIT = kR * CG;
    constexpr int U = 4;
    const int stride = NGW * 64;
    for (int it0 = gw * 64 + lane; it0 < NIT; it0 += U * stride) {
        v4u wa[U], wu[U], w1[U], w2[U]; int row[U], c0[U]; bool ok[U];
#pragma unroll
        for (int k = 0; k < U; ++k) { const int it = it0 + k * stride; ok[k] = it < NIT; const int itc = ok[k] ? it : it0; row[k] = itc / CG; c0[k] = (itc % CG) * 8;
            const bool prompt = row[k] < kRP; const int t = prompt ? (row[k] & 2047) : ((row[k] - kRP) & 31);
            const bf16* ap = AU + (size_t)row[k] * 5632 + c0[k];
            wa[k] = *(const v4u*)ap; wu[k] = *(const v4u*)(ap + DFF);
            w1[k] = *(const v4u*)(ap - (t >= 1 ? 5632 : 0)); w2[k] = *(const v4u*)(ap - (t >= 2 ? 2 * 5632 : 0)); }
#pragma unroll
        for (int k = 0; k < U; ++k) { if (!ok[k]) continue;
            const bool prompt = row[k] < kRP; const int t = prompt ? (row[k] & 2047) : ((row[k] - kRP) & 31); const int b = prompt ? (row[k] >> 11) : ((row[k] - kRP) >> 5); const int S = prompt ? 2048 : 32;
            const int cc = c0[k];
            float a0[8] = {bflo(wa[k].x), bfhi(wa[k].x), bflo(wa[k].y), bfhi(wa[k].y), bflo(wa[k].z), bfhi(wa[k].z), bflo(wa[k].w), bfhi(wa[k].w)};
            float uu[8] = {bflo(wu[k].x), bfhi(wu[k].x), bflo(wu[k].y), bfhi(wu[k].y), bflo(wu[k].z), bfhi(wu[k].z), bflo(wu[k].w), bfhi(wu[k].w)};
            float a1[8] = {bflo(w1[k].x), bfhi(w1[k].x), bflo(w1[k].y), bfhi(w1[k].y), bflo(w1[k].z), bfhi(w1[k].z), bflo(w1[k].w), bfhi(w1[k].w)};
            float a2[8] = {bflo(w2[k].x), bfhi(w2[k].x), bflo(w2[k].y), bfhi(w2[k].y), bflo(w2[k].z), bfhi(w2[k].z), bflo(w2[k].w), bfhi(w2[k].w)};
            if (t < 1) {
#pragma unroll
                for (int i = 0; i < 8; ++i) a1[i] = prompt ? 0.f : cpast[((size_t)b * 2 + 1) * DFF + cc + i]; }
            if (t < 2) {
#pragma unroll
                for (int i = 0; i < 8; ++i) a2[i] = prompt ? 0.f : cpast[((size_t)b * 2 + t) * DFF + cc + i]; }
            const f32x4 c00 = *(const f32x4*)(cw + cc), c01 = *(const f32x4*)(cw + cc + 4), c10 = *(const f32x4*)(cw + DFF + cc), c11 = *(const f32x4*)(cw + DFF + cc + 4),
                        c20 = *(const f32x4*)(cw + 2 * DFF + cc), c21 = *(const f32x4*)(cw + 2 * DFF + cc + 4), b0 = *(const f32x4*)(cb + cc), b1 = *(const f32x4*)(cb + cc + 4);
            const float w0[8] = {c00.x, c00.y, c00.z, c00.w, c01.x, c01.y, c01.z, c01.w}, w1f[8] = {c10.x, c10.y, c10.z, c10.w, c11.x, c11.y, c11.z, c11.w},
                        w2f[8] = {c20.x, c20.y, c20.z, c20.w, c21.x, c21.y, c21.z, c21.w}, bb[8] = {b0.x, b0.y, b0.z, b0.w, b1.x, b1.y, b1.z, b1.w};
            float o[8];
#pragma unroll
            for (int i = 0; i < 8; ++i) { const float cv = a2[i] * w0[i] + a1[i] * w1f[i] + a0[i] * w2f[i] + bb[i];
                o[i] = cv * __builtin_amdgcn_rcpf(1.f + __expf(-cv)) * uu[i]; }
            v4u w; w.x = pk2(o[0], o[1]); w.y = pk2(o[2], o[3]); w.z = pk2(o[4], o[5]); w.w = pk2(o[6], o[7]);
            *(v4u*)(ACT + (size_t)row[k] * DFF + cc) = w;
            if (t >= S - 2) { float* od = outp + (prompt ? OUT_PCONV + ((size_t)l * 8 + b) * 2 * DFF : OUT_SCONV + ((size_t)l * 16 + b) * 2 * DFF) + (size_t)(t - (S - 2)) * DFF + cc;
                *(f32x4*)od = (f32x4){a0[0], a0[1], a0[2], a0[3]}; *(f32x4*)(od + 4) = (f32x4){a0[4], a0[5], a0[6], a0[7]}; }
        }
    }
}
#define XB_TMO      128
#define XB_XCNT(j)  (256  + 64 * (j))
#define XB_XSUB(j)  (1280 + 64 * (j))
#define XB_XGEN(j)  (2304 + 64 * (j))
#define XB_TOP      3328
#define XB_TOPGEN   3392
#define XCD_BAR_WORDS 3456
#define XB_SPIN_CAP (1u << 18)

__device__ __forceinline__ unsigned xb_ld(unsigned* p)              { return __hip_atomic_load(p, __ATOMIC_RELAXED, __HIP_MEMORY_SCOPE_AGENT); }
__device__ __forceinline__ unsigned xb_add(unsigned* p, unsigned v) { return __hip_atomic_fetch_add(p, v, __ATOMIC_RELAXED, __HIP_MEMORY_SCOPE_AGENT); }
__device__ __forceinline__ unsigned xb_xcc_id() { return (unsigned)__builtin_amdgcn_s_getreg((3 << 11) | 20) & 0xFu; }
#define XB_SPIN(cond, bar) do { unsigned _sp = 0; while (cond) { __builtin_amdgcn_s_sleep(1); \
    if ((++_sp & 255u) == 0u) { if (xb_ld(&(bar)[XB_TMO])) break; if (_sp > XB_SPIN_CAP) { atomicAdd(&(bar)[XB_TMO], 1u); break; } } } } while (0)

struct XcdBarrier {
    unsigned* bar; unsigned x;
    volatile LAS unsigned* st;
};

__device__ __forceinline__ XcdBarrier xcd_barrier_post(unsigned* bar, volatile LAS unsigned* st, bool t0  ) {
    XcdBarrier b; b.bar = bar; b.x = xb_xcc_id(); b.st = st;
    if (t0) (void)xb_add(&bar[XB_XCNT(b.x)], 1u);
    return b;
}
__device__ __forceinline__ void xcd_barrier_complete(unsigned* bar, unsigned x, unsigned& nloc, unsigned& nx) {
    const unsigned G = gridDim.x * gridDim.y * gridDim.z;
    unsigned sum, cnt, mine, sp = 0u;
    for (;;) {
        sum = 0u; cnt = 0u; mine = 0u;
#pragma unroll
        for (unsigned j = 0; j < 16; ++j) { const unsigned c = xb_ld(&bar[XB_XCNT(j)]); sum += c; cnt += (c > 0u) ? 1u : 0u; mine = (j == x) ? c : mine; }
        if (sum == G) break;
        __builtin_amdgcn_s_sleep(1);
        if ((++sp & 255u) == 0u) { if (xb_ld(&bar[XB_TMO])) break; if (sp > XB_SPIN_CAP) { atomicAdd(&bar[XB_TMO], 1u); break; } }
    }
    nloc = mine > 0u ? mine : 1u; nx = cnt > 0u ? cnt : 1u;
}

__device__ __forceinline__ void xcd_barrier(const XcdBarrier& b, bool t0  ) {
    asm volatile("s_waitcnt vmcnt(0)" ::: "memory");
    __syncthreads();
    if (t0) {
        unsigned* bar = b.bar;
        __builtin_amdgcn_s_waitcnt(0);
        unsigned nloc = b.st[0], nx = b.st[1];
        if (nloc == 0u) { xcd_barrier_complete(bar, b.x, nloc, nx); b.st[0] = nloc; b.st[1] = nx; }
        const unsigned old = xb_add(&bar[XB_XSUB(b.x)], 1u);
        const unsigned gen = old / nloc;
        if (old + 1u == (gen + 1u) * nloc) {
            __builtin_amdgcn_fence(__ATOMIC_RELEASE, "agent");
            asm volatile("s_waitcnt vmcnt(0)" ::: "memory");
            const unsigned og = xb_add(&bar[XB_TOP], 1u);
            const unsigned tg = og / nx;
            if (og + 1u == (tg + 1u) * nx) xb_add(&bar[XB_TOPGEN], 1u);
            else XB_SPIN(xb_ld(&bar[XB_TOPGEN]) == tg, bar);
            __builtin_amdgcn_fence(__ATOMIC_ACQUIRE, "agent");
            xb_add(&bar[XB_XGEN(b.x)], 1u);
            asm volatile("s_waitcnt vmcnt(0)" ::: "memory");
        } else {
            XB_SPIN(xb_ld(&bar[XB_XGEN(b.x)]) == gen, bar);
            __builtin_amdgcn_fence(__ATOMIC_ACQUIRE, "agent");
            asm volatile("s_waitcnt vmcnt(0)" ::: "memory");
        }
    }
    __syncthreads();
}
namespace att {
typedef short bf16x8 __attribute__((ext_vector_type(8)));
typedef short s16x4 __attribute__((ext_vector_type(4)));
typedef float f32x16 __attribute__((ext_vector_type(16)));
enum { MLA = 0, SBK = 1, DIFF = 2 };
template <int N> struct IC { static constexpr int value = N; };
template <int MODE> struct Cfg {
    static constexpr int DQK = MODE == MLA ? 96 : 64;
    static constexpr int NMAP = MODE == DIFF ? 2 : 1;
    static constexpr int KW = MODE == MLA ? 96 : (MODE == DIFF ? 128 : 64);
    static constexpr int DV = MODE == DIFF ? 128 : 64;
    static constexpr int KP = KW * 2 + 16;
    static constexpr int VP = MODE == DIFF ? 320 : 192;
    static constexpr int KS = DQK / 16, DT = DV / 32;
    static constexpr int KWS = MODE == MLA ? 96 : 64;
    static constexpr int KPS = KWS * 2 + 16;
};
__device__ __forceinline__ unsigned cvtpk(float lo, float hi) { typedef float f2 __attribute__((ext_vector_type(2))); typedef __bf16 b2 __attribute__((ext_vector_type(2)));
    f2 v = {lo, hi}; b2 b = __builtin_convertvector(v, b2); return __builtin_bit_cast(unsigned, b); }
__device__ __forceinline__ bf16x8 pack8(const f32x16& p, int s8) {
    v4u w; w.x = cvtpk(p[s8 + 0], p[s8 + 1]); w.y = cvtpk(p[s8 + 2], p[s8 + 3]); w.z = cvtpk(p[s8 + 4], p[s8 + 5]); w.w = cvtpk(p[s8 + 6], p[s8 + 7]); return __builtin_bit_cast(bf16x8, w); }
__device__ __forceinline__ s16x4 vtr(LAS const unsigned char* p) { typedef short v4i16_t __attribute__((ext_vector_type(4)));
    return __builtin_bit_cast(s16x4, __builtin_amdgcn_ds_read_tr16_b64_v4i16((LAS v4i16_t*)p)); }
__device__ __forceinline__ float ex2(float x) { return __builtin_amdgcn_exp2f(x); }
__device__ __forceinline__ float lg2(float x) { return __builtin_amdgcn_logf(x); }

template <int KS> __device__ __forceinline__ f32x16 qk_sub(LAS const unsigned char* Kt, int kpitch, const bf16x8 (&qf)[KS], int r32, int hi) {
    f32x16 p = {0.f, 0.f, 0.f, 0.f, 0.f, 0.f, 0.f, 0.f, 0.f, 0.f, 0.f, 0.f, 0.f, 0.f, 0.f, 0.f};
    LAS const unsigned char* kb = Kt + r32 * kpitch + hi * 16;
#pragma unroll
    for (int ks = 0; ks < KS; ++ks) { const bf16x8 kf = *(LAS const bf16x8*)(kb + ks * 32); p = __builtin_amdgcn_mfma_f32_32x32x16_bf16(kf, qf[ks], p, 0, 0, 0); }
    return p;
}
__device__ __forceinline__ bf16x8 v_frag(LAS const unsigned char* Vt, int vpitch, int dt, int s, int lane) {
    const int i = lane & 15, g1 = (lane >> 4) & 1, hi = lane >> 5;
    LAS const unsigned char* a = Vt + (16 * s + 4 * hi + (i >> 2)) * vpitch + (32 * dt + 16 * g1 + 4 * (i & 3)) * 2;
    const s16x4 lo = vtr(a), hh = vtr(a + 8 * vpitch);
    return (bf16x8){lo[0], lo[1], lo[2], lo[3], hh[0], hh[1], hh[2], hh[3]};
}

__device__ __forceinline__ void store_pair16(bf16* p, v2u wk, v2u wk1, int hi) {
    auto r0 = __builtin_amdgcn_permlane32_swap(wk.x, wk1.x, false, false); auto r1 = __builtin_amdgcn_permlane32_swap(wk.y, wk1.y, false, false);
    v4u o; o.x = r0[0]; o.y = r1[0]; o.z = r0[1]; o.w = r1[1];
    *(v4u*)(p + (hi ? 8 : 0)) = o;
}
__device__ __forceinline__ void softmax_update(f32x16& p, float& m, float& l, float& alpha) {
    float mx = p[0];
#pragma unroll
    for (int r = 1; r < 16; ++r) mx = fmaxf(mx, p[r]);
    mx = half_max(mx);
    const float mn = fmaxf(m, mx); alpha = ex2(m - mn); m = mn;
    float s = 0.f;
#pragma unroll
    for (int r = 0; r < 16; ++r) { p[r] = ex2(p[r] - mn); s += p[r]; }
    l = l * alpha + s;
}
__device__ __forceinline__ void softmax_update2(f32x16& pa, f32x16& pb, float& m, float& l, float& alpha) {
    float mx = fmaxf(pa[0], pb[0]);
#pragma unroll
    for (int r = 1; r < 16; ++r) mx = fmaxf(mx, fmaxf(pa[r], pb[r]));
    mx = half_max(mx);
    const float mn = fmaxf(m, mx); alpha = ex2(m - mn); m = mn;
    float s0 = 0.f, s1 = 0.f;
#pragma unroll
    for (int r = 0; r < 16; ++r) { pa[r] = ex2(pa[r] - mn); pb[r] = ex2(pb[r] - mn); s0 += pa[r]; s1 += pb[r]; }
    l = l * alpha + (s0 + s1);
}
__device__ __forceinline__ void sb_update(f32x16& p, unsigned vmask, float& C, int hi) {
    float lnb[16];
#pragma unroll
    for (int r = 0; r < 16; ++r) { const float t = p[r]; const float w = t > 64.0f ? t : lg2(1.0f + ex2(t));
        const bool ok = (vmask >> r) & 1u; lnb[r] = ok ? -w : 0.f; p[r] = t - w; }
    float e[16], T[4], Tp[4];
#pragma unroll
    for (int g = 0; g < 4; ++g) { e[4 * g + 3] = 0.f; e[4 * g + 2] = lnb[4 * g + 3]; e[4 * g + 1] = e[4 * g + 2] + lnb[4 * g + 2]; e[4 * g + 0] = e[4 * g + 1] + lnb[4 * g + 1]; T[g] = e[4 * g] + lnb[4 * g]; }
#pragma unroll
    for (int g = 0; g < 4; ++g) Tp[g] = half_other(T[g], hi);
    const float ps0 = T[0] + Tp[0], ps1 = T[1] + Tp[1], ps2 = T[2] + Tp[2], ps3 = T[3] + Tp[3];
    float Rg[4]; Rg[3] = 0.f; Rg[2] = ps3; Rg[1] = ps3 + ps2; Rg[0] = Rg[1] + ps1;
    const float tot = Rg[0] + ps0;
#pragma unroll
    for (int g = 0; g < 4; ++g) { const float sg = C + Rg[g] + (hi == 0 ? Tp[g] : 0.f);
#pragma unroll
        for (int j = 0; j < 4; ++j) { const int r = 4 * g + j; const bool ok = (vmask >> r) & 1u; p[r] = ok ? ex2(p[r] + sg + e[r]) : 0.f; } }
    C += tot;
}

template <int MODE>
__device__ __forceinline__ void prompt_unit(LAS unsigned char* lds, const bf16* Qb, int qp, const bf16* Kb, int kp, const bf16* Vb, int vp, bf16* Ob, int op, int q0,
                                            int tid, int lane, int wave, float slope2, float lam, float onem_lam_init, const float* subln_g) {
    typedef Cfg<MODE> C;
    constexpr int KS = C::KS, DT = C::DT, KP = C::KP, VP = C::VP;
    constexpr int QROWS = MODE == DIFF ? 128 : 256;
    constexpr int KTB = 64 * KP, VTB = 64 * VP, BUFB = KTB + VTB;
    constexpr int KCR = C::KW / 8, VCR = C::DV / 8;
    constexpr int NKC = (64 * KCR + 511) / 512, NVC = (64 * VCR + 511) / 512;
    constexpr int KTPR = KCR / NKC, VTPR = VCR / NVC;
    static_assert(KCR % NKC == 0 && VCR % NVC == 0 && 64 * KTPR <= 512 && 64 * VTPR <= 512 && 2 * BUFB <= RING_BYTES, "staging map");
    const int r32 = lane & 31, hi = lane >> 5;
    const int wq = MODE == DIFF ? (wave & 3) : wave, map = MODE == DIFF ? (wave >> 2) : 0;
    const int qrow = q0 + 32 * wq + r32;
    bf16x8 qf[KS];
#pragma unroll
    for (int ks = 0; ks < KS; ++ks) qf[ks] = *(const bf16x8*)(Qb + (size_t)qrow * qp + map * 64 + ks * 16 + hi * 8);
    f32x16 o[DT];
#pragma unroll
    for (int dt = 0; dt < DT; ++dt)
#pragma unroll
        for (int r = 0; r < 16; ++r) o[dt][r] = 0.f;
    float mrun = -INFINITY, lrun = 0.f, Ccar = 0.f;
    bool dead = false;
    LAS volatile unsigned* sbflag = (LAS volatile unsigned*)(lds + RING_BYTES + 4352);
    if (MODE == SBK && tid < 16) sbflag[tid] = 0u;
    const int ntiles = (q0 + QROWS) / 64;
    const int cw = (q0 + 32 * wq) / 64;
    v4u kreg[NKC], vreg[NVC];
    const bool kact = tid < 64 * KTPR, vact = tid < 64 * VTPR;
    const int krow = tid / KTPR, kcc = (tid % KTPR) * NKC, vrow = tid / VTPR, vcc = (tid % VTPR) * NVC;
    const bf16* kgp = Kb + (size_t)krow * kp + kcc * 8; const bf16* vgp = Vb + (size_t)vrow * vp + vcc * 8;
    LAS unsigned char* klp = lds + krow * KP + kcc * 16; LAS unsigned char* vlp = lds + KTB + vrow * VP + vcc * 16;
    LAS const unsigned char* kfp = lds + r32 * KP + hi * 16 + map * 128;
    LAS const unsigned char* vfp = lds + KTB + (4 * hi + ((lane & 15) >> 2)) * VP + (16 * ((lane >> 4) & 1) + 4 * (lane & 3)) * 2;
    auto issue = [&](int jt) {
        if (kact) {
#pragma unroll
            for (int i = 0; i < NKC; ++i) kreg[i] = *(const v4u*)(kgp + (size_t)jt * 64 * kp + i * 8); }
        if (vact) {
#pragma unroll
            for (int i = 0; i < NVC; ++i) vreg[i] = *(const v4u*)(vgp + (size_t)jt * 64 * vp + i * 8); }
    };
    auto commit = [&](auto BUFC) {
        constexpr int buf = decltype(BUFC)::value;
        if (kact) {
#pragma unroll
            for (int i = 0; i < NKC; ++i) *(LAS v4u*)(klp + buf * BUFB + i * 16) = kreg[i]; }
        if (vact) {
#pragma unroll
            for (int i = 0; i < NVC; ++i) *(LAS v4u*)(vlp + buf * BUFB + i * 16) = vreg[i]; }
    };
    auto step = [&](int it, auto CURC) {
        constexpr int cur = decltype(CURC)::value;
        const int jt = ntiles - 1 - it;
        if (it + 1 < ntiles) issue(jt - 1);
        if (jt <= cw && !dead) {
            f32x16 p1 = {0.f, 0.f, 0.f, 0.f, 0.f, 0.f, 0.f, 0.f, 0.f, 0.f, 0.f, 0.f, 0.f, 0.f, 0.f, 0.f}, p0 = p1;
            bf16x8 kf1[KS], kf0[KS];
#pragma unroll
            for (int ks = 0; ks < KS; ++ks) { kf1[ks] = *(LAS const bf16x8*)(kfp + cur * BUFB + 32 * KP + ks * 32); kf0[ks] = *(LAS const bf16x8*)(kfp + cur * BUFB + ks * 32); }
            __builtin_amdgcn_s_setprio(1);
#pragma unroll
            for (int ks = 0; ks < KS; ++ks) { p1 = __builtin_amdgcn_mfma_f32_32x32x16_bf16(kf1[ks], qf[ks], p1, 0, 0, 0); p0 = __builtin_amdgcn_mfma_f32_32x32x16_bf16(kf0[ks], qf[ks], p0, 0, 0, 0); }
            __builtin_amdgcn_s_setprio(0);
            const int base0 = qrow - jt * 64 - 4 * hi, base1 = base0 - 32;
            if constexpr (MODE == SBK) {
                unsigned vm1 = 0xffffu, vm0 = 0xffffu;
                if (jt == cw) { vm1 = 0u; vm0 = 0u;
#pragma unroll
                    for (int r = 0; r < 16; ++r) { vm1 |= (((r & 3) + 8 * (r >> 2)) < base1 ? 1u : 0u) << r; vm0 |= (((r & 3) + 8 * (r >> 2)) < base0 ? 1u : 0u) << r; } }
                sb_update(p1, vm1, Ccar, hi); sb_update(p0, vm0, Ccar, hi);
            } else {
                if constexpr (MODE == DIFF) { const float f0 = (float)base0, f1 = (float)base1;
#pragma unroll
                    for (int r = 0; r < 16; ++r) { const float cr = (float)((r & 3) + 8 * (r >> 2)); p0[r] -= slope2 * fabsf(f0 - cr); p1[r] -= slope2 * fabsf(f1 - cr); } }
                float alpha; softmax_update2(p0, p1, mrun, lrun, alpha);
                if (__any(alpha != 1.0f)) {
#pragma unroll
                    for (int dt = 0; dt < DT; ++dt)
#pragma unroll
                        for (int r = 0; r < 16; ++r) o[dt][r] *= alpha; }
            }
            const bf16x8 pf[4] = {pack8(p0, 0), pack8(p0, 8), pack8(p1, 0), pack8(p1, 8)};
#pragma unroll
            for (int dt = 0; dt < DT; ++dt) {
                bf16x8 vf[4];
#pragma unroll
                for (int s = 0; s < 4; ++s) { LAS const unsigned char* va = vfp + cur * BUFB + (16 * s) * VP + dt * 64;
                    const s16x4 lo = vtr(va), hh = vtr(va + 8 * VP); vf[s] = (bf16x8){lo[0], lo[1], lo[2], lo[3], hh[0], hh[1], hh[2], hh[3]}; }
                __builtin_amdgcn_s_setprio(1);
#pragma unroll
                for (int s = 0; s < 4; ++s) o[dt] = __builtin_amdgcn_mfma_f32_32x32x16_bf16(vf[s], pf[s], o[dt], 0, 0, 0);
                __builtin_amdgcn_s_setprio(0);
            }
            if constexpr (MODE == SBK) { if (__all(Ccar < -160.0f)) { dead = true; if (lane == 0) sbflag[wave] = 1u; } }
        }
        if (it + 1 < ntiles) commit(IC<(cur ^ 1)>{});
        __syncthreads();
    };
    issue(ntiles - 1); commit(IC<0>{});
    __syncthreads();
    __builtin_amdgcn_s_waitcnt(0x0F70);
#pragma unroll 1
    for (int it = 0; it < ntiles; it += 2) {
        if constexpr (MODE == SBK) {
            if (it > 0) { if (tid == 0) { unsigned n = 0; for (int w = 0; w < 8; ++w) n += sbflag[w]; sbflag[8] = n; }
                __syncthreads(); if (sbflag[8] == 8u) break; }
        }
        step(it, IC<0>{}); step(it + 1, IC<1>{});
    }
    bf16* orow = Ob + (size_t)qrow * op;
    if constexpr (MODE == MLA) {
        const float inv = 1.0f / half_sum(lrun);
#pragma unroll
        for (int dt = 0; dt < DT; ++dt)
#pragma unroll
            for (int g = 0; g < 4; g += 2) { v2u w0, w1; w0.x = cvtpk(o[dt][4 * g] * inv, o[dt][4 * g + 1] * inv); w0.y = cvtpk(o[dt][4 * g + 2] * inv, o[dt][4 * g + 3] * inv);
                w1.x = cvtpk(o[dt][4 * g + 4] * inv, o[dt][4 * g + 5] * inv); w1.y = cvtpk(o[dt][4 * g + 6] * inv, o[dt][4 * g + 7] * inv);
                store_pair16(orow + 32 * dt + 8 * g, w0, w1, hi); }
    } else if constexpr (MODE == SBK) {
#pragma unroll
        for (int dt = 0; dt < DT; ++dt)
#pragma unroll
            for (int g = 0; g < 4; g += 2) { v2u w0, w1; w0.x = cvtpk(o[dt][4 * g], o[dt][4 * g + 1]); w0.y = cvtpk(o[dt][4 * g + 2], o[dt][4 * g + 3]);
                w1.x = cvtpk(o[dt][4 * g + 4], o[dt][4 * g + 5]); w1.y = cvtpk(o[dt][4 * g + 6], o[dt][4 * g + 7]);
                store_pair16(orow + 32 * dt + 8 * g, w0, w1, hi); }
    } else {
        LAS float* xo = (LAS float*)lds + wq * (128 * 32);
        const float inv = (map == 1 ? lam : 1.0f) / half_sum(lrun);
        if (map == 1) {
#pragma unroll
            for (int dt = 0; dt < DT; ++dt)
#pragma unroll
                for (int r = 0; r < 16; ++r) xo[(32 * dt + 8 * (r >> 2) + 4 * hi + (r & 3)) * 32 + r32] = o[dt][r] * inv;
        }
        __syncthreads();
        if (map == 0) {
            float ss = 0.f;
#pragma unroll
            for (int dt = 0; dt < DT; ++dt)
#pragma unroll
                for (int r = 0; r < 16; ++r) { const float v = o[dt][r] * inv - xo[(32 * dt + 8 * (r >> 2) + 4 * hi + (r & 3)) * 32 + r32]; o[dt][r] = v; ss += v * v; }
            ss = half_sum(ss);
            const float rs = rsqrtf(ss * (1.0f / 128.0f) + kEPS) * onem_lam_init;
#pragma unroll
            for (int dt = 0; dt < DT; ++dt)
#pragma unroll
                for (int g = 0; g < 4; g += 2) { const int d = 32 * dt + 8 * g + 4 * hi; const f32x4 g0 = *(const f32x4*)(subln_g + d), g1 = *(const f32x4*)(subln_g + d + 8);
                    v2u w0, w1; w0.x = cvtpk(o[dt][4 * g] * rs * g0.x, o[dt][4 * g + 1] * rs * g0.y); w0.y = cvtpk(o[dt][4 * g + 2] * rs * g0.z, o[dt][4 * g + 3] * rs * g0.w);
                    w1.x = cvtpk(o[dt][4 * g + 4] * rs * g1.x, o[dt][4 * g + 5] * rs * g1.y); w1.y = cvtpk(o[dt][4 * g + 6] * rs * g1.z, o[dt][4 * g + 7] * rs * g1.w);
                    store_pair16(orow + 32 * dt + 8 * g, w0, w1, hi); }
        }
        __syncthreads();
    }
}

struct SampleSrc {
    const void* kc; int kcp; const void* vc; int vcp;
    const bf16* kn; int knp; const bf16* vn; int vnp;
    const bf16* q; int qp;
};
template <int MODE>
__device__ __forceinline__ void sample_unit(LAS unsigned char* lds, LAS unsigned char* xch, const SampleSrc& S, bf16* Ob  , int op,
                                            int tid, int lane, int wave, float slope2, float lam, float onem_lam_init, const float* subln_g, const float* wuv = nullptr  ) {
    typedef Cfg<MODE> C;
    constexpr int KS = C::KS, KP = C::KPS, KWS = C::KWS, DV = MODE == MLA ? 128 : C::DV, DT = DV / 32, VP = MODE == MLA ? 272 : C::VP;
    constexpr bool CF32 = MODE != MLA;
    constexpr int KTB = 32 * KP, VTB = 32 * VP, WB = (KTB + VTB + 255) & ~255;
    constexpr int NKC = 32 * KWS / 8 / 64, NVH = 16 * DV / 8 / 64;
    static_assert(8 * WB <= RING_BYTES, "sample staging");
    constexpr int KLPR = (KWS / 8) / NKC, VLPR = (DV / 8) / NVH;
    static_assert(32 * KLPR == 64 && 16 * VLPR == 64, "sample staging map");
    const int r32 = lane & 31, hi = lane >> 5;
    const int krow = lane / KLPR, kcc = (lane % KLPR) * NKC, vrow = lane / VLPR, vcc = (lane % VLPR) * NVH;
    constexpr int NG = MODE == DIFF ? 2 : 1, WPG = 8 / NG;
    const int wi = wave % WPG;
    LAS unsigned char* kb = lds + wave * WB; LAS unsigned char* vb = kb + KTB;
    constexpr bool QLDS = MODE == DIFF || MODE == MLA;
    bf16x8 qf[QLDS ? 1 : KS];
    LAS unsigned char* qlp = lds + 8 * WB + (wave / WPG) * (KS * 1024) + lane * 16;
    static_assert(!QLDS || 8 * WB + NG * KS * 1024 <= RING_BYTES, "sample Q LDS");
    { bf16x8 qtmp[KS];
#pragma unroll
      for (int ks = 0; ks < KS; ++ks) qtmp[ks] = __builtin_nontemporal_load((const bf16x8*)(S.q + (size_t)r32 * S.qp + ks * 16 + hi * 8));
#pragma unroll
      for (int ks = 0; ks < KS; ++ks) { if constexpr (QLDS) *(LAS bf16x8*)(qlp + ks * 1024) = qtmp[ks]; else qf[ks] = qtmp[ks]; } }
    f32x16 o[DT];
#pragma unroll
    for (int dt = 0; dt < DT; ++dt)
#pragma unroll
        for (int r = 0; r < 16; ++r) o[dt][r] = 0.f;
    float mrun = -INFINITY, lrun = 0.f, Ccar = 0.f;
    const int qpos = PASTL + r32;

    bf16x8 pf[2];
    auto computeA = [&](int kpos0, bool diag) {
        f32x16 p = {0.f, 0.f, 0.f, 0.f, 0.f, 0.f, 0.f, 0.f, 0.f, 0.f, 0.f, 0.f, 0.f, 0.f, 0.f, 0.f};
        { LAS const unsigned char* kq = kb + r32 * KP + hi * 16;
#pragma unroll
          for (int ks = 0; ks < KS; ++ks) { const bf16x8 kf = *(LAS const bf16x8*)(kq + ks * 32); bf16x8 qq; if constexpr (QLDS) qq = *(LAS const bf16x8*)(qlp + ks * 1024); else qq = qf[ks];
              p = __builtin_amdgcn_mfma_f32_32x32x16_bf16(kf, qq, p, 0, 0, 0); } }
        const int base = qpos - kpos0 - 4 * hi;
        if constexpr (MODE == SBK) {
            unsigned vmask = 0xffffu;
            if (diag) { vmask = 0u;
#pragma unroll
                for (int r = 0; r < 16; ++r) vmask |= (((r & 3) + 8 * (r >> 2)) < base ? 1u : 0u) << r; }
            sb_update(p, vmask, Ccar, hi);
        } else {
            if constexpr (MODE == DIFF) { const float fb = (float)base;
#pragma unroll
                for (int r = 0; r < 16; ++r) p[r] -= slope2 * fabsf(fb - (float)((r & 3) + 8 * (r >> 2))); }
            float alpha; softmax_update(p, mrun, lrun, alpha);
            if (__any(alpha != 1.0f)) {
#pragma unroll
                for (int dt = 0; dt < DT; ++dt)
#pragma unroll
                    for (int r = 0; r < 16; ++r) o[dt][r] *= alpha; }
        }
        pf[0] = pack8(p, 0); pf[1] = pack8(p, 8);
#pragma unroll
        for (int dt = 0; dt < DT; ++dt) { const bf16x8 vf = v_frag(vb, VP, dt, 0, lane); o[dt] = __builtin_amdgcn_mfma_f32_32x32x16_bf16(vf, pf[0], o[dt], 0, 0, 0); }
    };
    auto computeB = [&]() {
#pragma unroll
        for (int dt = 0; dt < DT; ++dt) { const bf16x8 vf = v_frag(vb, VP, dt, 1, lane); o[dt] = __builtin_amdgcn_mfma_f32_32x32x16_bf16(vf, pf[1], o[dt], 0, 0, 0); }
    };
    auto new_rows = [&]() {
        int ln2 = lane; asm volatile("" : "+v"(ln2));
        const int krow = ln2 / KLPR, kcc = (ln2 % KLPR) * NKC, vrow = ln2 / VLPR, vcc = (ln2 % VLPR) * NVH;
#pragma unroll
        for (int i = 0; i < NKC; ++i) *(LAS v4u*)(kb + krow * KP + (kcc + i) * 16) = *(const v4u*)(S.kn + (size_t)krow * S.knp + (kcc + i) * 8);
#pragma unroll
        for (int hf = 0; hf < 2; ++hf)
#pragma unroll
            for (int i = 0; i < NVH; ++i) *(LAS v4u*)(vb + (16 * hf + vrow) * VP + (vcc + i) * 16) = *(const v4u*)(S.vn + (size_t)(16 * hf + vrow) * S.vnp + (vcc + i) * 8);
        computeA(PASTL, true); computeB();
    };
    if (MODE == SBK && wi == WPG - 1) new_rows();
    constexpr int SPW = 128 / WPG;
    const int s_lo = wi * SPW, s_hi = s_lo + SPW;
    constexpr int NKR = CF32 ? 2 * NKC : NKC, NVR = CF32 ? 2 * NVH : NVH;
    v4u kr[NKR], vr[2][NVR];
    auto cvt8 = [&](const v4u& a, const v4u& b) { v4u w; w.x = cvtpk(__uint_as_float(a.x), __uint_as_float(a.y)); w.y = cvtpk(__uint_as_float(a.z), __uint_as_float(a.w));
        w.z = cvtpk(__uint_as_float(b.x), __uint_as_float(b.y)); w.w = cvtpk(__uint_as_float(b.z), __uint_as_float(b.w)); return w; };
    constexpr int ESZ = CF32 ? 4 : 2;
    const unsigned kgo = (unsigned)((krow * S.kcp + kcc * 8) * ESZ), vgo = (unsigned)((vrow * S.vcp + vcc * 8) * ESZ);
    LAS unsigned char* kll = kb + krow * KP + kcc * 16; LAS unsigned char* vll = vb + vrow * VP + vcc * 16;
    constexpr int LK = KWS * 4 / 16, LV = DV * 4 / 16;
    const unsigned kgo32 = (unsigned)(((lane / LK) * S.kcp) * 4 + (lane % LK) * 16), vgo32 = (unsigned)(((lane / LV) * S.vcp) * 4 + (lane % LV) * 16);
    LAS unsigned char* kll32 = kb + (lane / LK) * KP + (lane % LK) * 8; LAS unsigned char* vll32 = vb + (lane / LV) * VP + (lane % LV) * 8;
    unsigned kof[CF32 ? 1 : NKC]; unsigned vof0 = 0;
    if constexpr (!CF32) { int lnk = lane; asm volatile("" : "+v"(lnk));
#pragma unroll
        for (int i = 0; i < NKC; ++i) { const int p = 64 * i + lnk, row = p / (KWS / 8), ch = p % (KWS / 8); kof[i] = (unsigned)((row * S.kcp + ch * 8) * 2); }
        vof0 = (unsigned)(((lnk / (DV / 8)) * S.vcp + (lnk % (DV / 8)) * 8) * 2); }
    auto issue = [&](int s) {
        if constexpr (CF32) {
            const unsigned char* g = (const unsigned char*)S.kc + (size_t)(32 * s) * S.kcp * 4;
#pragma unroll
            for (int i = 0; i < NKR; ++i) kr[i] = __builtin_nontemporal_load((const v4u*)(g + kgo32 + (size_t)i * (64 / LK) * S.kcp * 4));
#pragma unroll
            for (int hf = 0; hf < 2; ++hf) { const unsigned char* gv = (const unsigned char*)S.vc + (size_t)(32 * s + 16 * hf) * S.vcp * 4;
#pragma unroll
                for (int i = 0; i < NVR; ++i) vr[hf][i] = __builtin_nontemporal_load((const v4u*)(gv + vgo32 + (size_t)i * (64 / LV) * S.vcp * 4)); }
        } else {
            const unsigned char* g = (const unsigned char*)S.kc + (size_t)(32 * s) * S.kcp * 2;
#pragma unroll
            for (int i = 0; i < NKR; ++i) kr[i] = __builtin_nontemporal_load((const v4u*)(g + kof[i]));
#pragma unroll
            for (int hf = 0; hf < 2; ++hf) { const unsigned char* gv = (const unsigned char*)S.vc + (size_t)(32 * s + 16 * hf) * S.vcp * 2;
#pragma unroll
                for (int i = 0; i < NVR; ++i) vr[hf][i] = __builtin_nontemporal_load((const v4u*)(gv + vof0 + (unsigned)(i * (64 / (DV / 8)) * S.vcp * 2))); }
        }
    };
    auto cvt4 = [&](const v4u& x) { v2u w; w.x = cvtpk(__uint_as_float(x.x), __uint_as_float(x.y)); w.y = cvtpk(__uint_as_float(x.z), __uint_as_float(x.w)); return w; };
    auto commit = [&]() {
        if constexpr (CF32) {
#pragma unroll
            for (int i = 0; i < NKR; ++i) *(LAS v2u*)(kll32 + i * (64 / LK) * KP) = cvt4(kr[i]);
#pragma unroll
            for (int hf = 0; hf < 2; ++hf)
#pragma unroll
                for (int i = 0; i < NVR; ++i) *(LAS v2u*)(vll32 + (16 * hf + i * (64 / LV)) * VP) = cvt4(vr[hf][i]);
        } else {
#pragma unroll
            for (int i = 0; i < NKC; ++i) { const int p = 64 * i + lane, row = p / (KWS / 8), ch = p % (KWS / 8); *(LAS v4u*)(kb + row * KP + ch * 16) = kr[i]; }
#pragma unroll
            for (int hf = 0; hf < 2; ++hf)
#pragma unroll
                for (int i = 0; i < NVH; ++i) { const int p = 64 * i + lane, row = 16 * hf + p / (DV / 8), ch = p % (DV / 8); *(LAS v4u*)(vb + row * VP + ch * 16) = vr[hf][i]; }
        }
    };
    issue(s_hi - 1);
#pragma unroll 1
    for (int s = s_hi - 1; s >= s_lo; --s) {
        commit();
        if (s > s_lo) issue(s - 1);
        computeA(32 * s, false);
        computeB();
    }
    if (MODE != SBK && wi == WPG - 1) new_rows();
    f32x4 wreg[MODE == MLA ? 4 : 1];
    if constexpr (MODE == MLA) {
#pragma unroll
        for (int i = 0; i < 4; ++i) { const int p = tid + 512 * i; wreg[i] = *(const f32x4*)(wuv + (size_t)(p >> 4) * 512 + (p & 15) * 4); } }
    __syncthreads();
    LAS float* part = (LAS float*)lds;
    LAS float* st = (LAS float*)xch;
#pragma unroll
    for (int dt = 0; dt < DT; ++dt)
#pragma unroll
        for (int r = 0; r < 16; ++r) part[(wave * DV + 32 * dt + 8 * (r >> 2) + 4 * hi + (r & 3)) * 32 + r32] = o[dt][r];
    if (hi == 0) { st[wave * 32 + r32] = MODE == SBK ? Ccar : mrun; }
    { const float lt = half_sum(lrun); if (hi == 0) st[256 + wave * 32 + r32] = lt; }
    __syncthreads();
    {
        const int q = tid & 31, dg = tid >> 5;
        constexpr int DPG = DV / 16;
        float sc[8];
        if constexpr (MODE == SBK) { float car = 0.f;
#pragma unroll
            for (int w = 7; w >= 0; --w) { sc[w] = ex2(car); car += st[w * 32 + q]; }
        } else {
#pragma unroll
            for (int g = 0; g < NG; ++g) { float M = -INFINITY;
#pragma unroll
                for (int w = 0; w < WPG; ++w) M = fmaxf(M, st[(g * WPG + w) * 32 + q]);
                float L = 0.f;
#pragma unroll
                for (int w = 0; w < WPG; ++w) { const float e = ex2(st[(g * WPG + w) * 32 + q] - M); sc[g * WPG + w] = e; L += e * st[256 + (g * WPG + w) * 32 + q]; }
                const float invL = (g == 1 ? -lam : 1.0f) / L;
#pragma unroll
                for (int w = 0; w < WPG; ++w) sc[g * WPG + w] *= invL; }
        }
        float v[DPG]; float ss = 0.f;
#pragma unroll
        for (int j = 0; j < DPG; ++j) { const int d = dg * DPG + j; float a = 0.f;
#pragma unroll
            for (int w = 0; w < 8; ++w) a += sc[w] * part[(w * DV + d) * 32 + q];
            v[j] = a; ss += a * a; }
        if constexpr (MODE == DIFF) {
            __syncthreads();
            st[dg * 32 + q] = ss;
            __syncthreads();
            float tot = 0.f;
#pragma unroll
            for (int g = 0; g < 16; ++g) tot += st[g * 32 + q];
            const float rs = rsqrtf(tot * (1.0f / 128.0f) + kEPS) * onem_lam_init;
#pragma unroll
            for (int j = 0; j < DPG; ++j) v[j] *= rs * subln_g[dg * DPG + j];
        }
        if constexpr (MODE == MLA) {
            __syncthreads();
            LAS float* lat = (LAS float*)lds;
            LAS float* wl_ = lat + 8192;
            *(LAS f32x4*)(lat + q * 132 + dg * 8) = (f32x4){v[0], v[1], v[2], v[3]}; *(LAS f32x4*)(lat + q * 132 + dg * 8 + 4) = (f32x4){v[4], v[5], v[6], v[7]};
#pragma unroll
            for (int i = 0; i < 4; ++i) { const int p = tid + 512 * i; *(LAS f32x4*)(wl_ + (p >> 4) * 64 + (p & 15) * 4) = wreg[i]; }
            __syncthreads();
            f32x4 acc = {0.f, 0.f, 0.f, 0.f};
#pragma unroll 4
            for (int d0 = 0; d0 < 128; d0 += 4) { const f32x4 l4 = *(LAS const f32x4*)(lat + q * 132 + d0);
#pragma unroll
                for (int j = 0; j < 4; ++j) { const f32x4 w4 = *(LAS const f32x4*)(wl_ + (d0 + j) * 64 + dg * 4); acc += l4[j] * w4; } }
            v2u w; w.x = cvtpk(acc[0], acc[1]); w.y = cvtpk(acc[2], acc[3]); *(v2u*)(Ob + (size_t)q * op + dg * 4) = w;
        } else {
        bf16* od = Ob + (size_t)q * op + dg * DPG;
        if constexpr (DPG == 4) { v2u w; w.x = cvtpk(v[0], v[1]); w.y = cvtpk(v[2], v[3]); *(v2u*)od = w; }
        else { v4u w; w.x = cvtpk(v[0], v[1]); w.y = cvtpk(v[2], v[3]); w.z = cvtpk(v[4], v[5]); w.w = cvtpk(v[6], v[7]); *(v4u*)od = w; }
        }
    }
    __syncthreads();
}
__device__ __forceinline__ void sample_unit_sb(LAS unsigned char* lds, LAS unsigned char* xch, const SampleSrc& S, bf16* Ob, int op, int tid, int lane, int wave) {
    typedef Cfg<SBK> C;
    constexpr int KS = C::KS, DT = C::DT, KP = C::KPS, VP = C::VP, DV = C::DV;
    constexpr int KTB = 32 * KP, VTB = 32 * VP, WB = (KTB + VTB + 255) & ~255;
    static_assert(8 * WB + DV * 32 * 4 <= RING_BYTES && DV * 32 * 4 <= WB, "sb sample LDS");
    const int r32 = lane & 31, hi = lane >> 5;
    LAS unsigned char* kb = lds + wave * WB; LAS unsigned char* vb = kb + KTB;
    LAS float* part = (LAS float*)(lds + wave * WB);
    LAS float* accum = (LAS float*)(lds + 8 * WB);
    LAS float* st = (LAS float*)xch;
    bf16x8 qf[KS];
#pragma unroll
    for (int ks = 0; ks < KS; ++ks) qf[ks] = *(const bf16x8*)(S.q + (size_t)r32 * S.qp + ks * 16 + hi * 8);
    const int qpos = PASTL + r32;
    const int krow = lane >> 1, kcc = (lane & 1) * 4, vrow = lane >> 2, vcc = (lane & 3) * 2;
    for (int i = tid; i < DV * 32; i += 512) accum[i] = 0.f;
    if (tid < 32) st[256 + tid] = 0.f;
    __syncthreads();
    __builtin_amdgcn_s_waitcnt(0x0F70);
    f32x16 o[DT]; float Ccar;
    bf16x8 pf[2];
    auto compute = [&](int kpos0, bool diag) {
        f32x16 p = qk_sub<KS>(kb, KP, qf, r32, hi);
        const int base = qpos - kpos0 - 4 * hi;
        unsigned vmask = 0xffffu;
        if (diag) { vmask = 0u;
#pragma unroll
            for (int r = 0; r < 16; ++r) vmask |= (((r & 3) + 8 * (r >> 2)) < base ? 1u : 0u) << r; }
        sb_update(p, vmask, Ccar, hi);
        pf[0] = pack8(p, 0); pf[1] = pack8(p, 8);
#pragma unroll
        for (int dt = 0; dt < DT; ++dt)
#pragma unroll
            for (int s = 0; s < 2; ++s) { const bf16x8 vf = v_frag(vb, VP, dt, s, lane); o[dt] = __builtin_amdgcn_mfma_f32_32x32x16_bf16(vf, pf[s], o[dt], 0, 0, 0); }
    };
#pragma unroll 1
    for (int rnd = 0; rnd < 16; ++rnd) {
#pragma unroll
        for (int dt = 0; dt < DT; ++dt)
#pragma unroll
            for (int r = 0; r < 16; ++r) o[dt][r] = 0.f;
        Ccar = 0.f;
        const int s = 128 - 8 * (rnd + 1) + wave;
        const float* kc = (const float*)S.kc + (size_t)(32 * s + krow) * S.kcp + kcc * 8; const float* vc = (const float*)S.vc + (size_t)(32 * s + vrow) * S.vcp + vcc * 8;
        v4u kr[8], vr[8];
#pragma unroll
        for (int i = 0; i < 8; ++i) kr[i] = __builtin_nontemporal_load((const v4u*)kc + i);
#pragma unroll
        for (int hf = 0; hf < 2; ++hf)
#pragma unroll
            for (int i = 0; i < 4; ++i) vr[4 * hf + i] = __builtin_nontemporal_load((const v4u*)(vc + (size_t)16 * hf * S.vcp) + i);
        if (rnd == 0 && wave == 7) {
#pragma unroll
            for (int i = 0; i < 4; ++i) *(LAS v4u*)(kb + krow * KP + (kcc + i) * 16) = *(const v4u*)(S.kn + (size_t)krow * S.knp + (kcc + i) * 8);
#pragma unroll
            for (int hf = 0; hf < 2; ++hf)
#pragma unroll
                for (int i = 0; i < 2; ++i) *(LAS v4u*)(vb + (16 * hf + vrow) * VP + (vcc + i) * 16) = *(const v4u*)(S.vn + (size_t)(16 * hf + vrow) * S.vnp + (vcc + i) * 8);
            compute(PASTL, true);
        }
        auto cvt8 = [&](const v4u& x, const v4u& y) { v4u w; w.x = cvtpk(__uint_as_float(x.x), __uint_as_float(x.y)); w.y = cvtpk(__uint_as_float(x.z), __uint_as_float(x.w));
            w.z = cvtpk(__uint_as_float(y.x), __uint_as_float(y.y)); w.w = cvtpk(__uint_as_float(y.z), __uint_as_float(y.w)); return w; };
#pragma unroll
        for (int i = 0; i < 4; ++i) *(LAS v4u*)(kb + krow * KP + (kcc + i) * 16) = cvt8(kr[2 * i], kr[2 * i + 1]);
#pragma unroll
        for (int hf = 0; hf < 2; ++hf)
#pragma unroll
            for (int i = 0; i < 2; ++i) *(LAS v4u*)(vb + (16 * hf + vrow) * VP + (vcc + i) * 16) = cvt8(vr[4 * hf + 2 * i], vr[4 * hf + 2 * i + 1]);
        compute(32 * s, false);
#pragma unroll
        for (int dt = 0; dt < DT; ++dt)
#pragma unroll
            for (int r = 0; r < 16; ++r) part[(32 * dt + 8 * (r >> 2) + 4 * hi + (r & 3)) * 32 + r32] = o[dt][r];
        if (hi == 0) st[wave * 32 + r32] = Ccar;
        __syncthreads();
        {
            const int q = tid & 31, dg = tid >> 5;
            float car = st[256 + q]; float sc[8];
#pragma unroll
            for (int w = 7; w >= 0; --w) { sc[w] = ex2(car); car += st[w * 32 + q]; }
#pragma unroll
            for (int j = 0; j < 4; ++j) { const int d = dg * 4 + j; float v = accum[d * 32 + q];
#pragma unroll
                for (int w = 0; w < 8; ++w) v += sc[w] * ((LAS const float*)(lds + w * WB))[d * 32 + q];
                accum[d * 32 + q] = v; }
            __syncthreads();
            if (tid < 64) { const bool dd = (tid < 32) ? (car < -160.0f) : true; const bool alld = __all(dd); if (tid < 32) st[256 + q] = car; if (tid == 0) st[320] = alld ? 1.f : 0.f; }
            __syncthreads();
        }
        if (st[320] != 0.f) break;
    }
    {
        const int q = tid & 31, dg = tid >> 5;
        v2u w; w.x = cvtpk(accum[(dg * 4 + 0) * 32 + q], accum[(dg * 4 + 1) * 32 + q]); w.y = cvtpk(accum[(dg * 4 + 2) * 32 + q], accum[(dg * 4 + 3) * 32 + q]);
        *(v2u*)(Ob + (size_t)q * op + dg * 4) = w;
    }
    __syncthreads();
}
}

#ifndef ATT_MASK
#define ATT_MASK 63
#endif
#define ATT_LAMBDA() const float* lv = a->in[IN_LAMBDA] + l * 256; const float p1 = wave_sum(lv[lane] * lv[64 + lane]), p2 = wave_sum(lv[128 + lane] * lv[192 + lane]); \
    const float lam_init = 0.8f - 0.6f * expf(-0.3f * (float)l); const float lam = expf(p1) - expf(p2) + lam_init, oml = 1.0f - lam_init; const float* subg = a->in[IN_SUBLN_G] + l * 128;
#define ATT_SITE() const int wave = wave_in; const int lane = hw_lane(); const int tid = wave * 64 + lane;
#define ATT_POP(qi) if (tid == 0) *slot = __hip_atomic_fetch_add(wq + (qi), 1u, __ATOMIC_RELAXED, __HIP_MEMORY_SCOPE_AGENT); __syncthreads(); const int u = (int)*slot; __syncthreads();
template <int AMASK = ATT_MASK> __device__ __forceinline__ void attn_phase(CArgsP a, int l, LAS unsigned char* lds, unsigned* wq  , int wave_in  ) {
    unsigned char* ws = a->ws;
    const bf16* Z = (const bf16*)(ws + WS_Z); const bf16* Qm = (const bf16*)(ws + WS_Q); const bf16* Km = (const bf16*)(ws + WS_KMLA); const bf16* KNMV = (const bf16*)(ws + WS_KNMV);
    const bf16* KMC = (const bf16*)(ws + WS_KMLAC) + (size_t)l * NCACHE * 768; const bf16* KNMVC = (const bf16*)(ws + WS_KNMVC);
    bf16* Omla = (bf16*)(ws + WS_O); bf16* Osb = Omla + (size_t)kR * 512; bf16* Odiff = Osb + (size_t)kR * 512;
    LAS unsigned char* xch = lds + RING_BYTES;
    LAS volatile unsigned* slot = (LAS volatile unsigned*)(xch + 4096);
    if constexpr (AMASK & 1) { ATT_SITE() ATT_LAMBDA() for (;;) { ATT_POP(0) if (u >= 64) break;
        const int b = u >> 2, h = u & 3, gm = wave >> 2;
        att::SampleSrc S;
        S.kc = a->in[IN_CDK] + ((size_t)l * NCACHE + (size_t)b * PASTL) * 512 + (2 * h + gm) * 64; S.kcp = 512;
        S.vc = a->in[IN_CDV] + ((size_t)l * NCACHE + (size_t)b * PASTL) * 512 + h * 128; S.vcp = 512;
        const bf16* zr = Z + (size_t)(kRP + b * 32) * kZW;
        S.kn = zr + ZC_DK + (2 * h + gm) * 64; S.knp = kZW; S.vn = zr + ZC_DV + h * 128; S.vnp = kZW; S.q = zr + ZC_DQ + (2 * h + gm) * 64; S.qp = kZW;
        const float slope2 = exp2f(-2.0f * (float)(h + 1)) * LOG2E;
        att::sample_unit<att::DIFF>(lds, xch, S, Odiff + (size_t)(kRP + b * 32) * 512 + h * 128, 512, tid, lane, wave, slope2, lam, oml, subg); } }
    if constexpr (AMASK & 4) { ATT_SITE() for (;;) { ATT_POP(5) if (u >= 128) break;
        const int b = u >> 3, h = u & 7;
        att::SampleSrc S;
        S.kc = KMC + (size_t)b * PASTL * 768 + h * 96; S.kcp = 768; S.vc = (const bf16*)(ws + WS_CKVB) + ((size_t)l * NCACHE + (size_t)b * PASTL) * 128; S.vcp = 128;
        S.kn = Km + (size_t)(kRP + b * 32) * 768 + h * 96; S.knp = 768; S.vn = Z + (size_t)(kRP + b * 32) * kZW + ZC_CKV; S.vnp = kZW;
        S.q = Qm + (size_t)(kRP + b * 32) * 768 + h * 96; S.qp = 768;
        att::sample_unit<att::MLA>(lds, xch, S, Omla + (size_t)(kRP + b * 32) * 512 + h * 64, 512, tid, lane, wave, 0.f, 0.f, 0.f, nullptr, a->in[IN_WUV] + (size_t)l * 128 * 512 + h * 64); } }
    if constexpr (AMASK & 2) { ATT_SITE() for (;;) { ATT_POP(4) if (u >= 128) break;
        const int b = u >> 3, h = u & 7;
        att::SampleSrc S;
        S.kc = a->in[IN_CSBK] + ((size_t)l * NCACHE + (size_t)b * PASTL) * 512 + h * 64; S.kcp = 512;
        S.vc = a->in[IN_CSBV] + ((size_t)l * NCACHE + (size_t)b * PASTL) * 512 + h * 64; S.vcp = 512;
        const bf16* zr = Z + (size_t)(kRP + b * 32) * kZW;
        S.kn = zr + ZC_SK + h * 64; S.knp = kZW; S.vn = zr + ZC_SV + h * 64; S.vnp = kZW; S.q = zr + ZC_SQ + h * 64; S.qp = kZW;
        att::sample_unit_sb(lds, xch, S, Osb + (size_t)(kRP + b * 32) * 512 + h * 64, 512, tid, lane, wave); } }
    if constexpr (AMASK & 8) { ATT_SITE() ATT_LAMBDA() for (;;) { ATT_POP(1) if (u >= 512) break;
        const int qb = 15 - (u >> 5), w = u & 31, b = w >> 2, h = w & 3; const bf16* zr = Z + (size_t)(b * 2048) * kZW;
        const float slope2 = exp2f(-2.0f * (float)(h + 1)) * LOG2E;
        att::prompt_unit<att::DIFF>(lds, zr + ZC_DQ + h * 128, kZW, zr + ZC_DK + h * 128, kZW, zr + ZC_DV + h * 128, kZW, Odiff + (size_t)(b * 2048) * 512 + h * 128, 512, qb * 128, tid, lane, wave, slope2, lam, oml, subg); } }
    if constexpr (AMASK & 16) { ATT_SITE() for (;;) { ATT_POP(2) if (u >= 512) break;
        const int qb = 7 - (u >> 6), w = u & 63, b = w >> 3, h = w & 7; const bf16* zr = Z + (size_t)(b * 2048) * kZW;
        att::prompt_unit<att::SBK>(lds, zr + ZC_SQ + h * 64, kZW, zr + ZC_SK + h * 64, kZW, zr + ZC_SV + h * 64, kZW, Osb + (size_t)(b * 2048) * 512 + h * 64, 512, qb * 256, tid, lane, wave, 0.f, 0.f, 0.f, nullptr); } }
    if constexpr (AMASK & 32) { ATT_SITE() for (;;) { ATT_POP(3) if (u >= 512) break;
        const int qb = 7 - (u >> 6), w = u & 63, b = w >> 3, h = w & 7;
        att::prompt_unit<att::MLA>(lds, Qm + (size_t)(b * 2048) * 768 + h * 96, 768, Km + (size_t)(b * 2048) * 768 + h * 96, 768, KNMV + (size_t)(b * 2048) * 1024 + 512 + h * 64, 1024,
                                   Omla + (size_t)(b * 2048) * 512 + h * 64, 512, qb * 256, tid, lane, wave, 0.f, 0.f, 0.f, nullptr); } }
    if (l == 0) { ATT_SITE() LAS float* scr = (LAS float*)(lds + wave * 16384);
        for (;;) { ATT_POP(6) if (u >= p0w::NCHUNK) break;
#pragma unroll 1
            for (int k = 0; k < 8; ++k) { const int it = p0w::CL + u * p0w::CHUNK + k * 8 + wave; if (it < 2 * p0w::CL) p0_weight_item(a, it, scr, lane); } } }
}
namespace sm {
typedef short bf16x8 __attribute__((ext_vector_type(8)));
typedef float f32x16 __attribute__((ext_vector_type(16)));
constexpr int ROW0 = 16384, MROWS = 512, NCOLS = 1024, NTILES = (MROWS / 32) * (NCOLS / 32);
template <int KSTEPS  , class Epi>
__device__ __forceinline__ void small_gemm(LAS unsigned char* lds, const bf16* A, int lda, const bf16* Bt, int K, const Epi& E, int blk, int nblk, int wave, int lane) {
    constexpr int CH = KSTEPS <= 11 ? KSTEPS : KSTEPS / 2; static_assert(KSTEPS <= 11 || KSTEPS % 2 == 0, "k split");
    const int c = lane & 31, hi = lane >> 5;
    LAS float* part = (LAS float*)lds;
    for (int t0 = blk; t0 < NTILES; t0 += 2 * nblk) {
        const int t1 = t0 + nblk; const bool two = t1 < NTILES;
        const int ta = t0, tb = two ? t1 : t0;
        const int m0a = ROW0 + 32 * (ta >> 5), n0a = 32 * (ta & 31), m0b = ROW0 + 32 * (tb >> 5), n0b = 32 * (tb & 31);
        const bf16* apa = A + (size_t)(m0a + c) * lda + wave * (KSTEPS * 16) + hi * 8; const bf16* bpa = Bt + (size_t)(n0a + c) * K + wave * (KSTEPS * 16) + hi * 8;
        const bf16* apb = A + (size_t)(m0b + c) * lda + wave * (KSTEPS * 16) + hi * 8; const bf16* bpb = Bt + (size_t)(n0b + c) * K + wave * (KSTEPS * 16) + hi * 8;
        f32x16 acca = {0.f, 0.f, 0.f, 0.f, 0.f, 0.f, 0.f, 0.f, 0.f, 0.f, 0.f, 0.f, 0.f, 0.f, 0.f, 0.f}, accb = acca;
#pragma unroll
        for (int k0 = 0; k0 < KSTEPS; k0 += CH) {
            bf16x8 afa[CH], bfa[CH], afb[CH], bfb[CH];
#pragma unroll
            for (int j = 0; j < CH; ++j) { afa[j] = *(const bf16x8*)(apa + (k0 + j) * 16); bfa[j] = *(const bf16x8*)(bpa + (k0 + j) * 16);
                                           afb[j] = *(const bf16x8*)(apb + (k0 + j) * 16); bfb[j] = *(const bf16x8*)(bpb + (k0 + j) * 16); }
#pragma unroll
            for (int j = 0; j < CH; ++j) { acca = __builtin_amdgcn_mfma_f32_32x32x16_bf16(bfa[j], afa[j], acca, 0, 0, 0); accb = __builtin_amdgcn_mfma_f32_32x32x16_bf16(bfb[j], afb[j], accb, 0, 0, 0); }
        }
#pragma unroll
        for (int r = 0; r < 16; ++r) { part[(wave * 16 + r) * 64 + lane] = acca[r]; part[8192 + (wave * 16 + r) * 64 + lane] = accb[r]; }
        __syncthreads();
        {
            const int g = wave & 3; const bool second = wave >= 4;
            if (!second || two) {
                LAS const float* pp = part + (second ? 8192 : 0);
                f32x4 v = {0.f, 0.f, 0.f, 0.f};
#pragma unroll
                for (int w = 0; w < 8; ++w)
#pragma unroll
                    for (int i = 0; i < 4; ++i) v[i] += pp[(w * 16 + 4 * g + i) * 64 + lane];
                E(v, (second ? m0b : m0a) + c, (second ? n0b : n0a) + 4 * hi + 8 * g, lane);
            }
        }
        __syncthreads();
    }
}
template <int J> struct EpiBranchS {
    const bf16* Z; bf16* P; bf16* Mb;
    __device__ __forceinline__ void operator()(f32x4 v, int row, int col, int lane) const {
        const v2u gw_ = *(const v2u*)(Z + (size_t)row * pg8::kZW + pg8::ZC_G + J * 1024 + col);
        v[0] *= pg8::fast_sigmoid(bflo(gw_.x)); v[1] *= pg8::fast_sigmoid(bfhi(gw_.x)); v[2] *= pg8::fast_sigmoid(bflo(gw_.y)); v[3] *= pg8::fast_sigmoid(bfhi(gw_.y));
        bf16* pp = P + (size_t)row * 1024 + col;
        if (J >= 1) { const v2u q = *(const v2u*)pp; v[0] += bflo(q.x); v[1] += bfhi(q.x); v[2] += bflo(q.y); v[3] += bfhi(q.y); }
        v2u w; w.x = pk2(v[0], v[1]); w.y = pk2(v[2], v[3]);
        *(v2u*)((J <= 1 ? pp : Mb + (size_t)row * 1024 + col)) = w;
    }
};
struct EpiResS {
    const float* Xr; float* X; bf16* Xb; float* ssq_next;
    __device__ __forceinline__ void operator()(f32x4 v, int row, int col, int lane) const {
        float* xp = X + (size_t)row * 1024 + col;
        v += *(const f32x4*)(Xr + (size_t)row * 1024 + col); *(f32x4*)xp = v;
        if (Xb) { v2u w; w.x = pk2(v[0], v[1]); w.y = pk2(v[2], v[3]); *(v2u*)(Xb + (size_t)row * 1024 + col) = w; }
        if (ssq_next) { float s = (v[0] * v[0] + v[1] * v[1]) + (v[2] * v[2] + v[3] * v[3]); s = half_sum(s); if (lane < 32) __hip_atomic_fetch_add(ssq_next + row, s, __ATOMIC_RELAXED, __HIP_MEMORY_SCOPE_AGENT); }
    }
};
}

#ifndef GEMM_ALIGN
#define GEMM_ALIGN true
#endif
#define GRID_BAR() do { CArgsP ab_ = (CArgsP)__builtin_amdgcn_kernarg_segment_ptr(); asm volatile("" : "+s"(ab_)); unsigned char* wsb_ = ab_->ws; XcdBarrier bar_; bar_.bar = (unsigned*)(wsb_ + WS_CTL) + CW_BAR; bar_.x = xb_xcc_id(); \
    bar_.st = (volatile LAS unsigned*)(lds + MISC_OFF) + 8; xcd_barrier(bar_, wave0 == 0 && hw_lane() == 0); } while (0)
#define FRESH() CArgsP a = (CArgsP)__builtin_amdgcn_kernarg_segment_ptr(); asm volatile("" : "+s"(a)); const int wave = wave0; const int lane = hw_lane(); const int tid = wave * 64 + lane; \
    const int gw = blockIdx.x * NWAVES + wave, NGW = gridDim.x * NWAVES, G = gridDim.x; \
    unsigned char* ws = a->ws; float* ssq = (float*)(ws + WS_CTL) + CW_SSQ; (void)lane; (void)gw; (void)NGW; (void)G; (void)ssq


template <int l> __device__ __forceinline__ void layer_phases(LAS unsigned char* lds, const int wave0) {
        {
            FRESH(); bf16* wl = (bf16*)(ws + WS_W + (size_t)l * WL_SIZE);
            pg8::Gemm g{(const bf16*)(ws + WS_XB), (const bf16*)((unsigned char*)wl + WL_IN), kR, kZW, 1024, 1024}; pg8::StaticOrder S; S.init(kR, kZW, G, (int)blockIdx.x);
            pg8::EpiIn E{(const void __attribute__((address_space(4)))*)a, l, (PG8_LAS float*)(lds + RING_BYTES),
                         WS_Z, WS_CTL + (size_t)(CW_SSQ + 2 * l * kR) * 4, WS_ROPE, WS_KMLA, OUT_PCKV, OUT_SCKV, OUT_PKR, OUT_SKR, OUT_PSBK, OUT_SSBK,
                         N_INPUTS, N_INPUTS + 1, IN_QNG, IN_KVNG, IN_KR_G, IN_DQN_G, IN_DKN_G};
            pg8::gemm_phase<pg8::EpiIn, pg8::StaticOrder, true, true>(lds, g, S, E, tid);
        }
        { FRESH(); bf16* wl = (bf16*)(ws + WS_W + (size_t)l * WL_SIZE);
          pg8::Gemm g{(const bf16*)(ws + WS_CKVB) + (size_t)l * NCACHE * 128, (const bf16*)((unsigned char*)wl + WL_UKV), NCACHE, 512, 128, 128}; typedef pg8::TailOrder<2, (NCACHE / 256) * 2, (kR / 256) * (kZW / 256), 3> KcOrder;   KcOrder S; S.init(G, (int)blockIdx.x);
          pg8::EpiKV E{(bf16*)(ws + WS_KMLAC) + (size_t)l * NCACHE * 768, (bf16*)(ws + WS_KNMVC), a->in[IN_KN_G] + l * 64}; pg8::gemm_phase<pg8::EpiKV, KcOrder, GEMM_ALIGN, true>(lds, g, S, E, tid); }
        GRID_BAR();
        {
            { FRESH(); bf16* wl = (bf16*)(ws + WS_W + (size_t)l * WL_SIZE);
              pg8::Gemm g{(const bf16*)(ws + WS_Z) + ZC_CQ, (const bf16*)((unsigned char*)wl + WL_UQ), kR, 768, 256, kZW}; pg8::StaticOrder S; S.init(kR, 768, G, (int)blockIdx.x);
              pg8::EpiQ E{(bf16*)(ws + WS_Q), a->in[IN_QN_G] + l * 64, a->in[IN_QR_G] + l * 32, (const float*)(ws + WS_ROPE)}; pg8::gemm_phase<pg8::EpiQ, pg8::StaticOrder, GEMM_ALIGN, true>(lds, g, S, E, tid); }
            { FRESH(); bf16* wl = (bf16*)(ws + WS_W + (size_t)l * WL_SIZE);
              pg8::Gemm g{(const bf16*)(ws + WS_Z) + ZC_CKV, (const bf16*)((unsigned char*)wl + WL_UKV), kR, 1024, 128, kZW}; pg8::StaticOrder S; S.init(kR, 1024, G, (int)blockIdx.x);
              pg8::EpiKV E{(bf16*)(ws + WS_KMLA), (bf16*)(ws + WS_KNMV), a->in[IN_KN_G] + l * 64}; pg8::gemm_phase<pg8::EpiKV, pg8::StaticOrder, GEMM_ALIGN, true>(lds, g, S, E, tid); }
        }
        GRID_BAR();
        { FRESH(); attn_phase(a, l, lds, (unsigned*)(ws + WS_CTL) + CW_WQ + 8 * l, wave0); }
        GRID_BAR();
        {
            { FRESH(); bf16* wl = (bf16*)(ws + WS_W + (size_t)l * WL_SIZE);
              pg8::Gemm g{(const bf16*)(ws + WS_O), (const bf16*)((unsigned char*)wl + WL_BR), 3 * kR, 3 * 1024, 512, 512}; pg8::BranchOrder S; S.init(kRP, G, (int)blockIdx.x);
              pg8::EpiBranchAll E{(const bf16*)(ws + WS_Z), (bf16*)(ws + WS_MP), (bf16*)(ws + WS_MB)}; pg8::gemm_phase<pg8::EpiBranchAll, pg8::BranchOrder, GEMM_ALIGN, true>(lds, g, S, E, tid);
              { sm::EpiBranchS<0> Es{(const bf16*)(ws + WS_Z), (bf16*)(ws + WS_MP), (bf16*)(ws + WS_MB)}; sm::small_gemm<4>(lds, g.A, 512, g.Bt, 512, Es, (int)blockIdx.x, G, wave, lane); }
              { sm::EpiBranchS<1> Es{(const bf16*)(ws + WS_Z), (bf16*)(ws + WS_MP), (bf16*)(ws + WS_MB)}; sm::small_gemm<4>(lds, g.A + (size_t)kR * 512, 512, g.Bt + (size_t)1024 * 512, 512, Es, (int)blockIdx.x, G, wave, lane); }
              { sm::EpiBranchS<2> Es{(const bf16*)(ws + WS_Z), (bf16*)(ws + WS_MP), (bf16*)(ws + WS_MB)}; sm::small_gemm<4>(lds, g.A + (size_t)2 * kR * 512, 512, g.Bt + (size_t)2 * 1024 * 512, 512, Es, (int)blockIdx.x, G, wave, lane); } }
        }
        GRID_BAR();
        {
            FRESH(); bf16* wl = (bf16*)(ws + WS_W + (size_t)l * WL_SIZE);
            pg8::Gemm g{(const bf16*)(ws + WS_MB), (const bf16*)((unsigned char*)wl + WL_OUT), kRP, 1024, 1024, 1024}; pg8::StaticOrder S; S.init(kRP, 1024, G, (int)blockIdx.x);
            pg8::EpiRes E{l == 0 ? a->in[IN_XP] : (const float*)a->out, a->out, (bf16*)(ws + WS_XB), ssq + (2 * l + 1) * kR};
            pg8::gemm_phase<pg8::EpiRes, pg8::StaticOrder, GEMM_ALIGN, true>(lds, g, S, E, tid);
            sm::EpiResS Es{l == 0 ? a->in[IN_XS] - (size_t)kRP * 1024 : (const float*)a->out, a->out, (bf16*)(ws + WS_XB), ssq + (2 * l + 1) * kR}; sm::small_gemm<8>(lds, g.A, 1024, g.Bt, 1024, Es, (int)blockIdx.x, G, wave, lane);
        }
        GRID_BAR();
        {
            FRESH(); bf16* wl = (bf16*)(ws + WS_W + (size_t)l * WL_SIZE);
            pg8::Gemm g{(const bf16*)(ws + WS_XB) - 2 * 1024, (const bf16*)((unsigned char*)wl + WL_UP), 67 * 256, 5632, 1024, 1024, 254}; pg8::StaticOrder S; S.init(67 * 256, 5632, G, (int)blockIdx.x);
            pg8::EpiUpConv E{(bf16*)(ws + WS_ACT), ssq + (2 * l + 1) * kR, a->in[IN_CONVW] + (size_t)l * 3 * DFF, a->in[IN_CONVB] + (size_t)l * DFF, a->in[IN_CONV] + (size_t)l * 16 * 2 * DFF, a->out,
                             OUT_PCONV + (size_t)l * 8 * 2 * DFF, OUT_SCONV + (size_t)l * 16 * 2 * DFF, (PG8_LAS float*)(lds + RING_BYTES)};
            pg8::gemm_phase<pg8::EpiUpConv, pg8::StaticOrder, true, true>(lds, g, S, E, tid);
        }
        GRID_BAR();
        {
            FRESH(); bf16* wl = (bf16*)(ws + WS_W + (size_t)l * WL_SIZE);
            pg8::Gemm g{(const bf16*)(ws + WS_ACT), (const bf16*)((unsigned char*)wl + WL_DOWN), kRP, 1024, DFF, DFF}; pg8::StaticOrder S; S.init(kRP, 1024, G, (int)blockIdx.x);
            pg8::EpiRes E{a->out, a->out, l == 0 ? (bf16*)(ws + WS_XB) : nullptr, l == 0 ? ssq + 2 * kR : nullptr};
            pg8::gemm_phase<pg8::EpiRes, pg8::StaticOrder, GEMM_ALIGN, true>(lds, g, S, E, tid);
            sm::EpiResS Es{a->out, a->out, l == 0 ? (bf16*)(ws + WS_XB) : nullptr, l == 0 ? ssq + 2 * kR : nullptr}; sm::small_gemm<22>(lds, g.A, DFF, g.Bt, DFF, Es, (int)blockIdx.x, G, wave, lane);
        }
}

__global__ void __launch_bounds__(512, 2) k_mega(Args a_) {
    extern __shared__ __attribute__((aligned(16))) unsigned char lds_[];
    LAS unsigned char* lds = (LAS unsigned char*)lds_;
    const int wave0 = __builtin_amdgcn_readfirstlane((int)threadIdx.x >> 6);
    {
        volatile LAS unsigned* MISC0 = (volatile LAS unsigned*)(lds + MISC_OFF);
        if (wave0 == 0) { const int l0 = hw_lane(); if (l0 < 32) MISC0[l0] = 0u; }
        __syncthreads();
    }
    (void)xcd_barrier_post((unsigned*)(a_.ws + WS_CTL) + CW_BAR, (volatile LAS unsigned*)(lds + MISC_OFF) + 8, wave0 == 0 && hw_lane() == 0);
    { FRESH(); p0_phase(a, lds, gw, NGW, wave, lane); }
    GRID_BAR();
    layer_phases<0>(lds, wave0);
    GRID_BAR();
    layer_phases<1>(lds, wave0);
}

extern "C" void kernel_launch(void* const* d_in, const int* in_sizes, int n_in, void* d_out, int out_size, void* d_ws, size_t ws_size, hipStream_t stream) {
    static int grid = 0;
    if (grid == 0) {
        int dev = 0, cus = 0, per_cu = 0;
        if (hipGetDevice(&dev) != hipSuccess || hipDeviceGetAttribute(&cus, hipDeviceAttributeMultiprocessorCount, dev) != hipSuccess) { fprintf(stderr, "kernel_launch: device query failed\n"); grid = -1; return; }
        if (hipFuncSetAttribute((const void*)k_mega, hipFuncAttributeMaxDynamicSharedMemorySize, LDS_BYTES) != hipSuccess) { fprintf(stderr, "kernel_launch: hipFuncSetAttribute failed\n"); grid = -1; return; }
        if (hipOccupancyMaxActiveBlocksPerMultiprocessor(&per_cu, (const void*)k_mega, 512, LDS_BYTES) != hipSuccess || per_cu < 1) { fprintf(stderr, "kernel_launch: occupancy query reports %d blocks per CU\n", per_cu); per_cu = 1; }
        (void)hipGetLastError();
        grid = cus;
    }
    if (grid < 0) return;
    static_assert(WS_FAST_END <= (size_t)1374208512, "workspace");
    if (hipMemsetAsync((char*)d_ws + WS_CTL, 0, CTL_ZERO_BYTES, stream) != hipSuccess) return;
    Args a{};
    for (int i = 0; i < N_INPUTS; ++i) a.in[i] = (const float*)d_in[i];
    a.out = (float*)d_out; a.ws = (unsigned char*)d_ws; a.layer = 0; a.pad = 0;
    hipLaunchKernelGGL(k_mega, dim3(grid), dim3(512), LDS_BYTES, stream, a);
}
```
